# Optimizing an MI355X kernel written in HIP

```python
import math
import jax, jax.numpy as jnp
from jax import lax
import numpy as np

D_MODEL = 1024
BATCH = 4
SEQ = 4096
DEPTH = 1

CHUNK = 64
EPS = 1e-6
HG_HEADS = 8
HG_DK = 128
HG_DV = D_MODEL // HG_HEADS
HG_WIDTH_K = HG_HEADS * HG_DK
HG_WIDTH_V = HG_HEADS * HG_DV
GDN_QK_HEADS = 8
GDN_V_HEADS = 16
GDN_DK = 128
GDN_DV = 128
GDN_WIDTH_K = GDN_QK_HEADS * GDN_DK
GDN_WIDTH_V = GDN_V_HEADS * GDN_DV
CONV_K = 4
D_FF = 2816
IN_SIZES = (HG_WIDTH_K, HG_WIDTH_K, HG_WIDTH_V, HG_WIDTH_V,
            GDN_WIDTH_K, GDN_WIDTH_K, GDN_WIDTH_V, GDN_V_HEADS, GDN_V_HEADS, GDN_WIDTH_V,
            D_MODEL, D_MODEL)
IN_WIDTH = sum(IN_SIZES)

kernel_name = "hgrn2_gdn_gated_macaron_block"


def rmsnorm(x, g):
    xf = x.astype(jnp.float32)
    y = xf * lax.rsqrt(jnp.mean(xf * xf, axis=-1, keepdims=True) + EPS)
    return (y * g).astype(x.dtype)


def l2norm(x):
    return x * lax.rsqrt(jnp.sum(x * x, axis=-1, keepdims=True) + EPS)


def swiglu(x, w_in, w_out):
    a, b = jnp.split(x @ w_in, 2, axis=-1)
    return (jax.nn.silu(a) * b) @ w_out


def to_chunks(t, n_heads):
    B, S = t.shape[:2]
    t = t.reshape(B, S // CHUNK, CHUNK, n_heads, -1)
    return jnp.transpose(t, (0, 3, 1, 2, 4))


def from_chunks(t):
    B, H, NC, C, d = t.shape
    return jnp.transpose(t, (0, 2, 3, 1, 4)).reshape(B, NC * C, H, d)


def causal_short_conv(x, w):
    K = w.shape[0]
    S = x.shape[1]
    xp = jnp.pad(x, ((0, 0), (K - 1, 0), (0, 0)))
    return sum(xp[:, j:j + S] * w[j] for j in range(K))


def hgrn2_chunked(q, k, v, log_f):
    B, H, NC, C, DK = q.shape
    DV = v.shape[-1]
    b_cum = jnp.cumsum(log_f, axis=3)
    causal = jnp.tril(jnp.ones((C, C), dtype=bool))[:, :, None]

    def step(S, inp):
        q_c, k_c, v_c, b_c = inp
        inter = jnp.einsum('bhtk,bhkv->bhtv', q_c * jnp.exp(b_c), S)
        diff = b_c[:, :, :, None, :] - b_c[:, :, None, :, :]
        decay = jnp.exp(jnp.where(causal, diff, -jnp.inf))
        scores = jnp.einsum('bhtk,bhsk,bhtsk->bhts', q_c, k_c, decay)
        intra = jnp.einsum('bhts,bhsv->bhtv', scores, v_c)
        b_end = b_c[:, :, -1, :]
        k_to_end = k_c * jnp.exp(b_end[:, :, None, :] - b_c)
        S = jnp.exp(b_end)[..., None] * S + jnp.einsum('bhsk,bhsv->bhkv', k_to_end, v_c)
        return S, inter + intra

    S0 = jnp.zeros((B, H, DK, DV), jnp.float32)
    xs = (jnp.moveaxis(q, 2, 0), jnp.moveaxis(k, 2, 0), jnp.moveaxis(v, 2, 0), jnp.moveaxis(b_cum, 2, 0))
    _, o = lax.scan(step, S0, xs)
    return jnp.moveaxis(o, 0, 2)


def gated_delta_chunked(q, k, v, beta, g):
    B, H, NC, C, DK = q.shape
    DV = v.shape[-1]
    gam = jnp.cumsum(g, axis=-1)
    incl = jnp.tril(jnp.ones((C, C), dtype=bool))
    strict = jnp.tril(jnp.ones((C, C), dtype=bool), -1)
    diff = gam[..., :, None] - gam[..., None, :]
    Lmat = jnp.exp(jnp.where(incl, diff, -jnp.inf))
    kb = k * beta[..., None]
    A = jnp.where(strict, jnp.einsum('bhntk,bhnsk->bhnts', kb, k) * Lmat, 0.0)
    eye = jnp.eye(C, dtype=A.dtype)
    T = lax.linalg.triangular_solve(eye + A, jnp.broadcast_to(eye, A.shape),
                                    left_side=True, lower=True, unit_diagonal=True)
    u = jnp.matmul(T, v * beta[..., None])
    w = jnp.matmul(T, kb * jnp.exp(gam)[..., None])
    qk = jnp.einsum('bhntk,bhnsk->bhnts', q, k) * Lmat

    def step(S, inp):
        q_c, k_c, u_c, w_c, qk_c, gam_c = inp
        v_new = u_c - jnp.einsum('bhtk,bhkv->bhtv', w_c, S)
        o = (jnp.einsum('bhtk,bhkv->bhtv', q_c * jnp.exp(gam_c)[..., None], S)
             + jnp.einsum('bhts,bhsv->bhtv', qk_c, v_new))
        g_end = gam_c[..., -1]
        k_to_end = k_c * jnp.exp(g_end[..., None] - gam_c)[..., None]
        S = S * jnp.exp(g_end)[..., None, None] + jnp.einsum('bhsk,bhsv->bhkv', k_to_end, v_new)
        return S, o

    S0 = jnp.zeros((B, H, DK, DV), jnp.float32)
    xs = tuple(jnp.moveaxis(t, 2, 0) for t in (q, k, u, w, qk, gam))
    _, o = lax.scan(step, S0, xs)
    return jnp.moveaxis(o, 0, 2)


def hybrid_mixer(u, w_in, lb, hgrn_out_norm, conv_w, a_log, dt_bias, gdn_out_norm,
                 w_branch_hgrn, w_branch_gdn, w_out):
    B, S, _ = u.shape
    f32 = jnp.float32
    proj = (u @ w_in).astype(f32)
    offsets = np.cumsum(IN_SIZES)[:-1].tolist()
    (hq, hf, hi, hg, gq, gk, gv, ga, gb, gz, gate_h, gate_g) = jnp.split(proj, offsets, axis=-1)

    lb = lb.astype(f32)
    log_f = jnp.logaddexp(jnp.log(lb), jnp.log1p(-lb) + jax.nn.log_sigmoid(hf))
    k_h = -jnp.expm1(log_f)
    q_h = jax.nn.silu(hq) * HG_DK ** -0.5
    o_h = hgrn2_chunked(to_chunks(q_h, HG_HEADS), to_chunks(k_h, HG_HEADS),
                        to_chunks(hi, HG_HEADS), to_chunks(log_f, HG_HEADS))
    o_h = rmsnorm(from_chunks(o_h), hgrn_out_norm) * jax.nn.silu(hg).reshape(B, S, HG_HEADS, HG_DV)
    y_h = o_h.reshape(B, S, HG_WIDTH_V) @ w_branch_hgrn

    qkv = jax.nn.silu(causal_short_conv(jnp.concatenate([gq, gk, gv], axis=-1), conv_w))
    cq, ck, cv = jnp.split(qkv, [GDN_WIDTH_K, 2 * GDN_WIDTH_K], axis=-1)
    rep = GDN_V_HEADS // GDN_QK_HEADS
    q_g = l2norm(cq.reshape(B, S, GDN_QK_HEADS, GDN_DK)) * GDN_DK ** -0.5
    k_g = l2norm(ck.reshape(B, S, GDN_QK_HEADS, GDN_DK))
    q_g = jnp.repeat(q_g, rep, axis=2).reshape(B, S, GDN_V_HEADS * GDN_DK)
    k_g = jnp.repeat(k_g, rep, axis=2).reshape(B, S, GDN_V_HEADS * GDN_DK)
    beta = jax.nn.sigmoid(gb)
    g = -jnp.exp(a_log.astype(f32)) * jax.nn.softplus(ga + dt_bias)
    o_g = gated_delta_chunked(to_chunks(q_g, GDN_V_HEADS), to_chunks(k_g, GDN_V_HEADS),
                              to_chunks(cv, GDN_V_HEADS),
                              to_chunks(beta[..., None], GDN_V_HEADS)[..., 0],
                              to_chunks(g[..., None], GDN_V_HEADS)[..., 0])
    o_g = rmsnorm(from_chunks(o_g), gdn_out_norm) * jax.nn.silu(gz).reshape(B, S, GDN_V_HEADS, GDN_DV)
    y_g = o_g.reshape(B, S, GDN_WIDTH_V) @ w_branch_gdn

    y = jax.nn.sigmoid(gate_h) * y_h + jax.nn.sigmoid(gate_g) * y_g
    return (y @ w_out).astype(u.dtype)


def setup_inputs(seed: int = 0) -> dict:
    key = jax.random.key(seed)
    ks = jax.random.split(key, 20)
    f32 = jnp.float32
    L = DEPTH

    def dense(k, shape):
        return jax.random.normal(k, shape, f32) * shape[-2] ** -0.5

    def gain(k, shape):
        return 1.0 + 0.05 * jax.random.normal(k, shape, f32)

    A = jax.random.uniform(ks[8], (L, GDN_V_HEADS), f32, 1.0, 16.0)
    dt = jnp.exp(jax.random.uniform(ks[9], (L, GDN_V_HEADS), f32, math.log(1e-3), math.log(1e-1)))
    dt_bias = dt + jnp.log(-jnp.expm1(-dt))
    return {
        "x": jax.random.normal(ks[0], (BATCH, SEQ, D_MODEL), f32),
        "ffn1_norm": gain(ks[1], (L, D_MODEL)),
        "ffn1_w_in": dense(ks[2], (L, D_MODEL, 2 * D_FF)),
        "ffn1_w_out": dense(ks[3], (L, D_FF, D_MODEL)),
        "mix_norm": gain(ks[4], (L, D_MODEL)),
        "w_in": dense(ks[5], (L, D_MODEL, IN_WIDTH)),
        "hgrn_lb_logits": 0.5 * jax.random.normal(ks[6], (L + 1, HG_WIDTH_K), f32),
        "hgrn_out_norm": gain(ks[7], (L, HG_DV)),
        "gdn_conv_w": 0.5 * jax.random.normal(ks[10], (L, CONV_K, 2 * GDN_WIDTH_K + GDN_WIDTH_V), f32),
        "gdn_a_log": jnp.log(A),
        "gdn_dt_bias": dt_bias,
        "gdn_out_norm": gain(ks[11], (L, GDN_DV)),
        "w_branch_hgrn": dense(ks[12], (L, HG_WIDTH_V, D_MODEL)),
        "w_branch_gdn": dense(ks[13], (L, GDN_WIDTH_V, D_MODEL)),
        "w_out": dense(ks[14], (L, D_MODEL, D_MODEL)),
        "ffn2_norm": gain(ks[15], (L, D_MODEL)),
        "ffn2_w_in": dense(ks[16], (L, D_MODEL, 2 * D_FF)),
        "ffn2_w_out": dense(ks[17], (L, D_FF, D_MODEL)),
        "final_norm": gain(ks[18], (D_MODEL,)),
    }


def reference(x, ffn1_norm, ffn1_w_in, ffn1_w_out, mix_norm, w_in, hgrn_lb_logits,
              hgrn_out_norm, gdn_conv_w, gdn_a_log, gdn_dt_bias, gdn_out_norm,
              w_branch_hgrn, w_branch_gdn, w_out, ffn2_norm, ffn2_w_in, ffn2_w_out,
              final_norm):
    lb_all = jnp.cumsum(jax.nn.softmax(hgrn_lb_logits.astype(jnp.float32), axis=0), axis=0)
    h = x
    for l in range(DEPTH):
        h = h + 0.5 * swiglu(rmsnorm(h, ffn1_norm[l]), ffn1_w_in[l], ffn1_w_out[l])
        h = h + hybrid_mixer(rmsnorm(h, mix_norm[l]), w_in[l], lb_all[l], hgrn_out_norm[l],
                             gdn_conv_w[l], gdn_a_log[l], gdn_dt_bias[l], gdn_out_norm[l],
                             w_branch_hgrn[l], w_branch_gdn[l], w_out[l])
        h = h + 0.5 * swiglu(rmsnorm(h, ffn2_norm[l]), ffn2_w_in[l], ffn2_w_out[l])
    return rmsnorm(h, final_norm)
```

```cpp
#define PROBE_MASK 0x0
#include <hip/hip_runtime.h>
#include <hip/hip_cooperative_groups.h>
#include <cstdio>
namespace cg = cooperative_groups;

#define DI __device__ __forceinline__
#define LAS __attribute__((address_space(3)))
typedef unsigned short u16;
typedef short bf16x8 __attribute__((ext_vector_type(8)));
typedef float f32x4 __attribute__((ext_vector_type(4)));
typedef unsigned u32x4 __attribute__((ext_vector_type(4)));
typedef unsigned u32x2 __attribute__((ext_vector_type(2)));

constexpr int T_TOK = 16384, DM = 1024, DFF = 2816, INW = 12320;
constexpr int PLD = 8192;
constexpr int LLD = 4096;
constexpr int L_GZ = 0, L_GH = 2048, L_GG = 3072;
constexpr int C_HQ = 0, C_HF = 1024, C_HI = 2048, C_HG = 3072, C_GQ = 4096, C_GK = 5120, C_GV = 6144;
constexpr float EPS = 1e-6f;
constexpr size_t MiB = 1u << 20;
constexpr size_t WS_BAR = 512 * 1024, BAR_BYTES = 16384;
constexpr size_t WS_WAB = 256 * 1024;
constexpr size_t WS_SS = 0;
constexpr size_t WS_WIN = 1 * MiB, WS_WB = 25 * MiB, WS_WOUT = 31 * MiB;
constexpr size_t WS_WFI = 33 * MiB, WS_WFO = 44 * MiB;
constexpr size_t WS_XN = 50 * MiB;
constexpr size_t WS_XN3 = 82 * MiB;
constexpr size_t WS_SC = 82 * MiB, WS_WM = 86 * MiB, WS_QK = 102 * MiB, WS_HALO = 110 * MiB;
constexpr size_t WS_HID = 114 * MiB, WS_PROJ = 114 * MiB, WS_LATE = 178 * MiB;
constexpr size_t WS_STATE = 242 * MiB, WS_GAM = 248 * MiB, WS_DEC = 248 * MiB + 512 * 1024;
constexpr size_t WS_DUMMY = 248 * MiB + 768 * 1024;
constexpr size_t WS_GBG = 249 * MiB, WS_GBB = 250 * MiB;
constexpr size_t WS_TMP = 251 * MiB;
constexpr size_t WS_END = 256 * MiB;
constexpr int LDS_BYTES = 159744;

DI unsigned f2bf(float f) { unsigned u = __float_as_uint(f); return (u + 0x7fffu + ((u >> 16) & 1u)) >> 16; }
typedef float f32x2_t __attribute__((ext_vector_type(2)));
typedef __bf16 bf16x2_t __attribute__((ext_vector_type(2)));
DI unsigned pk2(float lo, float hi) { const f32x2_t v = {lo, hi}; return __builtin_bit_cast(unsigned, __builtin_convertvector(v, bf16x2_t)); }
DI float bf2f(unsigned b) { return __uint_as_float(b << 16); }
DI void unpack8(u32x4 w, float (&f)[8]) {
    f[0] = __uint_as_float(w.x << 16); f[1] = __uint_as_float(w.x & 0xffff0000u); f[2] = __uint_as_float(w.y << 16); f[3] = __uint_as_float(w.y & 0xffff0000u);
    f[4] = __uint_as_float(w.z << 16); f[5] = __uint_as_float(w.z & 0xffff0000u); f[6] = __uint_as_float(w.w << 16); f[7] = __uint_as_float(w.w & 0xffff0000u);
}
DI u32x4 pack8(const float (&f)[8]) { u32x4 w; w.x = pk2(f[0], f[1]); w.y = pk2(f[2], f[3]); w.z = pk2(f[4], f[5]); w.w = pk2(f[6], f[7]); return w; }
DI float wave_sum(float v) {
#pragma unroll
    for (int o = 1; o < 64; o <<= 1) v += __shfl_xor(v, o);
    return v;
}
#define DPP_ROR(x, n) __builtin_bit_cast(float, __builtin_amdgcn_update_dpp(0, __builtin_bit_cast(int, (x)), 0x120 + (n), 0xf, 0xf, false))
DI float row16_sum(float x) { x += DPP_ROR(x, 8); x += DPP_ROR(x, 4); x += DPP_ROR(x, 2); x += DPP_ROR(x, 1); return x; }
DI void lbar() { asm volatile("s_waitcnt lgkmcnt(0)\n\ts_barrier" ::: "memory"); }
DI float sigm(float x) { return __builtin_amdgcn_rcpf(1.0f + __expf(-x)); }
DI unsigned cvt_pk_bf16(float lo, float hi) { unsigned r; asm volatile("v_cvt_pk_bf16_f32 %0, %1, %2" : "=v"(r) : "v"(lo), "v"(hi)); return r; }
DI unsigned short f2h(float f) { _Float16 h = (_Float16)f; return __builtin_bit_cast(unsigned short, h); }
DI float h2f(unsigned short b) { return (float)__builtin_bit_cast(_Float16, b); }
DI void st_perm(LAS u16* row, int c, u32x4 v) { const int cc = c & 3; LAS u16* p = row + ((8 * c) & ~31) + 16 * (cc & 1) + 4 * (cc >> 1);
    u32x2 lo, hi; lo.x = v.x; lo.y = v.y; hi.x = v.z; hi.y = v.w; *(LAS u32x2*)p = lo; *(LAS u32x2*)(p + 8) = hi; }
DI size_t widx(bool dry, int tid, size_t idx) { return dry ? (size_t)tid * 8 : idx; }
DI bf16x8 mk8(u32x2 lo, u32x2 hi) { u32x4 w; w.x = lo.x; w.y = lo.y; w.z = hi.x; w.w = hi.y; return __builtin_bit_cast(bf16x8, w); }
DI bf16x8 packacc(f32x4 a, f32x4 b) { u32x4 w; w.x = pk2(a[0], a[1]); w.y = pk2(a[2], a[3]); w.z = pk2(b[0], b[1]); w.w = pk2(b[2], b[3]); return __builtin_bit_cast(bf16x8, w); }
#define MFMA16(a, b, c) __builtin_amdgcn_mfma_f32_16x16x32_bf16((a), (b), (c), 0, 0, 0)
DI bf16x8 fragN(const LAS u16* M, int row, int k0, int g, int stride) { return *(const LAS bf16x8*)(M + row * stride + k0 + 8 * g); }
DI bf16x8 fragP(const LAS u16* M, int row, int k0, int g, int stride) {
    const LAS u16* p = M + row * stride + k0 + 4 * g;
    return mk8(*(const LAS u32x2*)p, *(const LAS u32x2*)(p + 16));
}

#define XB_TMO      128
#define XB_XCNT(j)  (256  + 64 * (j))
#define XB_XSUB(j)  (1280 + 64 * (j))
#define XB_XGEN(j)  (2304 + 64 * (j))
#define XB_TOP      3328
#define XB_TOPGEN   3392
#define XCD_BAR_WORDS 3456
#define XB_SPIN_CAP (1u << 18)

__device__ __forceinline__ unsigned xb_ld(unsigned* p)              { return __hip_atomic_load(p, __ATOMIC_RELAXED, __HIP_MEMORY_SCOPE_AGENT); }
__device__ __forceinline__ unsigned xb_add(unsigned* p, unsigned v) { return __hip_atomic_fetch_add(p, v, __ATOMIC_RELAXED, __HIP_MEMORY_SCOPE_AGENT); }
__device__ __forceinline__ unsigned xb_xcc_id() { return (unsigned)__builtin_amdgcn_s_getreg((3 << 11) | 20) & 0xFu; }
#define XB_SPIN(cond, bar) do { unsigned _sp = 0; while (cond) { __builtin_amdgcn_s_sleep(1); \
    if ((++_sp & 255u) == 0u) { if (xb_ld(&(bar)[XB_TMO])) break; if (_sp > XB_SPIN_CAP) { atomicAdd(&(bar)[XB_TMO], 1u); break; } } } } while (0)

struct XcdBarrier {
    unsigned* bar; unsigned x;
    volatile LAS unsigned* st;
};

__device__ __forceinline__ XcdBarrier xcd_barrier_post(unsigned* bar, volatile LAS unsigned* st) {
    XcdBarrier b; b.bar = bar; b.x = xb_xcc_id(); b.st = st;
    if (threadIdx.x == 0) (void)xb_add(&bar[XB_XCNT(b.x)], 1u);
    return b;
}
__device__ __forceinline__ void xcd_barrier_complete(unsigned* bar, unsigned x, unsigned& nloc, unsigned& nx) {
    const unsigned G = gridDim.x * gridDim.y * gridDim.z;
    unsigned sum, cnt, mine, sp = 0u;
    for (;;) {
        sum = 0u; cnt = 0u; mine = 0u;
#pragma unroll
        for (unsigned j = 0; j < 16; ++j) { const unsigned c = xb_ld(&bar[XB_XCNT(j)]); sum += c; cnt += (c > 0u) ? 1u : 0u; mine = (j == x) ? c : mine; }
        if (sum == G) break;
        __builtin_amdgcn_s_sleep(1);
        if ((++sp & 255u) == 0u) { if (xb_ld(&bar[XB_TMO])) break; if (sp > XB_SPIN_CAP) { atomicAdd(&bar[XB_TMO], 1u); break; } }
    }
    nloc = mine > 0u ? mine : 1u; nx = cnt > 0u ? cnt : 1u;
}

__device__ __forceinline__ void xcd_barrier(const XcdBarrier& b) {
    asm volatile("s_waitcnt vmcnt(0)" ::: "memory");
    __syncthreads();
    if (threadIdx.x == 0) {
        unsigned* bar = b.bar;
        __builtin_amdgcn_s_waitcnt(0);
        unsigned nloc = b.st[0], nx = b.st[1];
        if (nloc == 0u) { xcd_barrier_complete(bar, b.x, nloc, nx); b.st[0] = nloc; b.st[1] = nx; }
        const unsigned old = xb_add(&bar[XB_XSUB(b.x)], 1u);
        const unsigned gen = old / nloc;
        if (old + 1u == (gen + 1u) * nloc) {
            __builtin_amdgcn_fence(__ATOMIC_RELEASE, "agent");
            asm volatile("s_waitcnt vmcnt(0)" ::: "memory");
            const unsigned og = xb_add(&bar[XB_TOP], 1u);
            const unsigned tg = og / nx;
            if (og + 1u == (tg + 1u) * nx) xb_add(&bar[XB_TOPGEN], 1u);
            else XB_SPIN(xb_ld(&bar[XB_TOPGEN]) == tg, bar);
            __builtin_amdgcn_fence(__ATOMIC_ACQUIRE, "agent");
            xb_add(&bar[XB_XGEN(b.x)], 1u);
            asm volatile("s_waitcnt vmcnt(0)" ::: "memory");
        } else {
            XB_SPIN(xb_ld(&bar[XB_XGEN(b.x)]) == gen, bar);
            __builtin_amdgcn_fence(__ATOMIC_ACQUIRE, "agent");
            asm volatile("s_waitcnt vmcnt(0)" ::: "memory");
        }
    }
    __syncthreads();
}


namespace pg8 {
constexpr int BM = 256, BK = 64, HALF = 128, HTB = HALF * BK * 2, NXCD = 8, WGM = 8;
DI int lds_byte(int r, int c) { const int st = (r >> 4) * 2 + (c >> 5), rr = r & 15, cc = c & 31, ob = rr * 64 + cc * 2; return st * 1024 + (ob ^ (((ob >> 9) & 1) << 5)); }
DI void stage_rc(int b, int& R, int& C) { const int st = b / 1024, sb = b % 1024, swz = sb ^ (((sb >> 9) & 1) << 5); R = (st >> 1) * 16 + swz / 64; C = (st & 1) * 32 + (swz % 64) / 2; }
DI int perm32(int rho) { const int n = rho >> 4, i = rho & 15; return 8 * (i >> 2) + 4 * n + (i & 3); }
struct Unit { int pm, pn, part; };
struct Order {
    int nM, nN, nwg, G, c;
    DI void init(int nM_, int nN_, int G_, int c_) { nM = nM_; nN = nN_; nwg = nM * nN; G = G_; c = c_; }
    DI bool next(int i, Unit& u) const {
        const long L = (long)i * G + c; if (L >= nwg) return false;
        int wgid = (int)L; { const int q = nwg / NXCD, r = nwg % NXCD, xcd = wgid % NXCD, off = wgid / NXCD; wgid = (xcd < r ? xcd * (q + 1) : r * (q + 1) + (xcd - r) * q) + off; }
        const int nig = WGM * nN, gid = wgid / nig, fm = gid * WGM, gsz = (nM - fm) < WGM ? (nM - fm) : WGM;
        u.pm = fm + ((wgid % nig) % gsz); u.pn = (wgid % nig) / gsz; u.part = 0; return true;
    }
};

template <class Epi, class Sched>
DI void gemm_phase(LAS unsigned char* lds, const Sched& S, const Epi& E) {
    int tid_ = threadIdx.x; asm volatile("" : "+v"(tid_));
    const int tid = tid_, wid = __builtin_amdgcn_readfirstlane(tid >> 6), lane = tid & 63, wr = wid >> 2, wc = wid & 3, fr = lane & 15, fq = lane >> 4;
    unsigned voffA[2], voffB[2];
#pragma unroll
    for (int i = 0; i < 2; ++i) { int R, C; stage_rc(tid * 16 + i * 8192, R, C); const int Rb = Epi::PERM ? ((R & ~31) + perm32(R & 31)) : R;
        voffA[i] = (unsigned)(R * S.lda + C) * 2u; voffB[i] = (unsigned)(Rb * S.ldb + C) * 2u; }
    const size_t kstep = (size_t)(BK * 2);
    const size_t hstepA = (size_t)HALF * S.lda * 2, hstepB = (size_t)HALF * S.ldb * 2;
    const unsigned ldsw = (unsigned)wid * 1024u;
    const int aoff = lds_byte(wr * 64 + fr, fq * 8), boff = lds_byte(wc * 32 + fr, fq * 8);
#define PG8_SA(b, h) (((b) * 2 + (h)) * HTB)
#define PG8_SB(b, h) ((4 + (b) * 2 + (h)) * HTB)
#define PG8_STAGE(bufoff, gbase, voff) do { _Pragma("unroll") for (int _i = 0; _i < 2; ++_i) \
        __builtin_amdgcn_global_load_lds((const unsigned*)((const char*)(gbase) + (voff)[_i]), (LAS unsigned*)(lds + (bufoff) + ldsw + _i * 8192), 16, 0, 0); } while (0)
#define PG8_LDA(dst, b, h) do { _Pragma("unroll") for (int m = 0; m < 4; ++m) _Pragma("unroll") for (int k = 0; k < 2; ++k) dst[m][k] = *(const LAS bf16x8*)(lds + PG8_SA(b, h) + aoff + m * 2048 + k * 1024); } while (0)
#define PG8_LDB(dst, b, h) do { _Pragma("unroll") for (int n = 0; n < 2; ++n) _Pragma("unroll") for (int k = 0; k < 2; ++k) dst[n][k] = *(const LAS bf16x8*)(lds + PG8_SB(b, h) + boff + n * 2048 + k * 1024); } while (0)
#define PG8_MMA(ai, bj, At, Bt) do { __builtin_amdgcn_s_setprio(1); _Pragma("unroll") for (int m = 0; m < 4; ++m) _Pragma("unroll") for (int n = 0; n < 2; ++n) _Pragma("unroll") for (int k = 0; k < 2; ++k) \
        acc[ai][bj][m][n] = __builtin_amdgcn_mfma_f32_16x16x32_bf16(Bt[n][k], At[m][k], acc[ai][bj][m][n], 0, 0, 0); __builtin_amdgcn_s_setprio(0); } while (0)
#define PG8_WAIT_V(n) asm volatile("s_waitcnt vmcnt(" #n ")" ::: "memory")
#define PG8_WAIT_L(n) asm volatile("s_waitcnt lgkmcnt(" #n ")" ::: "memory")
#define PG8_BAR __builtin_amdgcn_s_barrier()
#define PG8_SCHED __builtin_amdgcn_sched_barrier(0)
    Unit cur, nxt; int ui = 0;
    if (!S.next(0, cur)) return;
    f32x4 acc[2][2][4][2];
#pragma unroll
    for (int a = 0; a < 2; ++a)
#pragma unroll
        for (int b = 0; b < 2; ++b)
#pragma unroll
            for (int m = 0; m < 4; ++m)
#pragma unroll
                for (int n = 0; n < 2; ++n) acc[a][b][m][n] = (f32x4){0.f, 0.f, 0.f, 0.f};
    bf16x8 At[4][2], B0[2][2], B1[2][2];
    const char* cA; const char* cB; S.ptrs(cur, cA, cB);
    PG8_STAGE(PG8_SB(0, 0), cB, voffB); PG8_STAGE(PG8_SB(0, 1), cB + hstepB, voffB); PG8_STAGE(PG8_SA(0, 0), cA, voffA); PG8_STAGE(PG8_SA(0, 1), cA + hstepA, voffA);
    if (wr == 1) PG8_BAR;
    PG8_WAIT_V(2); PG8_BAR;
    PG8_STAGE(PG8_SB(1, 0), cB + kstep, voffB); PG8_STAGE(PG8_SA(1, 0), cA + kstep, voffA); PG8_STAGE(PG8_SB(1, 1), cB + hstepB + kstep, voffB);
    PG8_WAIT_V(6); PG8_BAR;
    for (;;) {
        const bool has_next = S.next(ui + 1, nxt); const int nt = S.ntu(cur);
        const char* nA = cA; const char* nB = cB; if (has_next) S.ptrs(nxt, nA, nB);
        for (int t = 0; t < nt; t += 2) {
            const bool last = (t == nt - 2);
            const char* a1 = cA + (size_t)(t + 1) * kstep;
            const char* a2 = last ? nA : cA + (size_t)(t + 2) * kstep; const char* b2 = last ? nB : cB + (size_t)(t + 2) * kstep;
            const char* a3 = a2 + kstep; const char* b3 = b2 + kstep;
            PG8_LDB(B0, 0, 0); PG8_LDB(B1, 0, 1); PG8_SCHED; PG8_LDA(At, 0, 0); PG8_STAGE(PG8_SA(1, 1), a1 + hstepA, voffA);
            PG8_WAIT_V(8); PG8_WAIT_L(0); PG8_BAR; PG8_MMA(0, 0, At, B0); PG8_MMA(0, 1, At, B1); PG8_BAR; PG8_SCHED;
            PG8_LDA(At, 0, 1); PG8_STAGE(PG8_SB(0, 0), b2, voffB); PG8_STAGE(PG8_SB(0, 1), b2 + hstepB, voffB); PG8_STAGE(PG8_SA(0, 0), a2, voffA);
            PG8_WAIT_V(8); PG8_WAIT_L(0); PG8_BAR; PG8_MMA(1, 0, At, B0); PG8_MMA(1, 1, At, B1); PG8_BAR; PG8_SCHED;
            PG8_LDB(B0, 1, 0); PG8_LDB(B1, 1, 1); PG8_SCHED; PG8_LDA(At, 1, 0); PG8_STAGE(PG8_SA(0, 1), a2 + hstepA, voffA);
            PG8_WAIT_V(8); PG8_WAIT_L(0); PG8_BAR; PG8_MMA(0, 0, At, B0); PG8_MMA(0, 1, At, B1); PG8_BAR; PG8_SCHED;
            PG8_LDA(At, 1, 1); PG8_STAGE(PG8_SB(1, 0), b3, voffB); PG8_STAGE(PG8_SB(1, 1), b3 + hstepB, voffB); PG8_STAGE(PG8_SA(1, 0), a3, voffA);
            PG8_WAIT_V(8); PG8_WAIT_L(0); PG8_BAR; PG8_MMA(1, 0, At, B0); PG8_MMA(1, 1, At, B1); PG8_BAR; PG8_SCHED;
        }
        if (wr == 0) PG8_BAR;
        { int fr2 = fr, fq2 = fq; asm volatile("" : "+v"(fr2), "+v"(fq2)); E(acc, cur, wr, wc, fr2, fq2); }
        if (!has_next) break;
#pragma unroll
        for (int a = 0; a < 2; ++a)
#pragma unroll
            for (int b = 0; b < 2; ++b)
#pragma unroll
                for (int m = 0; m < 4; ++m)
#pragma unroll
                    for (int n = 0; n < 2; ++n) acc[a][b][m][n] = (f32x4){0.f, 0.f, 0.f, 0.f};
        cur = nxt; cA = nA; cB = nB; ++ui;
        if (wr == 1) PG8_BAR;
    }
    PG8_WAIT_V(0);
    PG8_BAR;
#undef PG8_SA
#undef PG8_SB
#undef PG8_STAGE
#undef PG8_LDA
#undef PG8_LDB
#undef PG8_MMA
#undef PG8_WAIT_V
#undef PG8_WAIT_L
#undef PG8_BAR
#undef PG8_SCHED
}
}
using pg8::Unit;
typedef f32x4 Acc[2][2][4][2];

struct KArgs { const float* in[19]; float* out; unsigned char* ws; int ph_lo, ph_hi, probe, pad; };
enum { I_X = 0, I_F1N, I_F1WI, I_F1WO, I_MIXN, I_WIN, I_LBL, I_HON, I_CONVW, I_ALOG, I_DTB, I_GON, I_WBH, I_WBG, I_WOUT, I_F2N, I_F2WI, I_F2WO, I_FINN };

struct SchedStd {
    const char* A; const char* B; int lda, ldb, nt; pg8::Order O;
    DI bool next(int i, Unit& u) const { return O.next(i, u); }
    DI int ntu(const Unit&) const { return nt; }
    DI void ptrs(const Unit& u, const char*& a, const char*& b) const { a = A + (size_t)u.pm * 256 * lda * 2; b = B + (size_t)u.pn * 256 * ldb * 2; }
};
DI int g3_perm(int lp) {
    const int k = lp >> 3, t = lp & 7;
    if (t == 0 || t == 1 || t == 6) { const int i = 3 * k + (t == 6 ? 2 : t); return i < 8 ? i : i + 4; }
    const int i = 5 * k + (t == 7 ? 4 : t - 2); return i < 4 ? 8 + i : 12 + i;
}
struct SchedG3 {
    const char* A; const char* B; int lda, ldb, nt, j, pn0, perm; pg8::Order O;
    DI bool next(int i, Unit& u) const { return O.next(i, u); }
    DI int ntu(const Unit&) const { return nt; }
    DI void ptrs(const Unit& u, const char*& a, const char*& b) const {
        const size_t grow = (size_t)(u.pm >> 2) * 4096 + 1024 * j + (u.pm & 3) * 256;
        const int lp = pn0 + u.pn; a = A + grow * 1024 * 2; b = B + (size_t)(perm ? g3_perm(lp) : lp) * 256 * 1024 * 2; }
};
struct SchedG4 {
    const char* P; const char* L; const char* B; int lda, ldb, c;
    DI bool next(int i, Unit& u) const { if (c >= 192 || i >= 1) return false; const int tile = c / 3; u.pm = tile >> 2; u.pn = tile & 3; u.part = c - 3 * tile; return true; }
    DI int ntu(const Unit&) const { return 16; }
    DI void ptrs(const Unit& u, const char*& a, const char*& b) const {
        a = u.part == 0 ? P + ((size_t)u.pm * 256 * PLD + C_HG) * 2 : L + ((size_t)u.pm * 256 * LLD + L_GZ + 1024 * (u.part - 1)) * 2;
        b = B + ((size_t)u.pn * 256 * 3072 + (size_t)u.part * 1024) * 2; }
};

struct EpiSwiglu {
    static constexpr bool PERM = true;
    u16* H; const float* ss;
    DI bool operator()(Acc& acc, const Unit& u, int wr, int wc, int fr, int fq) const {
        const int row0 = u.pm * 256 + wr * 64 + fr, hc0 = u.pn * 128 + wc * 32 + 8 * fq;
#pragma unroll
        for (int ai = 0; ai < 2; ++ai)
#pragma unroll
            for (int m = 0; m < 4; ++m) { const int row = row0 + ai * 128 + m * 16; const float rs = rsqrtf(ss[row] * (1.0f / 1024.0f) + EPS);
                float h[8];
#pragma unroll
                for (int n = 0; n < 2; ++n)
#pragma unroll
                    for (int e = 0; e < 4; ++e) { const float a = acc[ai][0][m][n][e] * rs, b = acc[ai][1][m][n][e] * rs; h[4 * n + e] = a * sigm(a) * b; }
                u32x4 w; w.x = cvt_pk_bf16(h[0], h[1]); w.y = cvt_pk_bf16(h[2], h[3]); w.z = cvt_pk_bf16(h[4], h[5]); w.w = cvt_pk_bf16(h[6], h[7]);
                *(u32x4*)(H + (size_t)row * DFF + hc0) = w; asm volatile("" ::: "memory"); }
        return true;
    }
};
struct EpiResid {
    static constexpr bool PERM = false;
    const float* base; float* out; float scale; u16* xn; const float* g; float* ss_out; bool dry; float* dummy;
    DI bool operator()(Acc& acc, const Unit& u, int wr, int wc, int fr, int fq) const {
        const int row0 = u.pm * 256 + wr * 64 + fr, col0 = u.pn * 256 + wc * 32 + 4 * fq;
#pragma unroll
        for (int ai = 0; ai < 2; ++ai)
#pragma unroll
            for (int m = 0; m < 4; ++m) { const int row = row0 + ai * 128 + m * 16; const size_t off = (size_t)row * DM + col0; float q = 0.f;
#pragma unroll
                for (int bj = 0; bj < 2; ++bj)
#pragma unroll
                    for (int n = 0; n < 2; ++n) { const int co = bj * 128 + n * 16; const f32x4 bs = *(const f32x4*)(base + off + co); const f32x4 o = bs + acc[ai][bj][m][n] * scale;
                        *(f32x4*)(dry ? dummy + 4 * (fr + 16 * fq) : out + off + co) = o; q += (o[0] * o[0] + o[1] * o[1]) + (o[2] * o[2] + o[3] * o[3]);
                        if (xn) { const f32x4 gv = *(const f32x4*)(g + col0 + co); u32x2 w; w.x = cvt_pk_bf16(o[0] * gv[0], o[1] * gv[1]); w.y = cvt_pk_bf16(o[2] * gv[2], o[3] * gv[3]); *(u32x2*)(dry ? (u16*)dummy + 4 * (fr + 16 * fq) : xn + off + co) = w; }
                        asm volatile("" ::: "memory"); }
                q += __shfl_xor(q, 16); q += __shfl_xor(q, 32);
                if (fq == 0 && !dry) atomicAdd(ss_out + row, q); asm volatile("" ::: "memory"); }
        return true;
    }
};
struct EpiProj {
    static constexpr bool PERM = true;
    u16* P; u16* L; const float* ss; const float* lbl; u16* halo; int j, pn0, perm;
    DI bool operator()(Acc& acc, const Unit& u, int wr, int wc, int fr, int fq) const {
        const int b = u.pm >> 2, tl0 = (u.pm & 3) * 256 + wr * 64 + fr;
        const int pn = perm ? g3_perm(pn0 + u.pn) : pn0 + u.pn; const int kind = pn < 4 ? 0 : pn < 8 ? 1 : pn < 12 ? 2 : pn < 16 ? 3 : pn < 32 ? 4 : pn < 40 ? 5 : 6;
        float lb[2][8];
#pragma unroll
        for (int bj = 0; bj < 2; ++bj)
#pragma unroll
            for (int e = 0; e < 8; ++e) lb[bj][e] = 0.f;
        if (kind == 1) {
#pragma unroll
            for (int bj = 0; bj < 2; ++bj)
#pragma unroll
                for (int e = 0; e < 8; ++e) { const int c = pn * 256 - C_HF + bj * 128 + wc * 32 + 8 * fq + e; lb[bj][e] = __builtin_amdgcn_rcpf(1.0f + __expf(lbl[1024 + c] - lbl[c])); }
        }
        const float sc = kind == 0 ? 0.08838834764831845f : 1.0f;
#pragma unroll
        for (int ai = 0; ai < 2; ++ai)
#pragma unroll
            for (int m = 0; m < 4; ++m) { const int tl = tl0 + ai * 128 + m * 16; const int lr = b * 1024 + tl; const int gr = b * 4096 + 1024 * j + tl;
                const float rs = rsqrtf(ss[gr] * (1.0f / 1024.0f) + EPS);
#pragma unroll
                for (int bj = 0; bj < 2; ++bj) { const int col = pn * 256 + bj * 128 + wc * 32 + 8 * fq; float r[8];
#pragma unroll
                    for (int n = 0; n < 2; ++n)
#pragma unroll
                        for (int e = 0; e < 4; ++e) { const float v = acc[ai][bj][m][n][e] * rs; float o = v;
                            if (kind != 2 && kind != 4) { const float s = sigm(v);
                                if (kind == 0 || kind == 3 || kind == 5) o = v * s * sc;
                                else if (kind == 6) o = s;
                                else o = __logf(lb[bj][4 * n + e] + (1.0f - lb[bj][4 * n + e]) * s); }
                            r[4 * n + e] = o; }
                    u32x4 w;
                    if (kind == 1) { w.x = f2h(r[0]) | ((unsigned)f2h(r[1]) << 16); w.y = f2h(r[2]) | ((unsigned)f2h(r[3]) << 16); w.z = f2h(r[4]) | ((unsigned)f2h(r[5]) << 16); w.w = f2h(r[6]) | ((unsigned)f2h(r[7]) << 16); }
                    else { w.x = cvt_pk_bf16(r[0], r[1]); w.y = cvt_pk_bf16(r[2], r[3]); w.z = cvt_pk_bf16(r[4], r[5]); w.w = cvt_pk_bf16(r[6], r[7]); }
                    if (pn < 32) *(u32x4*)(P + (size_t)lr * PLD + col) = w; else *(u32x4*)(L + (size_t)lr * LLD + (col - 8192)) = w;
                    if (kind == 4 && (tl & 63) >= 61) { const int n_ch = (1024 * j + tl) >> 6; *(u32x4*)(halo + ((size_t)((b * 32 + (n_ch & 31)) * 3 + (tl & 63) - 61)) * 4096 + (col - C_GQ)) = w; } }
                asm volatile("" ::: "memory"); }
        return true;
    }
};
struct EpiG4 {
    static constexpr bool PERM = true;
    const u16* L; u16* Y; u16* TMP; unsigned* flags; int j;
    DI bool operator()(Acc& acc, const Unit& u, int wr, int wc, int fr, int fq) const {
        const int b = u.pm >> 2, tl0 = (u.pm & 3) * 256 + wr * 64 + fr, col0 = u.pn * 256 + wc * 32 + 8 * fq;
        unsigned* flag = flags + (j * 64 + u.pm * 4 + u.pn);
        int part = u.part; asm volatile("" : "+s"(part));
        if (part != 0) {
            u16* T = TMP + (size_t)(part - 1) * 4096 * DM;
#pragma unroll
            for (int ai = 0; ai < 2; ++ai)
#pragma unroll
                for (int m = 0; m < 4; ++m) { const int tl = tl0 + ai * 128 + m * 16; const int lr = b * 1024 + tl;
#pragma unroll
                    for (int bj = 0; bj < 2; ++bj) { const int col = col0 + bj * 128;
                        float gg[8]; unpack8(*(const u32x4*)(L + (size_t)lr * LLD + L_GG + col), gg); float y[8];
#pragma unroll
                        for (int n = 0; n < 2; ++n)
#pragma unroll
                            for (int e = 0; e < 4; ++e) y[4 * n + e] = acc[ai][bj][m][n][e] * gg[4 * n + e];
                        u32x4 w; w.x = cvt_pk_bf16(y[0], y[1]); w.y = cvt_pk_bf16(y[2], y[3]); w.z = cvt_pk_bf16(y[4], y[5]); w.w = cvt_pk_bf16(y[6], y[7]);
                        *(u32x4*)(T + (size_t)lr * DM + col) = w; }
                    asm volatile("" ::: "memory"); }
            asm volatile("s_waitcnt vmcnt(0)" ::: "memory");
            __syncthreads();
            if (threadIdx.x == 0) { __builtin_amdgcn_fence(__ATOMIC_RELEASE, "agent"); asm volatile("s_waitcnt vmcnt(0)" ::: "memory"); (void)__hip_atomic_fetch_add(flag, 1u, __ATOMIC_RELAXED, __HIP_MEMORY_SCOPE_AGENT); }
        } else {
            if (threadIdx.x == 0) { unsigned sp = 0;
                while (__hip_atomic_load(flag, __ATOMIC_RELAXED, __HIP_MEMORY_SCOPE_AGENT) < 2u) { __builtin_amdgcn_s_sleep(2); if (++sp > (1u << 22)) break; }
                __builtin_amdgcn_fence(__ATOMIC_ACQUIRE, "agent"); asm volatile("s_waitcnt vmcnt(0)" ::: "memory"); }
            __syncthreads();
#pragma unroll
            for (int ai = 0; ai < 2; ++ai)
#pragma unroll
                for (int m = 0; m < 4; ++m) { const int tl = tl0 + ai * 128 + m * 16; const int lr = b * 1024 + tl; const int gr = b * 4096 + 1024 * j + tl;
#pragma unroll
                    for (int bj = 0; bj < 2; ++bj) { const int col = col0 + bj * 128;
                        float gh[8], t1[8], t2[8]; unpack8(*(const u32x4*)(L + (size_t)lr * LLD + L_GH + col), gh);
                        unpack8(*(const u32x4*)(TMP + (size_t)lr * DM + col), t1); unpack8(*(const u32x4*)(TMP + (size_t)4096 * DM + (size_t)lr * DM + col), t2); float y[8];
#pragma unroll
                        for (int n = 0; n < 2; ++n)
#pragma unroll
                            for (int e = 0; e < 4; ++e) y[4 * n + e] = acc[ai][bj][m][n][e] * gh[4 * n + e] + (t1[4 * n + e] + t2[4 * n + e]);
                        u32x4 w; w.x = cvt_pk_bf16(y[0], y[1]); w.y = cvt_pk_bf16(y[2], y[3]); w.z = cvt_pk_bf16(y[4], y[5]); w.w = cvt_pk_bf16(y[6], y[7]);
                        *(u32x4*)(Y + (size_t)gr * DM + col) = w; }
                    asm volatile("" ::: "memory"); }
        }
        return true;
    }
};

DI void transpose_item(const float* W, int N, u16* WT, int ldd, int koff, LAS float* scr, int kb, int nb, int lane, int mode) {
    const int k0 = 64 * kb, n0 = 32 * nb;
#pragma unroll 8
    for (int i = 0; i < 32; ++i) { const int kk = 2 * i + (lane >> 5); scr[kk * 33 + (lane & 31)] = W[(size_t)(k0 + kk) * N + n0 + (lane & 31)]; }
    asm volatile("s_waitcnt lgkmcnt(0)" ::: "memory");
    const int c = lane & 7;
#pragma unroll
    for (int jj = 0; jj < 4; ++jj) { const int n = (lane >> 3) + 8 * jj; const int cn = n0 + n; int dr = cn;
        if (mode == 1) { if (cn < DFF) dr = 256 * (cn >> 7) + (cn & 127); else { const int q = cn - DFF; dr = 256 * (q >> 7) + 128 + (q & 127); } }
        if (mode == 2) { if (cn >= 8224) dr = cn - 32; }
        const LAS float* s = scr + (8 * c) * 33 + n;
        u32x4 o; o.x = pk2(s[0 * 33], s[1 * 33]); o.y = pk2(s[2 * 33], s[3 * 33]); o.z = pk2(s[4 * 33], s[5 * 33]); o.w = pk2(s[6 * 33], s[7 * 33]);
        *(u32x4*)(WT + (size_t)dr * ldd + koff + k0 + 8 * c) = o; }
    asm volatile("s_waitcnt lgkmcnt(0)" ::: "memory");
}
DI void convert_weight(const float* W, int K, int N, u16* WT, int ldd, int koff, int mode, LAS float* scr, int gw, int ngw, int lane) {
    const int nblk = N / 32, nitems = (K / 64) * nblk;
    for (int it = gw; it < nitems; it += ngw) { const int kb = it / nblk, nb = it % nblk; if (mode == 2 && nb == 256) continue; transpose_item(W, N, WT, ldd, koff, scr, kb, nb, lane, mode); }
}

DI void gab_item(LAS unsigned char* lds, const KArgs& a, int gr0) {
    int tid_ = threadIdx.x; asm volatile("" : "+v"(tid_));
    const int tid = tid_, lane = tid & 63, wid = tid >> 6, lj = lane & 15, g = lane >> 4;
    unsigned char* ws = a.ws; const u16* XN = (const u16*)(ws + WS_XN); const u16* WAB = (const u16*)(ws + WS_WAB); const float* ss2 = (const float*)(ws + WS_SS) + T_TOK;
    LAS float* red = (LAS float*)lds;
    f32x4 acc[2][4];
#pragma unroll
    for (int nt = 0; nt < 2; ++nt)
#pragma unroll
        for (int mt = 0; mt < 4; ++mt) acc[nt][mt] = (f32x4){0.f, 0.f, 0.f, 0.f};
#pragma unroll
    for (int q = 0; q < 4; ++q) { const int kk = 4 * wid + q; bf16x8 bfr[2], afr[4];
#pragma unroll
        for (int nt = 0; nt < 2; ++nt) bfr[nt] = *(const bf16x8*)(WAB + (size_t)(16 * nt + lj) * 1024 + 32 * kk + 8 * g);
#pragma unroll
        for (int mt = 0; mt < 4; ++mt) afr[mt] = *(const bf16x8*)(XN + (size_t)(gr0 + 16 * mt + lj) * 1024 + 32 * kk + 8 * g);
#pragma unroll
        for (int nt = 0; nt < 2; ++nt)
#pragma unroll
            for (int mt = 0; mt < 4; ++mt) acc[nt][mt] = MFMA16(afr[mt], bfr[nt], acc[nt][mt]); }
#pragma unroll
    for (int nt = 0; nt < 2; ++nt)
#pragma unroll
        for (int mt = 0; mt < 4; ++mt)
#pragma unroll
            for (int r = 0; r < 4; ++r) red[(wid * 64 + 16 * mt + 4 * g + r) * 32 + 16 * nt + lj] = acc[nt][mt][r];
    lbar();
#pragma unroll
    for (int q = 0; q < 4; ++q) { const int idx = tid + 512 * q, tok = idx >> 5, col = idx & 31; float sum = 0.f;
#pragma unroll
        for (int w2 = 0; w2 < 8; ++w2) sum += red[(w2 * 64 + tok) * 32 + col];
        sum *= rsqrtf(ss2[gr0 + tok] * (1.0f / 1024.0f) + EPS);
        if (col < 16) { const float xx = sum + a.in[I_DTB][col]; const float sp = xx > 20.f ? xx : log1pf(__expf(xx)); ((float*)(ws + WS_GBG))[(size_t)(gr0 + tok) * 16 + col] = -__expf(a.in[I_ALOG][col]) * sp; }
        else ((float*)(ws + WS_GBB))[(size_t)(gr0 + tok) * 16 + col - 16] = sigm(sum); }
    lbar();
}
DI int swt(int v) { return ((v >> 3) ^ v) & 7; }
DI int swz(int v, int s) { return v * 64 + ((((s >> 3) ^ swt(v)) & 7) << 3) + (s & 7); }
DI void prep_gdn(LAS unsigned char* lds, const KArgs& a, int j, int b, int nl, int hq, bool dry) {
    int tid_ = threadIdx.x; asm volatile("" : "+v"(tid_));
    const int tid = tid_, lane = tid & 63, wid = tid >> 6, lj = lane & 15, g = lane >> 4;
    unsigned char* ws = a.ws;
    u16* P = (u16*)(ws + WS_PROJ); u16* Pw = dry ? (u16*)(ws + WS_DUMMY) : P; const u16* XN = (const u16*)(ws + WS_XN); const u16* halo = (const u16*)(ws + WS_HALO); const float* ss2 = (const float*)(ws + WS_SS) + T_TOK;
    const int n = 16 * j + nl, lr0 = b * 1024 + 64 * nl, gr0 = b * 4096 + 64 * n;
    LAS u16* QGs = (LAS u16*)lds;
    LAS u16* KGs = QGs + 64 * 136;
    LAS u16* VBT = KGs + 64 * 136;
    LAS u16* KBT = VBT + 2 * 128 * 64;
    LAS float* AM = (LAS float*)(KBT + 2 * 128 * 64);
    LAS u16* TM = (LAS u16*)(AM + 2 * 64 * 68);
    LAS float* gms = (LAS float*)(TM + 2 * 64 * 72);
    const bool sk1 = dry && (a.probe & 0x10000), sk2 = dry && (a.probe & 0x20000), sk3 = dry && (a.probe & 0x40000), sk4 = dry && (a.probe & 0x80000), sk5 = dry && (a.probe & 0x100000);
    const int mat = tid >> 7, tg = (tid >> 4) & 7, c8 = tid & 15, t0 = 8 * tg;
    const int cb = mat == 0 ? C_GQ + 128 * hq : (mat == 1 ? C_GK + 128 * hq : C_GV + 128 * (2 * hq + mat - 2));
    const int wcol = cb - C_GQ + 8 * c8;
    u32x4 raw[11];
#pragma unroll
    for (int rr = 0; rr < 11; ++rr) { const int tt = t0 - 3 + rr; raw[rr] = (u32x4){0u, 0u, 0u, 0u};
        if (tt >= 0) raw[rr] = *(const u32x4*)(P + (size_t)(lr0 + tt) * PLD + cb + 8 * c8);
        else if (n > 0) raw[rr] = *(const u32x4*)(halo + ((size_t)((b * 32 + ((n - 1) & 31)) * 3 + (3 + tt))) * 4096 + wcol); }
    float w[4][8];
#pragma unroll
    for (int jj = 0; jj < 4; ++jj) { const f32x4 w0 = *(const f32x4*)(a.in[I_CONVW] + jj * 4096 + wcol), w1 = *(const f32x4*)(a.in[I_CONVW] + jj * 4096 + wcol + 4);
#pragma unroll
        for (int e = 0; e < 4; ++e) { w[jj][e] = w0[e]; w[jj][4 + e] = w1[e]; } }
    if (tid < 128) { const int e = tid >> 6, tok = tid & 63;
        gms[e * 64 + tok] = ((const float*)(ws + WS_GBG))[(size_t)(gr0 + tok) * 16 + 2 * hq + e]; gms[128 + e * 64 + tok] = ((const float*)(ws + WS_GBB))[(size_t)(gr0 + tok) * 16 + 2 * hq + e]; }
    lbar();
    if (wid < 2) { float v = gms[wid * 64 + lane];
#pragma unroll
        for (int o = 1; o < 64; o <<= 1) { const float t = __shfl_up(v, o); if (lane >= o) v += t; }
        gms[wid * 64 + lane] = v; }
    lbar();
    if (!sk2) {
        float y[8][8];
#pragma unroll
        for (int i = 0; i < 8; ++i)
#pragma unroll
            for (int e = 0; e < 8; ++e) y[i][e] = 0.f;
#pragma unroll
        for (int rr = 0; rr < 11; ++rr) { float x[8]; unpack8(raw[rr], x);
#pragma unroll
            for (int jj = 0; jj < 4; ++jj) { const int i = rr - jj; if (i >= 0 && i < 8) {
#pragma unroll
                for (int e = 0; e < 8; ++e) y[i][e] += w[jj][e] * x[e]; } } }
#pragma unroll
        for (int i = 0; i < 8; ++i) {
#pragma unroll
            for (int e = 0; e < 8; ++e) y[i][e] = y[i][e] * sigm(y[i][e]);
            if (mat < 2) { float q = 0.f;
#pragma unroll
                for (int e = 0; e < 8; ++e) q += y[i][e] * y[i][e];
                q = row16_sum(q);
                const float sc = rsqrtf(q + EPS) * (mat == 0 ? 0.08838834764831845f : 1.0f);
#pragma unroll
                for (int e = 0; e < 8; ++e) y[i][e] *= sc;
                *(LAS u32x4*)((mat == 0 ? QGs : KGs) + (t0 + i) * 136 + 8 * c8) = pack8(y[i]); } }
        if (mat >= 1) {
#pragma unroll
            for (int ee = 0; ee < 2; ++ee) { if (mat == 1 || mat - 2 == ee) {
                float f[8];
#pragma unroll
                for (int i = 0; i < 8; ++i) f[i] = gms[128 + ee * 64 + t0 + i] * (mat == 1 ? __expf(gms[ee * 64 + t0 + i]) : 1.0f);
                LAS u16* dst = (mat == 1 ? KBT : VBT) + ee * 8192;
#pragma unroll
                for (int e = 0; e < 8; ++e) { const int v = 8 * c8 + e; float col[8];
#pragma unroll
                    for (int i = 0; i < 8; ++i) col[i] = y[i][e] * f[i];
                    *(LAS u32x4*)(dst + v * 64 + (((tg ^ swt(v)) & 7) << 3)) = pack8(col); } } }
        }
    }
    lbar();
    const int cv0 = ((b * 16 + nl) * 16 + 2 * hq);
    u16* QKo = (u16*)(ws + WS_QK); u16* WMo = (u16*)(ws + WS_WM); float* GAMo = (float*)(ws + WS_GAM);
#pragma unroll
    for (int x = 0; x < 2; ++x) { if (sk3) break; const int tt = 2 * wid + x, mi = tt >> 2, ni = tt & 3;
        f32x4 kk = (f32x4){0.f, 0.f, 0.f, 0.f}, qk = (f32x4){0.f, 0.f, 0.f, 0.f};
#pragma unroll
        for (int ks = 0; ks < 4; ++ks) { const bf16x8 ka = fragN(KGs, 16 * mi + lj, 32 * ks, g, 136), kb2 = fragN(KGs, 16 * ni + lj, 32 * ks, g, 136), qb = fragN(QGs, 16 * ni + lj, 32 * ks, g, 136);
            kk = MFMA16(ka, kb2, kk); qk = MFMA16(ka, qb, qk); }
#pragma unroll
        for (int e = 0; e < 2; ++e) {
#pragma unroll
            for (int r = 0; r < 4; ++r) { const int t = 16 * mi + 4 * g + r, s = 16 * ni + lj;
                AM[e * 4352 + t * 68 + s] = (s < t) ? kk[r] * gms[128 + e * 64 + t] * __expf(gms[e * 64 + t] - gms[e * 64 + s]) : 0.f; }
            const int t = 16 * ni + lj; float o4[4];
#pragma unroll
            for (int r = 0; r < 4; ++r) { const int s = 16 * mi + 4 * g + r; o4[r] = (s <= t) ? qk[r] * __expf(gms[e * 64 + t] - gms[e * 64 + s]) : 0.f; }
            u32x2 w; w.x = pk2(o4[0], o4[1]); w.y = pk2(o4[2], o4[3]);
            *(LAS u32x2*)(TM + e * 4608 + t * 72 + 16 * mi + 4 * g) = w; } }
    lbar();
#pragma unroll
    for (int q = 0; q < 2; ++q) { const int pid = tid + 512 * q, e = pid >> 9, row = (pid >> 3) & 63, c = pid & 7;
        *(u32x4*)(QKo + (size_t)(cv0 + e) * 4096 + row * 64 + 8 * c) = *(const LAS u32x4*)(TM + e * 4608 + row * 72 + 8 * c); }
    lbar();
    if (wid < 2 && !sk4) { const LAS float* Ae = AM + wid * 4352; float Tc[64];
        f32x4 an[16], ac[16];
        Tc[0] = (lane == 0) ? 1.f : 0.f;
        an[0] = *(const LAS f32x4*)(Ae + 68);
#pragma unroll
        for (int i = 1; i < 64; ++i) {
#pragma unroll
            for (int q = 0; q < (i + 3) / 4; ++q) ac[q] = an[q];
            if (i + 1 < 64) {
#pragma unroll
                for (int q = 0; q < (i + 4) / 4; ++q) an[q] = *(const LAS f32x4*)(Ae + (i + 1) * 68 + 4 * q); }
            __builtin_amdgcn_sched_barrier(0);
            float s0 = (i == lane) ? 1.f : 0.f, s1 = 0.f;
#pragma unroll
            for (int jj = 0; jj < i; ++jj) { if (jj & 1) s1 -= ac[jj >> 2][jj & 3] * Tc[jj]; else s0 -= ac[jj >> 2][jj & 3] * Tc[jj]; }
            Tc[i] = s0 + s1;
            __builtin_amdgcn_sched_barrier(0);
        }
#pragma unroll
        for (int i = 0; i < 64; ++i) TM[wid * 4608 + i * 72 + lane] = (u16)f2bf(Tc[i]);
    } else if (wid >= 2) { const int t2 = tid - 128;
        for (int pid = t2; pid < 1024; pid += 384) { const int row = pid >> 4, c = pid & 15; *(u32x4*)(Pw + widx(dry, tid, (size_t)(lr0 + row) * PLD + C_GQ + 128 * hq + 8 * c)) = *(const LAS u32x4*)(QGs + row * 136 + 8 * c); }
        for (int pid = t2; pid < 1024; pid += 384) { const int k = pid >> 3, c = pid & 7; float v[8];
#pragma unroll
            for (int e = 0; e < 8; ++e) v[e] = bf2f(KGs[(8 * c + e) * 136 + k]);
            *(u32x4*)(Pw + widx(dry, tid, (size_t)(lr0 + (k >> 1)) * PLD + C_GK + 128 * hq + 64 * (k & 1) + 8 * c)) = pack8(v); }
        if (t2 < 128) GAMo[(size_t)(cv0 + (t2 >> 6)) * 64 + (t2 & 63)] = gms[t2];
    }
    lbar();
    LAS u16* WMst = QGs;
    LAS u16* UTst = (LAS u16*)AM;
    if (!sk5) { const int e = wid >> 2, q = wid & 3; const LAS u16* Te = TM + e * 4608;
        bf16x8 ta[2];
#pragma unroll
        for (int ks = 0; ks < 2; ++ks) ta[ks] = fragN(Te, 16 * q + lj, 32 * ks, g, 72);
#pragma unroll
        for (int vt = 0; vt < 8; ++vt) { const int v = 16 * vt + lj; f32x4 c = (f32x4){0.f, 0.f, 0.f, 0.f};
#pragma unroll
            for (int ks = 0; ks < 2; ++ks) c = MFMA16(ta[ks], *(const LAS bf16x8*)(VBT + e * 8192 + v * 64 + ((((4 * ks + g) ^ swt(v)) & 7) << 3)), c);
            const int t = 16 * q + 4 * g; u32x2 w; w.x = pk2(c[0], c[1]); w.y = pk2(c[2], c[3]);
            *(LAS u32x2*)(UTst + e * 8192 + v * 64 + t) = w; }
        bf16x8 tb[4][2];
#pragma unroll
        for (int tt = 0; tt < 4; ++tt)
#pragma unroll
            for (int ks = 0; ks < 2; ++ks) tb[tt][ks] = fragN(Te, 16 * tt + lj, 32 * ks, g, 72);
#pragma unroll
        for (int k2 = 0; k2 < 2; ++k2) { const int kt = 2 * q + k2, k = 16 * kt + lj; bf16x8 ka[2];
#pragma unroll
            for (int ks = 0; ks < 2; ++ks) ka[ks] = *(const LAS bf16x8*)(KBT + e * 8192 + k * 64 + ((((4 * ks + g) ^ swt(k)) & 7) << 3));
#pragma unroll
            for (int tt = 0; tt < 4; ++tt) { f32x4 c = (f32x4){0.f, 0.f, 0.f, 0.f};
#pragma unroll
                for (int ks = 0; ks < 2; ++ks) c = MFMA16(ka[ks], tb[tt][ks], c);
                const int t = 16 * tt + lj, kk = 16 * kt + 4 * g; u32x2 w; w.x = pk2(c[0], c[1]); w.y = pk2(c[2], c[3]);
                *(LAS u32x2*)(WMst + e * 8704 + t * 136 + kk) = w; } }
    }
    lbar();
#pragma unroll
    for (int q = 0; q < 4; ++q) { const int pid = tid + 512 * q, e = pid >> 10, r10 = pid & 1023;
        { const int v = r10 >> 3, c = r10 & 7; *(u32x4*)(Pw + widx(dry, tid, (size_t)(lr0 + (v >> 1)) * PLD + C_GV + 128 * (2 * hq + e) + 64 * (v & 1) + 8 * c)) = *(const LAS u32x4*)(UTst + e * 8192 + v * 64 + 8 * c); }
        { const int t = r10 >> 4, c = r10 & 15; *(u32x4*)(WMo + (size_t)(cv0 + e) * 8192 + t * 128 + 8 * c) = *(const LAS u32x4*)(WMst + e * 8704 + t * 136 + 8 * c); } }
    lbar();
}

DI void prep_hgrn(LAS unsigned char* lds, const KArgs& a, int b, int nl, int hi_, bool dry) {
    int tid_ = threadIdx.x; asm volatile("" : "+v"(tid_));
    const int tid = tid_, lane = tid & 63, wid = tid >> 6, lj = lane & 15, g = lane >> 4;
    unsigned char* ws = a.ws; u16* P = (u16*)(ws + WS_PROJ); u16* Pw = dry ? (u16*)(ws + WS_DUMMY) : P;
    const int lr0 = b * 1024 + 64 * nl; const int item = (b * 16 + nl) * 8 + hi_;
    LAS float* segs = (LAS float*)lds;
    LAS u16* Qs = (LAS u16*)(segs + 512);
    LAS u16* Ks = Qs + 64 * 136;
    const int k = tid & 127, seg = tid >> 7;
    float q[16], lf[16], vv[16];
#pragma unroll
    for (int r = 0; r < 16; ++r) { const size_t ro = (size_t)(lr0 + 16 * seg + r) * PLD + 128 * hi_ + k;
        q[r] = bf2f(P[ro + C_HQ]); lf[r] = h2f(P[ro + C_HF]); vv[r] = bf2f(P[ro + C_HI]); }
    float cs[16]; { float s = 0.f;
#pragma unroll
        for (int r = 0; r < 16; ++r) { s += lf[r]; cs[r] = s; } }
    segs[seg * 128 + k] = cs[15];
    asm volatile("s_waitcnt vmcnt(0)" ::: "memory"); lbar();
    const float s0 = segs[k], s1 = segs[128 + k], s2 = segs[256 + k], s3 = segs[384 + k];
    const float pre = seg == 0 ? 0.f : (seg == 1 ? s0 : (seg == 2 ? s0 + s1 : s0 + s1 + s2));
    const float bmid = s0 + s1, bend = s0 + s1 + s2 + s3;
    float ke[16], qe[16];
#pragma unroll
    for (int r = 0; r < 16; ++r) { const float bb = pre + cs[r]; const float kh = -expm1f(lf[r]); const int t = 16 * seg + r;
        qe[r] = q[r] * __expf(bb); ke[r] = kh * __expf(bend - bb);
        Qs[t * 136 + k] = (u16)f2bf(q[r] * __expf(bb - bmid)); Ks[t * 136 + k] = (u16)f2bf(kh * __expf(bmid - bb)); }
#pragma unroll
    for (int r = 0; r < 16; ++r) Pw[widx(dry, tid, (size_t)(lr0 + 16 * seg + r) * PLD + C_HQ + 128 * hi_ + k)] = (u16)f2bf(qe[r]);
    { u16* kd = Pw + widx(dry, 2 * tid, (size_t)(lr0 + (k >> 1)) * PLD + C_HF + 128 * hi_ + 64 * (k & 1) + 16 * seg); u16* vd = Pw + widx(dry, 2 * tid, (size_t)(lr0 + (k >> 1)) * PLD + C_HI + 128 * hi_ + 64 * (k & 1) + 16 * seg);
        float t8[8];
#pragma unroll
        for (int h = 0; h < 2; ++h) {
#pragma unroll
            for (int e = 0; e < 8; ++e) t8[e] = ke[8 * h + e];
            *(u32x4*)(kd + 8 * h) = pack8(t8);
#pragma unroll
            for (int e = 0; e < 8; ++e) t8[e] = vv[8 * h + e];
            *(u32x4*)(vd + 8 * h) = pack8(t8); } }
    if (seg == 0) ((float*)(ws + WS_DEC))[(size_t)item * 128 + k] = __expf(bend);
    lbar();
    u16* SCo = (u16*)(ws + WS_SC) + (size_t)item * 4096;
#pragma unroll 1
    for (int x = 0; x < 2; ++x) { const int tt = 2 * wid + x, mi = tt >> 2, ni = tt & 3; f32x4 c = (f32x4){0.f, 0.f, 0.f, 0.f};
        if (mi <= ni) {
#pragma unroll
            for (int ks = 0; ks < 4; ++ks) c = MFMA16(fragN(Ks, 16 * mi + lj, 32 * ks, g, 136), fragN(Qs, 16 * ni + lj, 32 * ks, g, 136), c); }
        const int t = 16 * ni + lj; float o4[4];
#pragma unroll
        for (int r = 0; r < 4; ++r) { const int s = 16 * mi + 4 * g + r; o4[r] = (s <= t) ? c[r] : 0.f; }
        u32x2 w; w.x = pk2(o4[0], o4[1]); w.y = pk2(o4[2], o4[3]);
        *(u32x2*)(SCo + t * 64 + 16 * mi + 4 * g) = w; }
    lbar();
}

DI void norm_accum(const f32x4 (&o)[4], LAS float* tot, int lj, int g) {
#pragma unroll
    for (int mt = 0; mt < 4; ++mt) { f32x4 q = o[mt] * o[mt];
        q[0] = row16_sum(q[0]); q[1] = row16_sum(q[1]); q[2] = row16_sum(q[2]); q[3] = row16_sum(q[3]);
        if (lj == 0) {
#pragma unroll
            for (int r = 0; r < 4; ++r) (void)__hip_atomic_fetch_add(tot + 16 * mt + 4 * g + r, q[r], __ATOMIC_RELAXED, __HIP_MEMORY_SCOPE_WORKGROUP); } }
}
DI void norm_finish(const f32x4 (&o)[4], const LAS float* tot, LAS u16* GT, float gnv, u16* gdst  , int pitch, bool dry, u16* sink, int w, int lane, int lj, int g) {
#pragma unroll
    for (int mt = 0; mt < 4; ++mt) { const f32x4 tt = *(const LAS f32x4*)(tot + 16 * mt + 4 * g);
#pragma unroll
        for (int r = 0; r < 4; ++r) { LAS u16* gp = GT + (16 * mt + 4 * g + r) * 136 + 16 * w + lj; *gp = (u16)pk2(o[mt][r] * rsqrtf(tt[r] * (1.0f / 128.0f) + EPS) * gnv * bf2f(*gp), 0.f); } }
    asm volatile("s_waitcnt lgkmcnt(0)" ::: "memory");
#pragma unroll
    for (int q = 0; q < 2; ++q) { const int p = lane + 64 * q, row = p >> 1, hf = p & 1; const u32x4 v = *(const LAS u32x4*)(GT + row * 136 + 16 * w + 8 * hf);
        *(u32x4*)(dry ? sink : gdst + (size_t)row * pitch + 16 * w + 8 * hf) = v; }
}

DI void recur_gdn(LAS unsigned char* lds, const KArgs& a, int j, int b, int vh, bool dry) {
    int tid_ = threadIdx.x; asm volatile("" : "+v"(tid_));
    const int tid = tid_, lane = tid & 63, w = tid >> 6, lj = lane & 15, g = lane >> 4;
    unsigned char* ws = a.ws; u16* P = (u16*)(ws + WS_PROJ); u16* LT = (u16*)(ws + WS_LATE) + (size_t)(j & 1) * 4096 * LLD;
    LAS u16* QG = (LAS u16*)lds;
    LAS u16* WMs = QG + 64 * 136;
    LAS u16* KT = WMs + 64 * 136;
    LAS u16* UT = KT + 128 * 72;
    LAS u16* QKs = UT + 128 * 72;
    LAS float* gam = (LAS float*)(QKs + 64 * 72);
    LAS float* tot = gam + 192;
    LAS u16* GT = (LAS u16*)(tot + 128);
    const int hq = vh >> 1; const int chain = b * 16 + vh;
    float* ST = (float*)(ws + WS_STATE) + (size_t)chain * 16384;
    u16* sink = (u16*)(ws + WS_DUMMY) + 8 * tid;
    f32x4 S[8];
#pragma unroll
    for (int m = 0; m < 8; ++m) S[m] = (j == 0) ? (f32x4){0.f, 0.f, 0.f, 0.f} : *(const f32x4*)(ST + ((w * 8 + m) * 64 + lane) * 4);
    u32x4 R[11]; float Rg = 0.f;
    unsigned oA[2], oT[2], oS[2];
#pragma unroll
    for (int q = 0; q < 2; ++q) { const int pid = tid + 512 * q; oA[q] = (unsigned)((pid >> 4) * PLD + 8 * (pid & 15)) * 2u; const int x = pid >> 3, c = pid & 7; oT[q] = (unsigned)((x >> 1) * PLD + 64 * (x & 1) + 8 * c) * 2u;
        const int p = lane + 64 * q; oS[q] = (unsigned)((p >> 1) * LLD + 16 * w + 8 * (p & 1)) * 2u; }
    auto load_chunk = [&](int nl) {
        const int lr0 = b * 1024 + 64 * nl; const size_t cv = (size_t)((b * 16 + nl) * 16 + vh);
        const char* wm = (const char*)(ws + WS_WM) + cv * 16384; const char* qk = (const char*)(ws + WS_QK) + cv * 8192;
        const char* pq = (const char*)(P + (size_t)lr0 * PLD + C_GQ + 128 * hq); const char* pk = (const char*)(P + (size_t)lr0 * PLD + C_GK + 128 * hq);
        const char* pv = (const char*)(P + (size_t)lr0 * PLD + C_GV + 128 * vh); const char* pg = (const char*)(LT + (size_t)lr0 * LLD + L_GZ + 128 * vh);
#pragma unroll
        for (int q = 0; q < 2; ++q) { R[q] = *(const u32x4*)(pq + oA[q]); R[2 + q] = *(const u32x4*)(wm + (unsigned)(tid + 512 * q) * 16u); R[4 + q] = *(const u32x4*)(pk + oT[q]); R[6 + q] = *(const u32x4*)(pv + oT[q]); R[9 + q] = *(const u32x4*)(pg + oS[q]); }
        R[8] = *(const u32x4*)(qk + (unsigned)tid * 16u);
        if (tid < 64) Rg = ((const float*)(ws + WS_GAM))[cv * 64 + tid];
    };
    auto store_chunk = [&]() {
#pragma unroll
        for (int q = 0; q < 2; ++q) { const int pid = tid + 512 * q; st_perm(QG + (pid >> 4) * 136, pid & 15, R[q]); st_perm(WMs + (pid >> 4) * 136, pid & 15, R[2 + q]);
            st_perm(KT + (pid >> 3) * 72, pid & 7, R[4 + q]); *(LAS u32x4*)(UT + (pid >> 3) * 72 + 8 * (pid & 7)) = R[6 + q]; }
        st_perm(QKs + (tid >> 3) * 72, tid & 7, R[8]);
#pragma unroll
        for (int q = 0; q < 2; ++q) { const int p = lane + 64 * q; *(LAS u32x4*)(GT + (p >> 1) * 136 + 16 * w + 8 * (p & 1)) = R[9 + q]; }
        if (tid < 64) { const float ge = __shfl(Rg, 63); gam[tid] = __expf(Rg); gam[64 + tid] = __expf(ge - Rg); if (tid == 63) gam[128] = __expf(ge); }
    };
    const float gnv = a.in[I_GON][16 * w + lj];
    load_chunk(0);
    if (tid < 128) tot[tid] = 0.f;
    store_chunk();
#pragma unroll 1
    for (int nl = 0; nl < 16; ++nl) {
        lbar();
        if (nl + 1 < 16) load_chunk(nl + 1);
        f32x4 vn[4], o[4];
        bf16x8 Sb[4];
#pragma unroll
        for (int kk = 0; kk < 4; ++kk) Sb[kk] = packacc(S[2 * kk], S[2 * kk + 1]);
        bf16x8 fa[3][4];
#define SBAR __builtin_amdgcn_sched_barrier(0)
#define LD_A(bf, M, mt, st) do { _Pragma("unroll") for (int kk = 0; kk < 4; ++kk) fa[bf][kk] = fragN(M, 16 * (mt) + lj, 32 * kk, g, st); } while (0)
#define LD_B(bf, M, m0) do { _Pragma("unroll") for (int m2 = 0; m2 < 2; ++m2) _Pragma("unroll") for (int tk = 0; tk < 2; ++tk) fa[bf][2 * m2 + tk] = fragN(M, 16 * ((m0) + m2) + lj, 32 * tk, g, 72); } while (0)
#define MF_W(bf, mt) do { f32x4 c = (f32x4){0.f, 0.f, 0.f, 0.f}; _Pragma("unroll") for (int kk = 0; kk < 4; ++kk) c = MFMA16(fa[bf][kk], Sb[kk], c); vn[mt] = c; } while (0)
#define MF_Q(bf, mt) do { f32x4 c2 = (f32x4){0.f, 0.f, 0.f, 0.f}; _Pragma("unroll") for (int kk = 0; kk < 4; ++kk) c2 = MFMA16(fa[bf][kk], Sb[kk], c2); \
            o[mt] = c2; } while (0)
#define MF_QK(bf, m0) do { _Pragma("unroll") for (int m2 = 0; m2 < 2; ++m2) { f32x4 c = (f32x4){0.f, 0.f, 0.f, 0.f}; _Pragma("unroll") for (int tk = 0; tk < 2; ++tk) c = MFMA16(fa[bf][2 * m2 + tk], vb[tk], c); dq[(m0) + m2] = c; } } while (0)
#define MF_KT(bf, m0) do { _Pragma("unroll") for (int m2 = 0; m2 < 2; ++m2) { f32x4 c = S[(m0) + m2] * eG; _Pragma("unroll") for (int tk = 0; tk < 2; ++tk) c = MFMA16(fa[bf][2 * m2 + tk], vsb[tk], c); S[(m0) + m2] = c; } } while (0)
        LD_A(0, WMs, 0, 136); LD_A(1, QG, 0, 136); SBAR;
        LD_A(2, WMs, 1, 136); SBAR; MF_W(0, 0); SBAR;
        LD_A(0, QG, 1, 136); SBAR; MF_Q(1, 0); SBAR;
        LD_A(1, WMs, 2, 136); SBAR; MF_W(2, 1); SBAR;
        LD_A(2, QG, 2, 136); SBAR; MF_Q(0, 1); SBAR;
        LD_A(0, WMs, 3, 136); SBAR; MF_W(1, 2); SBAR;
        LD_A(1, QG, 3, 136); SBAR; MF_Q(2, 2); SBAR;
        LD_B(2, QKs, 0); SBAR; MF_W(0, 3); SBAR;
        LD_B(0, QKs, 2); SBAR; MF_Q(1, 3); SBAR;
        bf16x8 vb[2], vsb[2]; f32x4 dq[4]; float eG;
        { u32x2 uw[4]; f32x4 es[4];
#pragma unroll
            for (int mt = 0; mt < 4; ++mt) { uw[mt] = *(const LAS u32x2*)(UT + (16 * w + lj) * 72 + 16 * mt + 4 * g); es[mt] = *(const LAS f32x4*)(gam + 64 + 16 * mt + 4 * g); }
            eG = gam[128];
            SBAR;
#pragma unroll
            for (int mt = 0; mt < 4; ++mt) { vn[mt][0] = bf2f(uw[mt].x & 0xffffu) - vn[mt][0]; vn[mt][1] = bf2f(uw[mt].x >> 16) - vn[mt][1]; vn[mt][2] = bf2f(uw[mt].y & 0xffffu) - vn[mt][2]; vn[mt][3] = bf2f(uw[mt].y >> 16) - vn[mt][3]; }
#pragma unroll
            for (int tk = 0; tk < 2; ++tk) { vb[tk] = packacc(vn[2 * tk], vn[2 * tk + 1]); vsb[tk] = packacc(vn[2 * tk] * es[2 * tk], vn[2 * tk + 1] * es[2 * tk + 1]); } }
        SBAR;
        LD_B(1, KT, 0); SBAR; MF_QK(2, 0); SBAR;
        LD_B(2, KT, 2); SBAR; MF_QK(0, 2); SBAR;
        LD_B(0, KT, 4); SBAR; MF_KT(1, 0); SBAR;
        LD_B(1, KT, 6); SBAR; MF_KT(2, 2); SBAR;
        MF_KT(0, 4); SBAR; MF_KT(1, 6); SBAR;
#undef LD_A
#undef LD_B
#undef MF_W
#undef MF_Q
#undef MF_QK
#undef MF_KT
#pragma unroll
        for (int mt = 0; mt < 4; ++mt) o[mt] = o[mt] * *(const LAS f32x4*)(gam + 16 * mt + 4 * g) + dq[mt];
        LAS float* tc = tot + 64 * (nl & 1);
        norm_accum(o, tc, lj, g);
        lbar();
        norm_finish(o, tc, GT, gnv, LT + (size_t)(b * 1024 + 64 * nl) * LLD + L_GZ + 128 * vh, LLD, dry, sink, w, lane, lj, g);
        if (tid < 64) tot[64 * ((nl + 1) & 1) + tid] = 0.f;
        if (nl + 1 < 16) store_chunk();
    }
#pragma unroll
    for (int m = 0; m < 8; ++m) *(f32x4*)(ST + ((w * 8 + m) * 64 + lane) * 4) = S[m];
    lbar();
}

DI void recur_hgrn(LAS unsigned char* lds, const KArgs& a, int j, int b, int hi_, bool dry) {
    int tid_ = threadIdx.x; asm volatile("" : "+v"(tid_));
    const int tid = tid_, lane = tid & 63, w = tid >> 6, lj = lane & 15, g = lane >> 4;
    unsigned char* ws = a.ws; u16* P = (u16*)(ws + WS_PROJ);
    LAS u16* QE = (LAS u16*)lds;
    LAS u16* KET = QE + 64 * 136;
    LAS u16* VT = KET + 128 * 72;
    LAS u16* SCs = VT + 128 * 72;
    LAS float* dec = (LAS float*)(SCs + 64 * 72);
    LAS float* tot = dec + 128;
    LAS u16* GT = (LAS u16*)(tot + 128);
    const int chain = 64 + b * 8 + hi_;
    float* ST = (float*)(ws + WS_STATE) + (size_t)chain * 16384;
    u16* sink = (u16*)(ws + WS_DUMMY) + 8 * tid;
    f32x4 S[8];
#pragma unroll
    for (int m = 0; m < 8; ++m) S[m] = (j == 0) ? (f32x4){0.f, 0.f, 0.f, 0.f} : *(const f32x4*)(ST + ((w * 8 + m) * 64 + lane) * 4);
    u32x4 R[9]; float Rd = 0.f;
    unsigned oA[2], oT[2], oS[2];
#pragma unroll
    for (int q = 0; q < 2; ++q) { const int pid = tid + 512 * q; oA[q] = (unsigned)((pid >> 4) * PLD + 8 * (pid & 15)) * 2u; const int x = pid >> 3, c = pid & 7; oT[q] = (unsigned)((x >> 1) * PLD + 64 * (x & 1) + 8 * c) * 2u;
        const int p = lane + 64 * q; oS[q] = (unsigned)((p >> 1) * PLD + 16 * w + 8 * (p & 1)) * 2u; }
    auto load_chunk = [&](int nl) {
        const int lr0 = b * 1024 + 64 * nl; const size_t item = (size_t)((b * 16 + nl) * 8 + hi_);
        const char* sc = (const char*)(ws + WS_SC) + item * 8192;
        const char* pq = (const char*)(P + (size_t)lr0 * PLD + C_HQ + 128 * hi_); const char* pk = (const char*)(P + (size_t)lr0 * PLD + C_HF + 128 * hi_);
        const char* pv = (const char*)(P + (size_t)lr0 * PLD + C_HI + 128 * hi_); const char* pg = (const char*)(P + (size_t)lr0 * PLD + C_HG + 128 * hi_);
#pragma unroll
        for (int q = 0; q < 2; ++q) { R[q] = *(const u32x4*)(pq + oA[q]); R[2 + q] = *(const u32x4*)(pk + oT[q]); R[4 + q] = *(const u32x4*)(pv + oT[q]); R[7 + q] = *(const u32x4*)(pg + oS[q]); }
        R[6] = *(const u32x4*)(sc + (unsigned)tid * 16u);
        if (tid < 128) Rd = ((const float*)(ws + WS_DEC))[item * 128 + tid];
    };
    auto store_chunk = [&]() {
#pragma unroll
        for (int q = 0; q < 2; ++q) { const int pid = tid + 512 * q; st_perm(QE + (pid >> 4) * 136, pid & 15, R[q]);
            *(LAS u32x4*)(KET + (pid >> 3) * 72 + 8 * (pid & 7)) = R[2 + q]; *(LAS u32x4*)(VT + (pid >> 3) * 72 + 8 * (pid & 7)) = R[4 + q]; }
        *(LAS u32x4*)(SCs + (tid >> 3) * 72 + 8 * (tid & 7)) = R[6];
#pragma unroll
        for (int q = 0; q < 2; ++q) { const int p = lane + 64 * q; *(LAS u32x4*)(GT + (p >> 1) * 136 + 16 * w + 8 * (p & 1)) = R[7 + q]; }
        if (tid < 128) dec[tid] = Rd;
    };
    const float gnv = a.in[I_HON][16 * w + lj];
    load_chunk(0);
    if (tid < 128) tot[tid] = 0.f;
    store_chunk();
#pragma unroll 1
    for (int nl = 0; nl < 16; ++nl) {
        lbar();
        if (nl + 1 < 16) load_chunk(nl + 1);
        bf16x8 Sb[4];
#pragma unroll
        for (int kk = 0; kk < 4; ++kk) Sb[kk] = packacc(S[2 * kk], S[2 * kk + 1]);
        bf16x8 Vb[2];
#pragma unroll
        for (int tk = 0; tk < 2; ++tk) Vb[tk] = fragN(VT, 16 * w + lj, 32 * tk, g, 72);
        f32x4 o[4];
        bf16x8 fa[2][8];
#define LD_QS(bf, mt) do { _Pragma("unroll") for (int kk = 0; kk < 4; ++kk) fa[bf][kk] = fragN(QE, 16 * (mt) + lj, 32 * kk, g, 136); \
            _Pragma("unroll") for (int tk = 0; tk < 2; ++tk) fa[bf][4 + tk] = fragN(SCs, 16 * (mt) + lj, 32 * tk, g, 72); } while (0)
#define LD_KE(bf, m0) do { _Pragma("unroll") for (int m2 = 0; m2 < 4; ++m2) _Pragma("unroll") for (int tk = 0; tk < 2; ++tk) fa[bf][2 * m2 + tk] = fragN(KET, 16 * ((m0) + m2) + lj, 32 * tk, g, 72); } while (0)
#define MF_QS(bf, mt) do { f32x4 c = (f32x4){0.f, 0.f, 0.f, 0.f}; _Pragma("unroll") for (int kk = 0; kk < 4; ++kk) c = MFMA16(fa[bf][kk], Sb[kk], c); \
            _Pragma("unroll") for (int tk = 0; tk < 2; ++tk) c = MFMA16(fa[bf][4 + tk], Vb[tk], c); o[mt] = c; } while (0)
#define MF_KE(bf, m0) do { _Pragma("unroll") for (int m2 = 0; m2 < 4; ++m2) { f32x4 c = S[(m0) + m2] * *(const LAS f32x4*)(dec + 16 * ((m0) + m2) + 4 * g); \
            _Pragma("unroll") for (int tk = 0; tk < 2; ++tk) c = MFMA16(fa[bf][2 * m2 + tk], Vb[tk], c); S[(m0) + m2] = c; } } while (0)
        LD_QS(0, 0); SBAR;
        LD_QS(1, 1); SBAR; MF_QS(0, 0); SBAR;
        LD_QS(0, 2); SBAR; MF_QS(1, 1); SBAR;
        LD_QS(1, 3); SBAR; MF_QS(0, 2); SBAR;
        LD_KE(0, 0); SBAR; MF_QS(1, 3); SBAR;
        LD_KE(1, 4); SBAR; MF_KE(0, 0); SBAR;
        MF_KE(1, 4); SBAR;
#undef LD_QS
#undef LD_KE
#undef MF_QS
#undef MF_KE
        LAS float* tc = tot + 64 * (nl & 1);
        norm_accum(o, tc, lj, g);
        lbar();
        norm_finish(o, tc, GT, gnv, P + (size_t)(b * 1024 + 64 * nl) * PLD + C_HG + 128 * hi_, PLD, dry, sink, w, lane, lj, g);
        if (tid < 64) tot[64 * ((nl + 1) & 1) + tid] = 0.f;
        if (nl + 1 < 16) store_chunk();
    }
#pragma unroll
    for (int m = 0; m < 8; ++m) *(f32x4*)(ST + ((w * 8 + m) * 64 + lane) * 4) = S[m];
    lbar();
}

#ifdef ONLY
#define EN(k) (ONLY == (k))
#else
#define EN(k) 1
#endif
__global__ void __launch_bounds__(512, 2) mk_fwd(KArgs a) {
    extern __shared__ __attribute__((aligned(16))) unsigned char lds_raw[];
    LAS unsigned char* lds = (LAS unsigned char*)lds_raw;
    cg::grid_group grid = cg::this_grid();
    volatile LAS unsigned* bst = (volatile LAS unsigned*)(lds + LDS_BYTES - 64);
    if (threadIdx.x < 2) bst[threadIdx.x] = 0u;
    __syncthreads();
    const XcdBarrier xbar = xcd_barrier_post((unsigned*)(a.ws + WS_BAR), bst);
    int seam = 0;
#define GRID_BAR() do { if (seam == 0) grid.sync(); else xcd_barrier(xbar); ++seam; } while (0)
    const int G = gridDim.x, bx = blockIdx.x;
    unsigned char* ws = a.ws;
    float* ssb = (float*)(ws + WS_SS);
    u16* XN = (u16*)(ws + WS_XN);

#pragma unroll 1
    for (int ph = a.ph_lo; ph < a.ph_hi; ++ph) {
        const int ptype = ph == 0 ? 0 : (ph == 1 || ph == 20) ? 1 : (ph == 2 || ph == 19 || ph == 21) ? 2 : ph == 22 ? 7 : 3 + ((ph - 3) & 3);
        (void)ptype;
        {
        constexpr bool dry = false;
        int tid_ = threadIdx.x; asm volatile("" : "+v"(tid_));
        const int tid = tid_, lane = tid & 63, wave = tid >> 6;
        const int gw = bx * 8 + wave, ngw = G * 8;
        LAS float* scr = (LAS float*)(lds + wave * 16384);
        if (EN(0) && ph == 0) {
            convert_weight(a.in[I_F1WI], DM, 2 * DFF, (u16*)(ws + WS_WFI), DM, 0, 1, scr, gw, ngw, lane);
            convert_weight(a.in[I_F1WO], DFF, DM, (u16*)(ws + WS_WFO), DFF, 0, 0, scr, gw, ngw, lane);
            convert_weight(a.in[I_WIN], DM, INW, (u16*)(ws + WS_WIN), DM, 0, 2, scr, gw, ngw, lane);
            convert_weight(a.in[I_WBH], DM, DM, (u16*)(ws + WS_WB), 3072, 0, 0, scr, gw, ngw, lane);
            convert_weight(a.in[I_WBG], 2048, DM, (u16*)(ws + WS_WB), 3072, 1024, 0, scr, gw, ngw, lane);
            convert_weight(a.in[I_WOUT], DM, DM, (u16*)(ws + WS_WOUT), DM, 0, 0, scr, gw, ngw, lane);
            if (bx < 64) { const int idx = bx * 512 + tid; const int k = idx >> 5, c = idx & 31; ((u16*)(ws + WS_WAB))[c * 1024 + k] = (u16)f2bf(a.in[I_WIN][(size_t)k * INW + 8192 + c]); }
            for (int m = gw; m < T_TOK; m += ngw) {
                const f32x4* xr = (const f32x4*)(a.in[I_X] + (size_t)m * DM) + lane; const f32x4* gr = (const f32x4*)a.in[I_F1N] + lane; float s = 0.f;
                unsigned long long* o8 = (unsigned long long*)(XN + (size_t)m * DM) + lane;
#pragma unroll
                for (int q = 0; q < 4; ++q) { const f32x4 v = xr[64 * q], gg = gr[64 * q]; s += (v[0] * v[0] + v[1] * v[1]) + (v[2] * v[2] + v[3] * v[3]);
                    o8[64 * q] = (unsigned long long)pk2(v[0] * gg[0], v[1] * gg[1]) | ((unsigned long long)pk2(v[2] * gg[2], v[3] * gg[3]) << 32); }
                s = wave_sum(s);
                if (lane == 0) { ssb[m] = s; ssb[T_TOK + m] = 0.f; ssb[2 * T_TOK + m] = 0.f; ssb[3 * T_TOK + m] = 0.f; }
            }
        } else if (EN(1) && (ph == 1 || ph == 20)) {
            SchedStd S; S.A = (const char*)(ws + (ph == 1 ? WS_XN : WS_XN3)); S.B = (const char*)(ws + WS_WFI); S.lda = DM; S.ldb = DM; S.nt = 16; S.O.init(64, 22, G, bx);
            EpiSwiglu E; E.H = (u16*)(ws + WS_HID); E.ss = ssb + (ph == 1 ? 0 : 2 * T_TOK);
            pg8::gemm_phase(lds, S, E);
        } else if (EN(2) && (ph == 2 || ph == 19 || ph == 21)) {
            SchedStd S; EpiResid E;
            if (ph == 19) { S.A = (const char*)(ws + WS_XN); S.B = (const char*)(ws + WS_WOUT); S.lda = DM; S.ldb = DM; S.nt = 16;
                E.base = a.out; E.scale = 1.0f; E.xn = (u16*)(ws + WS_XN3); E.g = a.in[I_F2N]; E.ss_out = ssb + 2 * T_TOK; }
            else { S.A = (const char*)(ws + WS_HID); S.B = (const char*)(ws + WS_WFO); S.lda = DFF; S.ldb = DFF; S.nt = 44;
                E.base = ph == 2 ? a.in[I_X] : a.out; E.scale = 0.5f; E.xn = ph == 2 ? XN : nullptr; E.g = a.in[I_MIXN]; E.ss_out = ssb + (ph == 2 ? T_TOK : 3 * T_TOK); }
            E.out = a.out; E.dry = dry; E.dummy = (float*)(ws + WS_DUMMY); S.O.init(64, 4, G, bx);
            pg8::gemm_phase(lds, S, E);
        } else if (ph < 19) {
            const int j = (ph - 3) >> 2, sub = (ph - 3) & 3;
            if (EN(3) && sub == 0) {
                SchedG3 S; S.A = (const char*)XN; S.B = (const char*)(ws + WS_WIN); S.lda = DM; S.ldb = DM; S.nt = 16; S.j = j; S.pn0 = 0; S.perm = (j != 0); S.O.init(16, j == 0 ? 48 : 32, G, bx);
                EpiProj E; E.P = (u16*)(ws + WS_PROJ); E.L = (u16*)(ws + WS_LATE) + (size_t)(j & 1) * 4096 * LLD; E.ss = ssb + T_TOK; E.lbl = a.in[I_LBL]; E.halo = (u16*)(ws + WS_HALO); E.j = j; E.pn0 = 0; E.perm = (j != 0);
                pg8::gemm_phase(lds, S, E);
                if (j == 0) { for (int it = bx; it < 256; it += G) gab_item(lds, a, it * 64); }
            } else if (sub == 1) {
#pragma unroll 1
                for (int it = bx; it < 1024; it += G) {
                    if (EN(4) && it < 512) { if (!(dry && (a.probe & 0x4000))) prep_gdn(lds, a, j, it >> 7, (it >> 3) & 15, it & 7, dry); }
                    else if (EN(5) && it >= 512) { const int i2 = it - 512; if (!(dry && (a.probe & 0x8000))) prep_hgrn(lds, a, i2 >> 7, (i2 >> 3) & 15, i2 & 7, dry); }
                }
            } else if (sub == 2) {
                if (j < 3 && bx >= 96 && !dry) {
                    SchedG3 S; S.A = (const char*)XN; S.B = (const char*)(ws + WS_WIN); S.lda = DM; S.ldb = DM; S.nt = 16; S.j = j + 1; S.pn0 = 32; S.perm = 0; S.O.init(16, 16, G - 96, bx - 96);
                    EpiProj E; E.P = (u16*)(ws + WS_PROJ); E.L = (u16*)(ws + WS_LATE) + (size_t)((j + 1) & 1) * 4096 * LLD; E.ss = ssb + T_TOK; E.lbl = a.in[I_LBL]; E.halo = (u16*)(ws + WS_HALO); E.j = j + 1; E.pn0 = 32; E.perm = 0;
                    pg8::gemm_phase(lds, S, E);
                }
                if (j == 3 && bx >= 96 && !dry) {
                    const int gw2 = (bx - 96) * 8 + wave, ngw2 = (G - 96) * 8;
                    convert_weight(a.in[I_F2WI], DM, 2 * DFF, (u16*)(ws + WS_WFI), DM, 0, 1, scr, gw2, ngw2, lane);
                    convert_weight(a.in[I_F2WO], DFF, DM, (u16*)(ws + WS_WFO), DFF, 0, 0, scr, gw2, ngw2, lane);
                }
#pragma unroll 1
                for (int c = bx; c < 96; c += G) {
                    if (EN(6) && c < 64) { recur_gdn(lds, a, j, c >> 4, c & 15, false); }
                    else if (EN(7) && c >= 64) { recur_hgrn(lds, a, j, (c - 64) >> 3, (c - 64) & 7, false); }
                }
            } else if (EN(8)) {
                SchedG4 S; S.P = (const char*)(ws + WS_PROJ); S.L = (const char*)(ws + WS_LATE) + (size_t)(j & 1) * 4096 * LLD * 2; S.B = (const char*)(ws + WS_WB); S.lda = (bx % 3 == 0) ? PLD : LLD; S.ldb = 3072; S.c = bx;
                EpiG4 E; E.L = (const u16*)(ws + WS_LATE) + (size_t)(j & 1) * 4096 * LLD; E.Y = (u16*)(ws + WS_XN); E.TMP = (u16*)(ws + (j == 3 ? WS_WM : WS_WFI)); E.flags = (unsigned*)(ws + WS_BAR) + 3584; E.j = j;
                pg8::gemm_phase(lds, S, E);
            }
        } else {
            const float* ss4 = ssb + 3 * T_TOK;
            for (int m = gw; m < T_TOK; m += ngw) { f32x4* xr = (f32x4*)(a.out + (size_t)m * DM) + lane; const f32x4* gr = (const f32x4*)a.in[I_FINN] + lane;
                f32x4* xw = dry ? (f32x4*)(ws + WS_DUMMY) + lane : xr;
                const float rs = rsqrtf(ss4[m] * (1.0f / 1024.0f) + EPS);
#pragma unroll
                for (int q = 0; q < 4; ++q) xw[dry ? 0 : 64 * q] = xr[64 * q] * gr[64 * q] * rs; }
        }
        if (dry) GRID_BAR();
        }
        if (ph + 1 < a.ph_hi) GRID_BAR();
    }
}

#ifndef PROBE_MASK
#define PROBE_MASK 0
#endif
extern "C" void kernel_launch(void* const* d_in, const int* in_sizes, int n_in, void* d_out, int out_size, void* d_ws, size_t ws_size, hipStream_t stream) {
    static int grid = 0;
    if (grid == 0) {
        if (n_in != 19 || ws_size < WS_END) { fprintf(stderr, "kernel_launch: unexpected inputs (n_in %d, ws %zu)\n", n_in, ws_size); grid = -1; return; }
        int dev = 0, cus = 0, per_cu = 0;
        hipGetDevice(&dev); hipDeviceGetAttribute(&cus, hipDeviceAttributeMultiprocessorCount, dev);
        hipFuncSetAttribute((const void*)mk_fwd, hipFuncAttributeMaxDynamicSharedMemorySize, LDS_BYTES);
        hipOccupancyMaxActiveBlocksPerMultiprocessor(&per_cu, (const void*)mk_fwd, 512, LDS_BYTES);
        if (per_cu < 1) { fprintf(stderr, "kernel_launch: occupancy query says %d blocks per CU\n", per_cu); per_cu = 1; }
        if (per_cu > 1) per_cu = 1;
        grid = cus * per_cu;
    }
    if (grid < 0) return;
    if (hipMemsetAsync((char*)d_ws + WS_BAR, 0, BAR_BYTES, stream) != hipSuccess) { fprintf(stderr, "kernel_launch: memset failed\n"); return; }
    KArgs a{};
    for (int i = 0; i < 19; ++i) a.in[i] = (const float*)d_in[i];
    a.out = (float*)d_out; a.ws = (unsigned char*)d_ws; a.ph_lo = 0; a.ph_hi = 23; a.probe = PROBE_MASK;
    void* args[] = {&a};
    hipError_t e = hipLaunchCooperativeKernel((const void*)mk_fwd, dim3(grid), dim3(512), args, LDS_BYTES, stream);
    if (e != hipSuccess) fprintf(stderr, "cooperative launch failed: %s (grid %d)\n", hipGetErrorString(e), grid);
}
```

```cpp
#define PROBE_MASK 0x0
#include <hip/hip_runtime.h>
#include <hip/hip_cooperative_groups.h>
#include <cstdio>
namespace cg = cooperative_groups;

#define DI __device__ __forceinline__
#define LAS __attribute__((address_space(3)))
typedef unsigned short u16;
typedef short bf16x8 __attribute__((ext_vector_type(8)));
typedef float f32x4 __attribute__((ext_vector_type(4)));
typedef unsigned u32x4 __attribute__((ext_vector_type(4)));
typedef unsigned u32x2 __attribute__((ext_vector_type(2)));

constexpr int T_TOK = 16384, DM = 1024, DFF = 2816, INW = 12320;
constexpr int PLD = 8192;
constexpr int LLD = 4096;
constexpr int L_GZ = 0, L_GH = 2048, L_GG = 3072;
constexpr int C_HQ = 0, C_HF = 1024, C_HI = 2048, C_HG = 3072, C_GQ = 4096, C_GK = 5120, C_GV = 6144;
constexpr float EPS = 1e-6f;
constexpr size_t MiB = 1u << 20;
constexpr size_t WS_BAR = 512 * 1024, BAR_BYTES = 16384;
constexpr size_t WS_WAB = 256 * 1024;
constexpr size_t WS_SS = 0;
constexpr size_t WS_WIN = 1 * MiB, WS_WB = 25 * MiB, WS_WOUT = 31 * MiB;
constexpr size_t WS_WFI = 33 * MiB, WS_WFO = 44 * MiB;
constexpr size_t WS_XN = 50 * MiB;
constexpr size_t WS_XN3 = 82 * MiB;
constexpr size_t WS_SC = 82 * MiB, WS_WM = 86 * MiB, WS_QK = 102 * MiB, WS_HALO = 110 * MiB;
constexpr size_t WS_HID = 114 * MiB, WS_PROJ = 114 * MiB, WS_LATE = 178 * MiB;
constexpr size_t WS_STATE = 242 * MiB, WS_GAM = 248 * MiB, WS_DEC = 248 * MiB + 512 * 1024;
constexpr size_t WS_DUMMY = 248 * MiB + 768 * 1024;
constexpr size_t WS_GBG = 249 * MiB, WS_GBB = 250 * MiB;
constexpr size_t WS_TMP = 251 * MiB;
constexpr size_t WS_END = 256 * MiB;
constexpr int LDS_BYTES = 159744;

DI unsigned f2bf(float f) { unsigned u = __float_as_uint(f); return (u + 0x7fffu + ((u >> 16) & 1u)) >> 16; }
typedef float f32x2_t __attribute__((ext_vector_type(2)));
typedef __bf16 bf16x2_t __attribute__((ext_vector_type(2)));
DI unsigned pk2(float lo, float hi) { const f32x2_t v = {lo, hi}; return __builtin_bit_cast(unsigned, __builtin_convertvector(v, bf16x2_t)); }
DI float bf2f(unsigned b) { return __uint_as_float(b << 16); }
DI void unpack8(u32x4 w, float (&f)[8]) {
    f[0] = __uint_as_float(w.x << 16); f[1] = __uint_as_float(w.x & 0xffff0000u); f[2] = __uint_as_float(w.y << 16); f[3] = __uint_as_float(w.y & 0xffff0000u);
    f[4] = __uint_as_float(w.z << 16); f[5] = __uint_as_float(w.z & 0xffff0000u); f[6] = __uint_as_float(w.w << 16); f[7] = __uint_as_float(w.w & 0xffff0000u);
}
DI u32x4 pack8(const float (&f)[8]) { u32x4 w; w.x = pk2(f[0], f[1]); w.y = pk2(f[2], f[3]); w.z = pk2(f[4], f[5]); w.w = pk2(f[6], f[7]); return w; }
DI float wave_sum(float v) {
#pragma unroll
    for (int o = 1; o < 64; o <<= 1) v += __shfl_xor(v, o);
    return v;
}
#define DPP_ROR(x, n) __builtin_bit_cast(float, __builtin_amdgcn_update_dpp(0, __builtin_bit_cast(int, (x)), 0x120 + (n), 0xf, 0xf, false))
DI float row16_sum(float x) { x += DPP_ROR(x, 8); x += DPP_ROR(x, 4); x += DPP_ROR(x, 2); x += DPP_ROR(x, 1); return x; }
DI float sigm(float x) { return __builtin_amdgcn_rcpf(1.0f + __expf(-x)); }
DI unsigned cvt_pk_bf16(float lo, float hi) { unsigned r; asm volatile("v_cvt_pk_bf16_f32 %0, %1, %2" : "=v"(r) : "v"(lo), "v"(hi)); return r; }
DI unsigned short f2h(float f) { _Float16 h = (_Float16)f; return __builtin_bit_cast(unsigned short, h); }
DI float h2f(unsigned short b) { return (float)__builtin_bit_cast(_Float16, b); }
DI void st_perm(LAS u16* row, int c, u32x4 v) { const int cc = c & 3; LAS u16* p = row + ((8 * c) & ~31) + 16 * (cc & 1) + 4 * (cc >> 1);
    u32x2 lo, hi; lo.x = v.x; lo.y = v.y; hi.x = v.z; hi.y = v.w; *(LAS u32x2*)p = lo; *(LAS u32x2*)(p + 8) = hi; }
DI size_t widx(bool dry, int tid, size_t idx) { return dry ? (size_t)tid * 8 : idx; }
DI bf16x8 mk8(u32x2 lo, u32x2 hi) { u32x4 w; w.x = lo.x; w.y = lo.y; w.z = hi.x; w.w = hi.y; return __builtin_bit_cast(bf16x8, w); }
DI bf16x8 packacc(f32x4 a, f32x4 b) { u32x4 w; w.x = pk2(a[0], a[1]); w.y = pk2(a[2], a[3]); w.z = pk2(b[0], b[1]); w.w = pk2(b[2], b[3]); return __builtin_bit_cast(bf16x8, w); }
#define MFMA16(a, b, c) __builtin_amdgcn_mfma_f32_16x16x32_bf16((a), (b), (c), 0, 0, 0)
DI bf16x8 fragN(const LAS u16* M, int row, int k0, int g, int stride) { return *(const LAS bf16x8*)(M + row * stride + k0 + 8 * g); }
DI bf16x8 fragP(const LAS u16* M, int row, int k0, int g, int stride) {
    const LAS u16* p = M + row * stride + k0 + 4 * g;
    return mk8(*(const LAS u32x2*)p, *(const LAS u32x2*)(p + 16));
}

#define XB_TMO      128
#define XB_XCNT(j)  (256  + 64 * (j))
#define XB_XSUB(j)  (1280 + 64 * (j))
#define XB_XGEN(j)  (2304 + 64 * (j))
#define XB_TOP      3328
#define XB_TOPGEN   3392
#define XCD_BAR_WORDS 3456
#define XB_SPIN_CAP (1u << 18)

__device__ __forceinline__ unsigned xb_ld(unsigned* p)              { return __hip_atomic_load(p, __ATOMIC_RELAXED, __HIP_MEMORY_SCOPE_AGENT); }
__device__ __forceinline__ unsigned xb_add(unsigned* p, unsigned v) { return __hip_atomic_fetch_add(p, v, __ATOMIC_RELAXED, __HIP_MEMORY_SCOPE_AGENT); }
__device__ __forceinline__ unsigned xb_xcc_id() { return (unsigned)__builtin_amdgcn_s_getreg((3 << 11) | 20) & 0xFu; }
#define XB_SPIN(cond, bar) do { unsigned _sp = 0; while (cond) { __builtin_amdgcn_s_sleep(1); \
    if ((++_sp & 255u) == 0u) { if (xb_ld(&(bar)[XB_TMO])) break; if (_sp > XB_SPIN_CAP) { atomicAdd(&(bar)[XB_TMO], 1u); break; } } } } while (0)

struct XcdBarrier {
    unsigned* bar; unsigned x;
    volatile LAS unsigned* st;
};

__device__ __forceinline__ XcdBarrier xcd_barrier_post(unsigned* bar, volatile LAS unsigned* st) {
    XcdBarrier b; b.bar = bar; b.x = xb_xcc_id(); b.st = st;
    if (threadIdx.x == 0) (void)xb_add(&bar[XB_XCNT(b.x)], 1u);
    return b;
}
__device__ __forceinline__ void xcd_barrier_complete(unsigned* bar, unsigned x, unsigned& nloc, unsigned& nx) {
    const unsigned G = gridDim.x * gridDim.y * gridDim.z;
    unsigned sum, cnt, mine, sp = 0u;
    for (;;) {
        sum = 0u; cnt = 0u; mine = 0u;
#pragma unroll
        for (unsigned j = 0; j < 16; ++j) { const unsigned c = xb_ld(&bar[XB_XCNT(j)]); sum += c; cnt += (c > 0u) ? 1u : 0u; mine = (j == x) ? c : mine; }
        if (sum == G) break;
        __builtin_amdgcn_s_sleep(1);
        if ((++sp & 255u) == 0u) { if (xb_ld(&bar[XB_TMO])) break; if (sp > XB_SPIN_CAP) { atomicAdd(&bar[XB_TMO], 1u); break; } }
    }
    nloc = mine > 0u ? mine : 1u; nx = cnt > 0u ? cnt : 1u;
}

__device__ __forceinline__ void xcd_barrier(const XcdBarrier& b) {
    asm volatile("s_waitcnt vmcnt(0)" ::: "memory");
    __syncthreads();
    if (threadIdx.x == 0) {
        unsigned* bar = b.bar;
        __builtin_amdgcn_s_waitcnt(0);
        unsigned nloc = b.st[0], nx = b.st[1];
        if (nloc == 0u) { xcd_barrier_complete(bar, b.x, nloc, nx); b.st[0] = nloc; b.st[1] = nx; }
        const unsigned old = xb_add(&bar[XB_XSUB(b.x)], 1u);
        const unsigned gen = old / nloc;
        if (old + 1u == (gen + 1u) * nloc) {
            __builtin_amdgcn_fence(__ATOMIC_RELEASE, "agent");
            asm volatile("s_waitcnt vmcnt(0)" ::: "memory");
            const unsigned og = xb_add(&bar[XB_TOP], 1u);
            const unsigned tg = og / nx;
            if (og + 1u == (tg + 1u) * nx) xb_add(&bar[XB_TOPGEN], 1u);
            else XB_SPIN(xb_ld(&bar[XB_TOPGEN]) == tg, bar);
            __builtin_amdgcn_fence(__ATOMIC_ACQUIRE, "agent");
            xb_add(&bar[XB_XGEN(b.x)], 1u);
            asm volatile("s_waitcnt vmcnt(0)" ::: "memory");
        } else {
            XB_SPIN(xb_ld(&bar[XB_XGEN(b.x)]) == gen, bar);
            __builtin_amdgcn_fence(__ATOMIC_ACQUIRE, "agent");
            asm volatile("s_waitcnt vmcnt(0)" ::: "memory");
        }
    }
    __syncthreads();
}


namespace pg8 {
constexpr int BM = 256, BK = 64, HALF = 128, HTB = HALF * BK * 2, NXCD = 8, WGM = 8;
DI int lds_byte(int r, int c) { const int st = (r >> 4) * 2 + (c >> 5), rr = r & 15, cc = c & 31, ob = rr * 64 + cc * 2; return st * 1024 + (ob ^ (((ob >> 9) & 1) << 5)); }
DI void stage_rc(int b, int& R, int& C) { const int st = b / 1024, sb = b % 1024, swz = sb ^ (((sb >> 9) & 1) << 5); R = (st >> 1) * 16 + swz / 64; C = (st & 1) * 32 + (swz % 64) / 2; }
DI int perm32(int rho) { const int n = rho >> 4, i = rho & 15; return 8 * (i >> 2) + 4 * n + (i & 3); }
struct Unit { int pm, pn, part; };
struct Order {
    int nM, nN, nwg, G, c;
    DI void init(int nM_, int nN_, int G_, int c_) { nM = nM_; nN = nN_; nwg = nM * nN; G = G_; c = c_; }
    DI bool next(int i, Unit& u) const {
        const long L = (long)i * G + c; if (L >= nwg) return false;
        int wgid = (int)L; { const int q = nwg / NXCD, r = nwg % NXCD, xcd = wgid % NXCD, off = wgid / NXCD; wgid = (xcd < r ? xcd * (q + 1) : r * (q + 1) + (xcd - r) * q) + off; }
        const int nig = WGM * nN, gid = wgid / nig, fm = gid * WGM, gsz = (nM - fm) < WGM ? (nM - fm) : WGM;
        u.pm = fm + ((wgid % nig) % gsz); u.pn = (wgid % nig) / gsz; u.part = 0; return true;
    }
};

template <class Epi, class Sched>
DI void gemm_phase(LAS unsigned char* lds, const Sched& S, const Epi& E) {
    int tid_ = threadIdx.x; asm volatile("" : "+v"(tid_));
    const int tid = tid_, wid = __builtin_amdgcn_readfirstlane(tid >> 6), lane = tid & 63, wr = wid >> 2, wc = wid & 3, fr = lane & 15, fq = lane >> 4;
    unsigned voffA[2], voffB[2];
#pragma unroll
    for (int i = 0; i < 2; ++i) { int R, C; stage_rc(tid * 16 + i * 8192, R, C); const int Rb = Epi::PERM ? ((R & ~31) + perm32(R & 31)) : R;
        voffA[i] = (unsigned)(R * S.lda + C) * 2u; voffB[i] = (unsigned)(Rb * S.ldb + C) * 2u; }
    const size_t kstep = (size_t)(BK * 2);
    const size_t hstepA = (size_t)HALF * S.lda * 2, hstepB = (size_t)HALF * S.ldb * 2;
    const unsigned ldsw = (unsigned)wid * 1024u;
    const int aoff = lds_byte(wr * 64 + fr, fq * 8), boff = lds_byte(wc * 32 + fr, fq * 8);
#define PG8_SA(b, h) (((b) * 2 + (h)) * HTB)
#define PG8_SB(b, h) ((4 + (b) * 2 + (h)) * HTB)
#define PG8_STAGE(bufoff, gbase, voff) do { _Pragma("unroll") for (int _i = 0; _i < 2; ++_i) \
        __builtin_amdgcn_global_load_lds((const unsigned*)((const char*)(gbase) + (voff)[_i]), (LAS unsigned*)(lds + (bufoff) + ldsw + _i * 8192), 16, 0, 0); } while (0)
#define PG8_LDA(dst, b, h) do { _Pragma("unroll") for (int m = 0; m < 4; ++m) _Pragma("unroll") for (int k = 0; k < 2; ++k) dst[m][k] = *(const LAS bf16x8*)(lds + PG8_SA(b, h) + aoff + m * 2048 + k * 1024); } while (0)
#define PG8_LDB(dst, b, h) do { _Pragma("unroll") for (int n = 0; n < 2; ++n) _Pragma("unroll") for (int k = 0; k < 2; ++k) dst[n][k] = *(const LAS bf16x8*)(lds + PG8_SB(b, h) + boff + n * 2048 + k * 1024); } while (0)
#define PG8_MMA(ai, bj, At, Bt) do { __builtin_amdgcn_s_setprio(1); _Pragma("unroll") for (int m = 0; m < 4; ++m) _Pragma("unroll") for (int n = 0; n < 2; ++n) _Pragma("unroll") for (int k = 0; k < 2; ++k) \
        acc[ai][bj][m][n] = __builtin_amdgcn_mfma_f32_16x16x32_bf16(Bt[n][k], At[m][k], acc[ai][bj][m][n], 0, 0, 0); __builtin_amdgcn_s_setprio(0); } while (0)
#define PG8_WAIT_V(n) asm volatile("s_waitcnt vmcnt(" #n ")" ::: "memory")
#define PG8_WAIT_L(n) asm volatile("s_waitcnt lgkmcnt(" #n ")" ::: "memory")
#define PG8_BAR __builtin_amdgcn_s_barrier()
#define PG8_SCHED __builtin_amdgcn_sched_barrier(0)
    Unit cur, nxt; int ui = 0;
    if (!S.next(0, cur)) return;
    f32x4 acc[2][2][4][2];
#pragma unroll
    for (int a = 0; a < 2; ++a)
#pragma unroll
        for (int b = 0; b < 2; ++b)
#pragma unroll
            for (int m = 0; m < 4; ++m)
#pragma unroll
                for (int n = 0; n < 2; ++n) acc[a][b][m][n] = (f32x4){0.f, 0.f, 0.f, 0.f};
    bf16x8 At[4][2], B0[2][2], B1[2][2];
    const char* cA; const char* cB; S.ptrs(cur, cA, cB);
    PG8_STAGE(PG8_SB(0, 0), cB, voffB); PG8_STAGE(PG8_SB(0, 1), cB + hstepB, voffB); PG8_STAGE(PG8_SA(0, 0), cA, voffA); PG8_STAGE(PG8_SA(0, 1), cA + hstepA, voffA);
    if (wr == 1) PG8_BAR;
    PG8_WAIT_V(2); PG8_BAR;
    PG8_STAGE(PG8_SB(1, 0), cB + kstep, voffB); PG8_STAGE(PG8_SA(1, 0), cA + kstep, voffA); PG8_STAGE(PG8_SB(1, 1), cB + hstepB + kstep, voffB);
    PG8_WAIT_V(6); PG8_BAR;
    for (;;) {
        const bool has_next = S.next(ui + 1, nxt); const int nt = S.ntu(cur);
        const char* nA = cA; const char* nB = cB; if (has_next) S.ptrs(nxt, nA, nB);
        for (int t = 0; t < nt; t += 2) {
            const bool last = (t == nt - 2);
            const char* a1 = cA + (size_t)(t + 1) * kstep;
            const char* a2 = last ? nA : cA + (size_t)(t + 2) * kstep; const char* b2 = last ? nB : cB + (size_t)(t + 2) * kstep;
            const char* a3 = a2 + kstep; const char* b3 = b2 + kstep;
            PG8_LDB(B0, 0, 0); PG8_LDB(B1, 0, 1); PG8_SCHED; PG8_LDA(At, 0, 0); PG8_STAGE(PG8_SA(1, 1), a1 + hstepA, voffA);
            PG8_WAIT_V(8); PG8_WAIT_L(0); PG8_BAR; PG8_MMA(0, 0, At, B0); PG8_MMA(0, 1, At, B1); PG8_BAR; PG8_SCHED;
            PG8_LDA(At, 0, 1); PG8_STAGE(PG8_SB(0, 0), b2, voffB); PG8_STAGE(PG8_SB(0, 1), b2 + hstepB, voffB); PG8_STAGE(PG8_SA(0, 0), a2, voffA);
            PG8_WAIT_V(8); PG8_WAIT_L(0); PG8_BAR; PG8_MMA(1, 0, At, B0); PG8_MMA(1, 1, At, B1); PG8_BAR; PG8_SCHED;
            PG8_LDB(B0, 1, 0); PG8_LDB(B1, 1, 1); PG8_SCHED; PG8_LDA(At, 1, 0); PG8_STAGE(PG8_SA(0, 1), a2 + hstepA, voffA);
            PG8_WAIT_V(8); PG8_WAIT_L(0); PG8_BAR; PG8_MMA(0, 0, At, B0); PG8_MMA(0, 1, At, B1); PG8_BAR; PG8_SCHED;
            PG8_LDA(At, 1, 1); PG8_STAGE(PG8_SB(1, 0), b3, voffB); PG8_STAGE(PG8_SB(1, 1), b3 + hstepB, voffB); PG8_STAGE(PG8_SA(1, 0), a3, voffA);
            PG8_WAIT_V(8); PG8_WAIT_L(0); PG8_BAR; PG8_MMA(1, 0, At, B0); PG8_MMA(1, 1, At, B1); PG8_BAR; PG8_SCHED;
        }
        if (wr == 0) PG8_BAR;
        { int fr2 = fr, fq2 = fq; asm volatile("" : "+v"(fr2), "+v"(fq2)); E(acc, cur, wr, wc, fr2, fq2); }
        if (!has_next) break;
#pragma unroll
        for (int a = 0; a < 2; ++a)
#pragma unroll
            for (int b = 0; b < 2; ++b)
#pragma unroll
                for (int m = 0; m < 4; ++m)
#pragma unroll
                    for (int n = 0; n < 2; ++n) acc[a][b][m][n] = (f32x4){0.f, 0.f, 0.f, 0.f};
        cur = nxt; cA = nA; cB = nB; ++ui;
        if (wr == 1) PG8_BAR;
    }
    PG8_WAIT_V(0);
    PG8_BAR;
#undef PG8_SA
#undef PG8_SB
#undef PG8_STAGE
#undef PG8_LDA
#undef PG8_LDB
#undef PG8_MMA
#undef PG8_WAIT_V
#undef PG8_WAIT_L
#undef PG8_BAR
#undef PG8_SCHED
}
}
using pg8::Unit;
typedef f32x4 Acc[2][2][4][2];

struct KArgs { const float* in[19]; float* out; unsigned char* ws; int ph_lo, ph_hi, probe, pad; };
enum { I_X = 0, I_F1N, I_F1WI, I_F1WO, I_MIXN, I_WIN, I_LBL, I_HON, I_CONVW, I_ALOG, I_DTB, I_GON, I_WBH, I_WBG, I_WOUT, I_F2N, I_F2WI, I_F2WO, I_FINN };

struct SchedStd {
    const char* A; const char* B; int lda, ldb, nt; pg8::Order O;
    DI bool next(int i, Unit& u) const { return O.next(i, u); }
    DI int ntu(const Unit&) const { return nt; }
    DI void ptrs(const Unit& u, const char*& a, const char*& b) const { a = A + (size_t)u.pm * 256 * lda * 2; b = B + (size_t)u.pn * 256 * ldb * 2; }
};
DI int g3_perm(int lp) {
    const int k = lp >> 3, t = lp & 7;
    if (t == 0 || t == 1 || t == 6) { const int i = 3 * k + (t == 6 ? 2 : t); return i < 8 ? i : i + 4; }
    const int i = 5 * k + (t == 7 ? 4 : t - 2); return i < 4 ? 8 + i : 12 + i;
}
struct SchedG3 {
    const char* A; const char* B; int lda, ldb, nt, j, pn0, perm; pg8::Order O;
    DI bool next(int i, Unit& u) const { return O.next(i, u); }
    DI int ntu(const Unit&) const { return nt; }
    DI void ptrs(const Unit& u, const char*& a, const char*& b) const {
        const size_t grow = (size_t)(u.pm >> 2) * 4096 + 1024 * j + (u.pm & 3) * 256;
        const int lp = pn0 + u.pn; a = A + grow * 1024 * 2; b = B + (size_t)(perm ? g3_perm(lp) : lp) * 256 * 1024 * 2; }
};
struct SchedG4 {
    const char* P; const char* L; const char* B; int lda, ldb, c;
    DI bool next(int i, Unit& u) const { if (c >= 192 || i >= 1) return false; const int tile = c / 3; u.pm = tile >> 2; u.pn = tile & 3; u.part = c - 3 * tile; return true; }
    DI int ntu(const Unit&) const { return 16; }
    DI void ptrs(const Unit& u, const char*& a, const char*& b) const {
        a = u.part == 0 ? P + ((size_t)u.pm * 256 * PLD + C_HG) * 2 : L + ((size_t)u.pm * 256 * LLD + L_GZ + 1024 * (u.part - 1)) * 2;
        b = B + ((size_t)u.pn * 256 * 3072 + (size_t)u.part * 1024) * 2; }
};

struct EpiSwiglu {
    static constexpr bool PERM = true;
    u16* H; const float* ss;
    DI bool operator()(Acc& acc, const Unit& u, int wr, int wc, int fr, int fq) const {
        const int row0 = u.pm * 256 + wr * 64 + fr, hc0 = u.pn * 128 + wc * 32 + 8 * fq;
#pragma unroll
        for (int ai = 0; ai < 2; ++ai)
#pragma unroll
            for (int m = 0; m < 4; ++m) { const int row = row0 + ai * 128 + m * 16; const float rs = rsqrtf(ss[row] * (1.0f / 1024.0f) + EPS);
                float h[8];
#pragma unroll
                for (int n = 0; n < 2; ++n)
#pragma unroll
                    for (int e = 0; e < 4; ++e) { const float a = acc[ai][0][m][n][e] * rs, b = acc[ai][1][m][n][e] * rs; h[4 * n + e] = a * sigm(a) * b; }
                u32x4 w; w.x = cvt_pk_bf16(h[0], h[1]); w.y = cvt_pk_bf16(h[2], h[3]); w.z = cvt_pk_bf16(h[4], h[5]); w.w = cvt_pk_bf16(h[6], h[7]);
                *(u32x4*)(H + (size_t)row * DFF + hc0) = w; asm volatile("" ::: "memory"); }
        return true;
    }
};
struct EpiResid {
    static constexpr bool PERM = false;
    const float* base; float* out; float scale; u16* xn; const float* g; float* ss_out; bool dry; float* dummy;
    DI bool operator()(Acc& acc, const Unit& u, int wr, int wc, int fr, int fq) const {
        const int row0 = u.pm * 256 + wr * 64 + fr, col0 = u.pn * 256 + wc * 32 + 4 * fq;
#pragma unroll
        for (int ai = 0; ai < 2; ++ai)
#pragma unroll
            for (int m = 0; m < 4; ++m) { const int row = row0 + ai * 128 + m * 16; const size_t off = (size_t)row * DM + col0; float q = 0.f;
#pragma unroll
                for (int bj = 0; bj < 2; ++bj)
#pragma unroll
                    for (int n = 0; n < 2; ++n) { const int co = bj * 128 + n * 16; const f32x4 bs = *(const f32x4*)(base + off + co); const f32x4 o = bs + acc[ai][bj][m][n] * scale;
                        *(f32x4*)(dry ? dummy + 4 * (fr + 16 * fq) : out + off + co) = o; q += (o[0] * o[0] + o[1] * o[1]) + (o[2] * o[2] + o[3] * o[3]);
                        if (xn) { const f32x4 gv = *(const f32x4*)(g + col0 + co); u32x2 w; w.x = cvt_pk_bf16(o[0] * gv[0], o[1] * gv[1]); w.y = cvt_pk_bf16(o[2] * gv[2], o[3] * gv[3]); *(u32x2*)(dry ? (u16*)dummy + 4 * (fr + 16 * fq) : xn + off + co) = w; }
                        asm volatile("" ::: "memory"); }
                q += __shfl_xor(q, 16); q += __shfl_xor(q, 32);
                if (fq == 0 && !dry) atomicAdd(ss_out + row, q); asm volatile("" ::: "memory"); }
        return true;
    }
};
struct EpiProj {
    static constexpr bool PERM = true;
    u16* P; u16* L; const float* ss; const float* lbl; u16* halo; int j, pn0, perm;
    DI bool operator()(Acc& acc, const Unit& u, int wr, int wc, int fr, int fq) const {
        const int b = u.pm >> 2, tl0 = (u.pm & 3) * 256 + wr * 64 + fr;
        const int pn = perm ? g3_perm(pn0 + u.pn) : pn0 + u.pn; const int kind = pn < 4 ? 0 : pn < 8 ? 1 : pn < 12 ? 2 : pn < 16 ? 3 : pn < 32 ? 4 : pn < 40 ? 5 : 6;
        float lb[2][8];
#pragma unroll
        for (int bj = 0; bj < 2; ++bj)
#pragma unroll
            for (int e = 0; e < 8; ++e) lb[bj][e] = 0.f;
        if (kind == 1) {
#pragma unroll
            for (int bj = 0; bj < 2; ++bj)
#pragma unroll
                for (int e = 0; e < 8; ++e) { const int c = pn * 256 - C_HF + bj * 128 + wc * 32 + 8 * fq + e; lb[bj][e] = __builtin_amdgcn_rcpf(1.0f + __expf(lbl[1024 + c] - lbl[c])); }
        }
        const float sc = kind == 0 ? 0.08838834764831845f : 1.0f;
#pragma unroll
        for (int ai = 0; ai < 2; ++ai)
#pragma unroll
            for (int m = 0; m < 4; ++m) { const int tl = tl0 + ai * 128 + m * 16; const int lr = b * 1024 + tl; const int gr = b * 4096 + 1024 * j + tl;
                const float rs = rsqrtf(ss[gr] * (1.0f / 1024.0f) + EPS);
#pragma unroll
                for (int bj = 0; bj < 2; ++bj) { const int col = pn * 256 + bj * 128 + wc * 32 + 8 * fq; float r[8];
#pragma unroll
                    for (int n = 0; n < 2; ++n)
#pragma unroll
                        for (int e = 0; e < 4; ++e) { const float v = acc[ai][bj][m][n][e] * rs; float o = v;
                            if (kind != 2 && kind != 4) { const float s = sigm(v);
                                if (kind == 0 || kind == 3 || kind == 5) o = v * s * sc;
                                else if (kind == 6) o = s;
                                else o = __logf(lb[bj][4 * n + e] + (1.0f - lb[bj][4 * n + e]) * s); }
                            r[4 * n + e] = o; }
                    u32x4 w;
                    if (kind == 1) { w.x = f2h(r[0]) | ((unsigned)f2h(r[1]) << 16); w.y = f2h(r[2]) | ((unsigned)f2h(r[3]) << 16); w.z = f2h(r[4]) | ((unsigned)f2h(r[5]) << 16); w.w = f2h(r[6]) | ((unsigned)f2h(r[7]) << 16); }
                    else { w.x = cvt_pk_bf16(r[0], r[1]); w.y = cvt_pk_bf16(r[2], r[3]); w.z = cvt_pk_bf16(r[4], r[5]); w.w = cvt_pk_bf16(r[6], r[7]); }
                    if (pn < 32) *(u32x4*)(P + (size_t)lr * PLD + col) = w; else *(u32x4*)(L + (size_t)lr * LLD + (col - 8192)) = w;
                    if (kind == 4 && (tl & 63) >= 61) { const int n_ch = (1024 * j + tl) >> 6; *(u32x4*)(halo + ((size_t)((b * 32 + (n_ch & 31)) * 3 + (tl & 63) - 61)) * 4096 + (col - C_GQ)) = w; } }
                asm volatile("" ::: "memory"); }
        return true;
    }
};
struct EpiG4 {
    static constexpr bool PERM = true;
    const u16* L; u16* Y; u16* TMP; unsigned* flags; int j;
    DI bool operator()(Acc& acc, const Unit& u, int wr, int wc, int fr, int fq) const {
        const int b = u.pm >> 2, tl0 = (u.pm & 3) * 256 + wr * 64 + fr, col0 = u.pn * 256 + wc * 32 + 8 * fq;
        unsigned* flag = flags + (j * 64 + u.pm * 4 + u.pn);
        int part = u.part; asm volatile("" : "+s"(part));
        if (part != 0) {
            u16* T = TMP + (size_t)(part - 1) * 4096 * DM;
#pragma unroll
            for (int ai = 0; ai < 2; ++ai)
#pragma unroll
                for (int m = 0; m < 4; ++m) { const int tl = tl0 + ai * 128 + m * 16; const int lr = b * 1024 + tl;
#pragma unroll
                    for (int bj = 0; bj < 2; ++bj) { const int col = col0 + bj * 128;
                        float gg[8]; unpack8(*(const u32x4*)(L + (size_t)lr * LLD + L_GG + col), gg); float y[8];
#pragma unroll
                        for (int n = 0; n < 2; ++n)
#pragma unroll
                            for (int e = 0; e < 4; ++e) y[4 * n + e] = acc[ai][bj][m][n][e] * gg[4 * n + e];
                        u32x4 w; w.x = cvt_pk_bf16(y[0], y[1]); w.y = cvt_pk_bf16(y[2], y[3]); w.z = cvt_pk_bf16(y[4], y[5]); w.w = cvt_pk_bf16(y[6], y[7]);
                        *(u32x4*)(T + (size_t)lr * DM + col) = w; }
                    asm volatile("" ::: "memory"); }
            asm volatile("s_waitcnt vmcnt(0)" ::: "memory");
            __syncthreads();
            if (threadIdx.x == 0) { __builtin_amdgcn_fence(__ATOMIC_RELEASE, "agent"); asm volatile("s_waitcnt vmcnt(0)" ::: "memory"); (void)__hip_atomic_fetch_add(flag, 1u, __ATOMIC_RELAXED, __HIP_MEMORY_SCOPE_AGENT); }
        } else {
            if (threadIdx.x == 0) { unsigned sp = 0;
                while (__hip_atomic_load(flag, __ATOMIC_RELAXED, __HIP_MEMORY_SCOPE_AGENT) < 2u) { __builtin_amdgcn_s_sleep(2); if (++sp > (1u << 22)) break; }
                __builtin_amdgcn_fence(__ATOMIC_ACQUIRE, "agent"); asm volatile("s_waitcnt vmcnt(0)" ::: "memory"); }
            __syncthreads();
#pragma unroll
            for (int ai = 0; ai < 2; ++ai)
#pragma unroll
                for (int m = 0; m < 4; ++m) { const int tl = tl0 + ai * 128 + m * 16; const int lr = b * 1024 + tl; const int gr = b * 4096 + 1024 * j + tl;
#pragma unroll
                    for (int bj = 0; bj < 2; ++bj) { const int col = col0 + bj * 128;
                        float gh[8], t1[8], t2[8]; unpack8(*(const u32x4*)(L + (size_t)lr * LLD + L_GH + col), gh);
                        unpack8(*(const u32x4*)(TMP + (size_t)lr * DM + col), t1); unpack8(*(const u32x4*)(TMP + (size_t)4096 * DM + (size_t)lr * DM + col), t2); float y[8];
#pragma unroll
                        for (int n = 0; n < 2; ++n)
#pragma unroll
                            for (int e = 0; e < 4; ++e) y[4 * n + e] = acc[ai][bj][m][n][e] * gh[4 * n + e] + (t1[4 * n + e] + t2[4 * n + e]);
                        u32x4 w; w.x = cvt_pk_bf16(y[0], y[1]); w.y = cvt_pk_bf16(y[2], y[3]); w.z = cvt_pk_bf16(y[4], y[5]); w.w = cvt_pk_bf16(y[6], y[7]);
                        *(u32x4*)(Y + (size_t)gr * DM + col) = w; }
                    asm volatile("" ::: "memory"); }
        }
        return true;
    }
};

DI void transpose_item(const float* W, int N, u16* WT, int ldd, int koff, LAS float* scr, int kb, int nb, int lane, int mode) {
    const int k0 = 64 * kb, n0 = 32 * nb;
#pragma unroll 8
    for (int i = 0; i < 32; ++i) { const int kk = 2 * i + (lane >> 5); scr[kk * 33 + (lane & 31)] = W[(size_t)(k0 + kk) * N + n0 + (lane & 31)]; }
    asm volatile("s_waitcnt lgkmcnt(0)" ::: "memory");
    const int c = lane & 7;
#pragma unroll
    for (int jj = 0; jj < 4; ++jj) { const int n = (lane >> 3) + 8 * jj; const int cn = n0 + n; int dr = cn;
        if (mode == 1) { if (cn < DFF) dr = 256 * (cn >> 7) + (cn & 127); else { const int q = cn - DFF; dr = 256 * (q >> 7) + 128 + (q & 127); } }
        if (mode == 2) { if (cn >= 8224) dr = cn - 32; }
        const LAS float* s = scr + (8 * c) * 33 + n;
        u32x4 o; o.x = pk2(s[0 * 33], s[1 * 33]); o.y = pk2(s[2 * 33], s[3 * 33]); o.z = pk2(s[4 * 33], s[5 * 33]); o.w = pk2(s[6 * 33], s[7 * 33]);
        *(u32x4*)(WT + (size_t)dr * ldd + koff + k0 + 8 * c) = o; }
    asm volatile("s_waitcnt lgkmcnt(0)" ::: "memory");
}
DI void convert_weight(const float* W, int K, int N, u16* WT, int ldd, int koff, int mode, LAS float* scr, int gw, int ngw, int lane) {
    const int nblk = N / 32, nitems = (K / 64) * nblk;
    for (int it = gw; it < nitems; it += ngw) { const int kb = it / nblk, nb = it % nblk; if (mode == 2 && nb == 256) continue; transpose_item(W, N, WT, ldd, koff, scr, kb, nb, lane, mode); }
}

DI void gab_item(LAS unsigned char* lds, const KArgs& a, int gr0) {
    int tid_ = threadIdx.x; asm volatile("" : "+v"(tid_));
    const int tid = tid_, lane = tid & 63, wid = tid >> 6, lj = lane & 15, g = lane >> 4;
    unsigned char* ws = a.ws; const u16* XN = (const u16*)(ws + WS_XN); const u16* WAB = (const u16*)(ws + WS_WAB); const float* ss2 = (const float*)(ws + WS_SS) + T_TOK;
    LAS float* red = (LAS float*)lds;
    f32x4 acc[2][4];
#pragma unroll
    for (int nt = 0; nt < 2; ++nt)
#pragma unroll
        for (int mt = 0; mt < 4; ++mt) acc[nt][mt] = (f32x4){0.f, 0.f, 0.f, 0.f};
#pragma unroll
    for (int q = 0; q < 4; ++q) { const int kk = 4 * wid + q; bf16x8 bfr[2], afr[4];
#pragma unroll
        for (int nt = 0; nt < 2; ++nt) bfr[nt] = *(const bf16x8*)(WAB + (size_t)(16 * nt + lj) * 1024 + 32 * kk + 8 * g);
#pragma unroll
        for (int mt = 0; mt < 4; ++mt) afr[mt] = *(const bf16x8*)(XN + (size_t)(gr0 + 16 * mt + lj) * 1024 + 32 * kk + 8 * g);
#pragma unroll
        for (int nt = 0; nt < 2; ++nt)
#pragma unroll
            for (int mt = 0; mt < 4; ++mt) acc[nt][mt] = MFMA16(afr[mt], bfr[nt], acc[nt][mt]); }
#pragma unroll
    for (int nt = 0; nt < 2; ++nt)
#pragma unroll
        for (int mt = 0; mt < 4; ++mt)
#pragma unroll
            for (int r = 0; r < 4; ++r) red[(wid * 64 + 16 * mt + 4 * g + r) * 32 + 16 * nt + lj] = acc[nt][mt][r];
    __syncthreads();
#pragma unroll
    for (int q = 0; q < 4; ++q) { const int idx = tid + 512 * q, tok = idx >> 5, col = idx & 31; float sum = 0.f;
#pragma unroll
        for (int w2 = 0; w2 < 8; ++w2) sum += red[(w2 * 64 + tok) * 32 + col];
        sum *= rsqrtf(ss2[gr0 + tok] * (1.0f / 1024.0f) + EPS);
        if (col < 16) { const float xx = sum + a.in[I_DTB][col]; const float sp = xx > 20.f ? xx : log1pf(__expf(xx)); ((float*)(ws + WS_GBG))[(size_t)(gr0 + tok) * 16 + col] = -__expf(a.in[I_ALOG][col]) * sp; }
        else ((float*)(ws + WS_GBB))[(size_t)(gr0 + tok) * 16 + col - 16] = sigm(sum); }
    __syncthreads();
}
DI int swt(int v) { return ((v >> 3) ^ v) & 7; }
DI int swz(int v, int s) { return v * 64 + ((((s >> 3) ^ swt(v)) & 7) << 3) + (s & 7); }
DI void prep_gdn(LAS unsigned char* lds, const KArgs& a, int j, int b, int nl, int hq, bool dry) {
    int tid_ = threadIdx.x; asm volatile("" : "+v"(tid_));
    const int tid = tid_, lane = tid & 63, wid = tid >> 6, lj = lane & 15, g = lane >> 4;
    unsigned char* ws = a.ws;
    u16* P = (u16*)(ws + WS_PROJ); u16* Pw = dry ? (u16*)(ws + WS_DUMMY) : P; const u16* XN = (const u16*)(ws + WS_XN); const u16* halo = (const u16*)(ws + WS_HALO); const float* ss2 = (const float*)(ws + WS_SS) + T_TOK;
    const int n = 16 * j + nl, lr0 = b * 1024 + 64 * nl, gr0 = b * 4096 + 64 * n;
    LAS u16* QGs = (LAS u16*)lds;
    LAS u16* KGs = QGs + 64 * 136;
    LAS u16* VBT = KGs + 64 * 136;
    LAS u16* KBT = VBT + 2 * 128 * 64;
    LAS float* AM = (LAS float*)(KBT + 2 * 128 * 64);
    LAS u16* TM = (LAS u16*)(AM + 2 * 64 * 68);
    LAS float* gms = (LAS float*)(TM + 2 * 64 * 72);
    const bool sk1 = dry && (a.probe & 0x10000), sk2 = dry && (a.probe & 0x20000), sk3 = dry && (a.probe & 0x40000), sk4 = dry && (a.probe & 0x80000), sk5 = dry && (a.probe & 0x100000);
    const int mat = tid >> 7, tg = (tid >> 4) & 7, c8 = tid & 15, t0 = 8 * tg;
    const int cb = mat == 0 ? C_GQ + 128 * hq : (mat == 1 ? C_GK + 128 * hq : C_GV + 128 * (2 * hq + mat - 2));
    const int wcol = cb - C_GQ + 8 * c8;
    u32x4 raw[11];
#pragma unroll
    for (int rr = 0; rr < 11; ++rr) { const int tt = t0 - 3 + rr; raw[rr] = (u32x4){0u, 0u, 0u, 0u};
        if (tt >= 0) raw[rr] = *(const u32x4*)(P + (size_t)(lr0 + tt) * PLD + cb + 8 * c8);
        else if (n > 0) raw[rr] = *(const u32x4*)(halo + ((size_t)((b * 32 + ((n - 1) & 31)) * 3 + (3 + tt))) * 4096 + wcol); }
    float w[4][8];
#pragma unroll
    for (int jj = 0; jj < 4; ++jj) { const f32x4 w0 = *(const f32x4*)(a.in[I_CONVW] + jj * 4096 + wcol), w1 = *(const f32x4*)(a.in[I_CONVW] + jj * 4096 + wcol + 4);
#pragma unroll
        for (int e = 0; e < 4; ++e) { w[jj][e] = w0[e]; w[jj][4 + e] = w1[e]; } }
    if (tid < 128) { const int e = tid >> 6, tok = tid & 63;
        gms[e * 64 + tok] = ((const float*)(ws + WS_GBG))[(size_t)(gr0 + tok) * 16 + 2 * hq + e]; gms[128 + e * 64 + tok] = ((const float*)(ws + WS_GBB))[(size_t)(gr0 + tok) * 16 + 2 * hq + e]; }
    __syncthreads();
    if (wid < 2) { float v = gms[wid * 64 + lane];
#pragma unroll
        for (int o = 1; o < 64; o <<= 1) { const float t = __shfl_up(v, o); if (lane >= o) v += t; }
        gms[wid * 64 + lane] = v; }
    __syncthreads();
    if (!sk2) {
        float y[8][8];
#pragma unroll
        for (int i = 0; i < 8; ++i)
#pragma unroll
            for (int e = 0; e < 8; ++e) y[i][e] = 0.f;
#pragma unroll
        for (int rr = 0; rr < 11; ++rr) { float x[8]; unpack8(raw[rr], x);
#pragma unroll
            for (int jj = 0; jj < 4; ++jj) { const int i = rr - jj; if (i >= 0 && i < 8) {
#pragma unroll
                for (int e = 0; e < 8; ++e) y[i][e] += w[jj][e] * x[e]; } } }
#pragma unroll
        for (int i = 0; i < 8; ++i) {
#pragma unroll
            for (int e = 0; e < 8; ++e) y[i][e] = y[i][e] * sigm(y[i][e]);
            if (mat < 2) { float q = 0.f;
#pragma unroll
                for (int e = 0; e < 8; ++e) q += y[i][e] * y[i][e];
                q = row16_sum(q);
                const float sc = rsqrtf(q + EPS) * (mat == 0 ? 0.08838834764831845f : 1.0f);
#pragma unroll
                for (int e = 0; e < 8; ++e) y[i][e] *= sc;
                *(LAS u32x4*)((mat == 0 ? QGs : KGs) + (t0 + i) * 136 + 8 * c8) = pack8(y[i]); } }
        if (mat >= 1) {
#pragma unroll
            for (int ee = 0; ee < 2; ++ee) { if (mat == 1 || mat - 2 == ee) {
                float f[8];
#pragma unroll
                for (int i = 0; i < 8; ++i) f[i] = gms[128 + ee * 64 + t0 + i] * (mat == 1 ? __expf(gms[ee * 64 + t0 + i]) : 1.0f);
                LAS u16* dst = (mat == 1 ? KBT : VBT) + ee * 8192;
#pragma unroll
                for (int e = 0; e < 8; ++e) { const int v = 8 * c8 + e; float col[8];
#pragma unroll
                    for (int i = 0; i < 8; ++i) col[i] = y[i][e] * f[i];
                    *(LAS u32x4*)(dst + v * 64 + (((tg ^ swt(v)) & 7) << 3)) = pack8(col); } } }
        }
    }
    __syncthreads();
    const int cv0 = ((b * 16 + nl) * 16 + 2 * hq);
    u16* QKo = (u16*)(ws + WS_QK); u16* WMo = (u16*)(ws + WS_WM); float* GAMo = (float*)(ws + WS_GAM);
#pragma unroll
    for (int x = 0; x < 2; ++x) { if (sk3) break; const int tt = 2 * wid + x, mi = tt >> 2, ni = tt & 3;
        f32x4 kk = (f32x4){0.f, 0.f, 0.f, 0.f}, qk = (f32x4){0.f, 0.f, 0.f, 0.f};
#pragma unroll
        for (int ks = 0; ks < 4; ++ks) { const bf16x8 ka = fragN(KGs, 16 * mi + lj, 32 * ks, g, 136), kb2 = fragN(KGs, 16 * ni + lj, 32 * ks, g, 136), qb = fragN(QGs, 16 * ni + lj, 32 * ks, g, 136);
            kk = MFMA16(ka, kb2, kk); qk = MFMA16(ka, qb, qk); }
#pragma unroll
        for (int e = 0; e < 2; ++e) {
#pragma unroll
            for (int r = 0; r < 4; ++r) { const int t = 16 * mi + 4 * g + r, s = 16 * ni + lj;
                AM[e * 4352 + t * 68 + s] = (s < t) ? kk[r] * gms[128 + e * 64 + t] * __expf(gms[e * 64 + t] - gms[e * 64 + s]) : 0.f; }
            const int t = 16 * ni + lj; float o4[4];
#pragma unroll
            for (int r = 0; r < 4; ++r) { const int s = 16 * mi + 4 * g + r; o4[r] = (s <= t) ? qk[r] * __expf(gms[e * 64 + t] - gms[e * 64 + s]) : 0.f; }
            u32x2 w; w.x = pk2(o4[0], o4[1]); w.y = pk2(o4[2], o4[3]);
            *(LAS u32x2*)(TM + e * 4608 + t * 72 + 16 * mi + 4 * g) = w; } }
    __syncthreads();
#pragma unroll
    for (int q = 0; q < 2; ++q) { const int pid = tid + 512 * q, e = pid >> 9, row = (pid >> 3) & 63, c = pid & 7;
        *(u32x4*)(QKo + (size_t)(cv0 + e) * 4096 + row * 64 + 8 * c) = *(const LAS u32x4*)(TM + e * 4608 + row * 72 + 8 * c); }
    __syncthreads();
    if (wid < 2 && !sk4) { const LAS float* Ae = AM + wid * 4352; float Tc[64];
        f32x4 an[16], ac[16];
        Tc[0] = (lane == 0) ? 1.f : 0.f;
        an[0] = *(const LAS f32x4*)(Ae + 68);
#pragma unroll
        for (int i = 1; i < 64; ++i) {
#pragma unroll
            for (int q = 0; q < (i + 3) / 4; ++q) ac[q] = an[q];
            if (i + 1 < 64) {
#pragma unroll
                for (int q = 0; q < (i + 4) / 4; ++q) an[q] = *(const LAS f32x4*)(Ae + (i + 1) * 68 + 4 * q); }
            __builtin_amdgcn_sched_barrier(0);
            float s0 = (i == lane) ? 1.f : 0.f, s1 = 0.f;
#pragma unroll
            for (int jj = 0; jj < i; ++jj) { if (jj & 1) s1 -= ac[jj >> 2][jj & 3] * Tc[jj]; else s0 -= ac[jj >> 2][jj & 3] * Tc[jj]; }
            Tc[i] = s0 + s1;
            __builtin_amdgcn_sched_barrier(0);
        }
#pragma unroll
        for (int i = 0; i < 64; ++i) TM[wid * 4608 + i * 72 + lane] = (u16)f2bf(Tc[i]);
    } else if (wid >= 2) { const int t2 = tid - 128;
        for (int pid = t2; pid < 1024; pid += 384) { const int row = pid >> 4, c = pid & 15; *(u32x4*)(Pw + widx(dry, tid, (size_t)(lr0 + row) * PLD + C_GQ + 128 * hq + 8 * c)) = *(const LAS u32x4*)(QGs + row * 136 + 8 * c); }
        for (int pid = t2; pid < 1024; pid += 384) { const int k = pid >> 3, c = pid & 7; float v[8];
#pragma unroll
            for (int e = 0; e < 8; ++e) v[e] = bf2f(KGs[(8 * c + e) * 136 + k]);
            *(u32x4*)(Pw + widx(dry, tid, (size_t)(lr0 + (k >> 1)) * PLD + C_GK + 128 * hq + 64 * (k & 1) + 8 * c)) = pack8(v); }
        if (t2 < 128) GAMo[(size_t)(cv0 + (t2 >> 6)) * 64 + (t2 & 63)] = gms[t2];
    }
    __syncthreads();
    LAS u16* WMst = QGs;
    LAS u16* UTst = (LAS u16*)AM;
    if (!sk5) { const int e = wid >> 2, q = wid & 3; const LAS u16* Te = TM + e * 4608;
        bf16x8 ta[2];
#pragma unroll
        for (int ks = 0; ks < 2; ++ks) ta[ks] = fragN(Te, 16 * q + lj, 32 * ks, g, 72);
#pragma unroll
        for (int vt = 0; vt < 8; ++vt) { const int v = 16 * vt + lj; f32x4 c = (f32x4){0.f, 0.f, 0.f, 0.f};
#pragma unroll
            for (int ks = 0; ks < 2; ++ks) c = MFMA16(ta[ks], *(const LAS bf16x8*)(VBT + e * 8192 + v * 64 + ((((4 * ks + g) ^ swt(v)) & 7) << 3)), c);
            const int t = 16 * q + 4 * g; u32x2 w; w.x = pk2(c[0], c[1]); w.y = pk2(c[2], c[3]);
            *(LAS u32x2*)(UTst + e * 8192 + v * 64 + t) = w; }
        bf16x8 tb[4][2];
#pragma unroll
        for (int tt = 0; tt < 4; ++tt)
#pragma unroll
            for (int ks = 0; ks < 2; ++ks) tb[tt][ks] = fragN(Te, 16 * tt + lj, 32 * ks, g, 72);
#pragma unroll
        for (int k2 = 0; k2 < 2; ++k2) { const int kt = 2 * q + k2, k = 16 * kt + lj; bf16x8 ka[2];
#pragma unroll
            for (int ks = 0; ks < 2; ++ks) ka[ks] = *(const LAS bf16x8*)(KBT + e * 8192 + k * 64 + ((((4 * ks + g) ^ swt(k)) & 7) << 3));
#pragma unroll
            for (int tt = 0; tt < 4; ++tt) { f32x4 c = (f32x4){0.f, 0.f, 0.f, 0.f};
#pragma unroll
                for (int ks = 0; ks < 2; ++ks) c = MFMA16(ka[ks], tb[tt][ks], c);
                const int t = 16 * tt + lj, kk = 16 * kt + 4 * g; u32x2 w; w.x = pk2(c[0], c[1]); w.y = pk2(c[2], c[3]);
                *(LAS u32x2*)(WMst + e * 8704 + t * 136 + kk) = w; } }
    }
    __syncthreads();
#pragma unroll
    for (int q = 0; q < 4; ++q) { const int pid = tid + 512 * q, e = pid >> 10, r10 = pid & 1023;
        { const int v = r10 >> 3, c = r10 & 7; *(u32x4*)(Pw + widx(dry, tid, (size_t)(lr0 + (v >> 1)) * PLD + C_GV + 128 * (2 * hq + e) + 64 * (v & 1) + 8 * c)) = *(const LAS u32x4*)(UTst + e * 8192 + v * 64 + 8 * c); }
        { const int t = r10 >> 4, c = r10 & 15; *(u32x4*)(WMo + (size_t)(cv0 + e) * 8192 + t * 128 + 8 * c) = *(const LAS u32x4*)(WMst + e * 8704 + t * 136 + 8 * c); } }
    __syncthreads();
}

DI void prep_hgrn(LAS unsigned char* lds, const KArgs& a, int b, int nl, int hi_, bool dry) {
    int tid_ = threadIdx.x; asm volatile("" : "+v"(tid_));
    const int tid = tid_, lane = tid & 63, wid = tid >> 6, lj = lane & 15, g = lane >> 4;
    unsigned char* ws = a.ws; u16* P = (u16*)(ws + WS_PROJ); u16* Pw = dry ? (u16*)(ws + WS_DUMMY) : P;
    const int lr0 = b * 1024 + 64 * nl; const int item = (b * 16 + nl) * 8 + hi_;
    LAS float* segs = (LAS float*)lds;
    LAS u16* Qs = (LAS u16*)(segs + 512);
    LAS u16* Ks = Qs + 64 * 136;
    const int k = tid & 127, seg = tid >> 7;
    float q[16], lf[16], vv[16];
#pragma unroll
    for (int r = 0; r < 16; ++r) { const size_t ro = (size_t)(lr0 + 16 * seg + r) * PLD + 128 * hi_ + k;
        q[r] = bf2f(P[ro + C_HQ]); lf[r] = h2f(P[ro + C_HF]); vv[r] = bf2f(P[ro + C_HI]); }
    float cs[16]; { float s = 0.f;
#pragma unroll
        for (int r = 0; r < 16; ++r) { s += lf[r]; cs[r] = s; } }
    segs[seg * 128 + k] = cs[15];
    __syncthreads();
    const float s0 = segs[k], s1 = segs[128 + k], s2 = segs[256 + k], s3 = segs[384 + k];
    const float pre = seg == 0 ? 0.f : (seg == 1 ? s0 : (seg == 2 ? s0 + s1 : s0 + s1 + s2));
    const float bmid = s0 + s1, bend = s0 + s1 + s2 + s3;
    float ke[16], qe[16];
#pragma unroll
    for (int r = 0; r < 16; ++r) { const float bb = pre + cs[r]; const float kh = -expm1f(lf[r]); const int t = 16 * seg + r;
        qe[r] = q[r] * __expf(bb); ke[r] = kh * __expf(bend - bb);
        Qs[t * 136 + k] = (u16)f2bf(q[r] * __expf(bb - bmid)); Ks[t * 136 + k] = (u16)f2bf(kh * __expf(bmid - bb)); }
#pragma unroll
    for (int r = 0; r < 16; ++r) Pw[widx(dry, tid, (size_t)(lr0 + 16 * seg + r) * PLD + C_HQ + 128 * hi_ + k)] = (u16)f2bf(qe[r]);
    { u16* kd = Pw + widx(dry, 2 * tid, (size_t)(lr0 + (k >> 1)) * PLD + C_HF + 128 * hi_ + 64 * (k & 1) + 16 * seg); u16* vd = Pw + widx(dry, 2 * tid, (size_t)(lr0 + (k >> 1)) * PLD + C_HI + 128 * hi_ + 64 * (k & 1) + 16 * seg);
        float t8[8];
#pragma unroll
        for (int h = 0; h < 2; ++h) {
#pragma unroll
            for (int e = 0; e < 8; ++e) t8[e] = ke[8 * h + e];
            *(u32x4*)(kd + 8 * h) = pack8(t8);
#pragma unroll
            for (int e = 0; e < 8; ++e) t8[e] = vv[8 * h + e];
            *(u32x4*)(vd + 8 * h) = pack8(t8); } }
    if (seg == 0) ((float*)(ws + WS_DEC))[(size_t)item * 128 + k] = __expf(bend);
    __syncthreads();
    u16* SCo = (u16*)(ws + WS_SC) + (size_t)item * 4096;
#pragma unroll 1
    for (int x = 0; x < 2; ++x) { const int tt = 2 * wid + x, mi = tt >> 2, ni = tt & 3; f32x4 c = (f32x4){0.f, 0.f, 0.f, 0.f};
        if (mi <= ni) {
#pragma unroll
            for (int ks = 0; ks < 4; ++ks) c = MFMA16(fragN(Ks, 16 * mi + lj, 32 * ks, g, 136), fragN(Qs, 16 * ni + lj, 32 * ks, g, 136), c); }
        const int t = 16 * ni + lj; float o4[4];
#pragma unroll
        for (int r = 0; r < 4; ++r) { const int s = 16 * mi + 4 * g + r; o4[r] = (s <= t) ? c[r] : 0.f; }
        u32x2 w; w.x = pk2(o4[0], o4[1]); w.y = pk2(o4[2], o4[3]);
        *(u32x2*)(SCo + t * 64 + 16 * mi + 4 * g) = w; }
    __syncthreads();
}

DI void norm_accum(const f32x4 (&o)[4], LAS float* tot, int lj, int g) {
#pragma unroll
    for (int mt = 0; mt < 4; ++mt) { f32x4 q = o[mt] * o[mt];
        q[0] = row16_sum(q[0]); q[1] = row16_sum(q[1]); q[2] = row16_sum(q[2]); q[3] = row16_sum(q[3]);
        if (lj == 0) {
#pragma unroll
            for (int r = 0; r < 4; ++r) (void)__hip_atomic_fetch_add(tot + 16 * mt + 4 * g + r, q[r], __ATOMIC_RELAXED, __HIP_MEMORY_SCOPE_WORKGROUP); } }
}
DI void norm_finish(const f32x4 (&o)[4], const LAS float* tot, LAS u16* GT, float gnv, u16* gdst  , int pitch, bool dry, u16* sink, int w, int lane, int lj, int g) {
#pragma unroll
    for (int mt = 0; mt < 4; ++mt) { const f32x4 tt = *(const LAS f32x4*)(tot + 16 * mt + 4 * g);
#pragma unroll
        for (int r = 0; r < 4; ++r) { LAS u16* gp = GT + (16 * mt + 4 * g + r) * 136 + 16 * w + lj; *gp = (u16)pk2(o[mt][r] * rsqrtf(tt[r] * (1.0f / 128.0f) + EPS) * gnv * bf2f(*gp), 0.f); } }
    asm volatile("s_waitcnt lgkmcnt(0)" ::: "memory");
#pragma unroll
    for (int q = 0; q < 2; ++q) { const int p = lane + 64 * q, row = p >> 1, hf = p & 1; const u32x4 v = *(const LAS u32x4*)(GT + row * 136 + 16 * w + 8 * hf);
        *(u32x4*)(dry ? sink : gdst + (size_t)row * pitch + 16 * w + 8 * hf) = v; }
}

DI void recur_gdn(LAS unsigned char* lds, const KArgs& a, int j, int b, int vh, bool dry) {
    int tid_ = threadIdx.x; asm volatile("" : "+v"(tid_));
    const int tid = tid_, lane = tid & 63, w = tid >> 6, lj = lane & 15, g = lane >> 4;
    unsigned char* ws = a.ws; u16* P = (u16*)(ws + WS_PROJ); u16* LT = (u16*)(ws + WS_LATE) + (size_t)(j & 1) * 4096 * LLD;
    LAS u16* QG = (LAS u16*)lds;
    LAS u16* WMs = QG + 64 * 136;
    LAS u16* KT = WMs + 64 * 136;
    LAS u16* UT = KT + 128 * 72;
    LAS u16* QKs = UT + 128 * 72;
    LAS float* gam = (LAS float*)(QKs + 64 * 72);
    LAS float* tot = gam + 192;
    LAS u16* GT = (LAS u16*)(tot + 128);
    const int hq = vh >> 1; const int chain = b * 16 + vh;
    float* ST = (float*)(ws + WS_STATE) + (size_t)chain * 16384;
    u16* sink = (u16*)(ws + WS_DUMMY) + 8 * tid;
    f32x4 S[8];
#pragma unroll
    for (int m = 0; m < 8; ++m) S[m] = (j == 0) ? (f32x4){0.f, 0.f, 0.f, 0.f} : *(const f32x4*)(ST + ((w * 8 + m) * 64 + lane) * 4);
    u32x4 R[11]; float Rg = 0.f;
    unsigned oA[2], oT[2], oS[2];
#pragma unroll
    for (int q = 0; q < 2; ++q) { const int pid = tid + 512 * q; oA[q] = (unsigned)((pid >> 4) * PLD + 8 * (pid & 15)) * 2u; const int x = pid >> 3, c = pid & 7; oT[q] = (unsigned)((x >> 1) * PLD + 64 * (x & 1) + 8 * c) * 2u;
        const int p = lane + 64 * q; oS[q] = (unsigned)((p >> 1) * LLD + 16 * w + 8 * (p & 1)) * 2u; }
    auto load_chunk = [&](int nl) {
        const int lr0 = b * 1024 + 64 * nl; const size_t cv = (size_t)((b * 16 + nl) * 16 + vh);
        const char* wm = (const char*)(ws + WS_WM) + cv * 16384; const char* qk = (const char*)(ws + WS_QK) + cv * 8192;
        const char* pq = (const char*)(P + (size_t)lr0 * PLD + C_GQ + 128 * hq); const char* pk = (const char*)(P + (size_t)lr0 * PLD + C_GK + 128 * hq);
        const char* pv = (const char*)(P + (size_t)lr0 * PLD + C_GV + 128 * vh); const char* pg = (const char*)(LT + (size_t)lr0 * LLD + L_GZ + 128 * vh);
#pragma unroll
        for (int q = 0; q < 2; ++q) { R[q] = *(const u32x4*)(pq + oA[q]); R[2 + q] = *(const u32x4*)(wm + (unsigned)(tid + 512 * q) * 16u); R[4 + q] = *(const u32x4*)(pk + oT[q]); R[6 + q] = *(const u32x4*)(pv + oT[q]); R[9 + q] = *(const u32x4*)(pg + oS[q]); }
        R[8] = *(const u32x4*)(qk + (unsigned)tid * 16u);
        if (tid < 64) Rg = ((const float*)(ws + WS_GAM))[cv * 64 + tid];
    };
    auto store_chunk = [&]() {
#pragma unroll
        for (int q = 0; q < 2; ++q) { const int pid = tid + 512 * q; st_perm(QG + (pid >> 4) * 136, pid & 15, R[q]); st_perm(WMs + (pid >> 4) * 136, pid & 15, R[2 + q]);
            st_perm(KT + (pid >> 3) * 72, pid & 7, R[4 + q]); *(LAS u32x4*)(UT + (pid >> 3) * 72 + 8 * (pid & 7)) = R[6 + q]; }
        st_perm(QKs + (tid >> 3) * 72, tid & 7, R[8]);
#pragma unroll
        for (int q = 0; q < 2; ++q) { const int p = lane + 64 * q; *(LAS u32x4*)(GT + (p >> 1) * 136 + 16 * w + 8 * (p & 1)) = R[9 + q]; }
        if (tid < 64) { const float ge = __shfl(Rg, 63); gam[tid] = __expf(Rg); gam[64 + tid] = __expf(ge - Rg); if (tid == 63) gam[128] = __expf(ge); }
    };
    const float gnv = a.in[I_GON][16 * w + lj];
    load_chunk(0);
    if (tid < 128) tot[tid] = 0.f;
    store_chunk();
#pragma unroll 1
    for (int nl = 0; nl < 16; ++nl) {
        __syncthreads();
        if (nl + 1 < 16) load_chunk(nl + 1);
        f32x4 vn[4], o[4];
        bf16x8 Sb[4];
#pragma unroll
        for (int kk = 0; kk < 4; ++kk) Sb[kk] = packacc(S[2 * kk], S[2 * kk + 1]);
        bf16x8 fa[3][4];
#define SBAR __builtin_amdgcn_sched_barrier(0)
#define LD_A(bf, M, mt, st) do { _Pragma("unroll") for (int kk = 0; kk < 4; ++kk) fa[bf][kk] = fragN(M, 16 * (mt) + lj, 32 * kk, g, st); } while (0)
#define LD_B(bf, M, m0) do { _Pragma("unroll") for (int m2 = 0; m2 < 2; ++m2) _Pragma("unroll") for (int tk = 0; tk < 2; ++tk) fa[bf][2 * m2 + tk] = fragN(M, 16 * ((m0) + m2) + lj, 32 * tk, g, 72); } while (0)
#define MF_W(bf, mt) do { f32x4 c = (f32x4){0.f, 0.f, 0.f, 0.f}; _Pragma("unroll") for (int kk = 0; kk < 4; ++kk) c = MFMA16(fa[bf][kk], Sb[kk], c); vn[mt] = c; } while (0)
#define MF_Q(bf, mt) do { f32x4 c2 = (f32x4){0.f, 0.f, 0.f, 0.f}; _Pragma("unroll") for (int kk = 0; kk < 4; ++kk) c2 = MFMA16(fa[bf][kk], Sb[kk], c2); \
            o[mt] = c2; } while (0)
#define MF_QK(bf, m0) do { _Pragma("unroll") for (int m2 = 0; m2 < 2; ++m2) { f32x4 c = (f32x4){0.f, 0.f, 0.f, 0.f}; _Pragma("unroll") for (int tk = 0; tk < 2; ++tk) c = MFMA16(fa[bf][2 * m2 + tk], vb[tk], c); dq[(m0) + m2] = c; } } while (0)
#define MF_KT(bf, m0) do { _Pragma("unroll") for (int m2 = 0; m2 < 2; ++m2) { f32x4 c = S[(m0) + m2] * eG; _Pragma("unroll") for (int tk = 0; tk < 2; ++tk) c = MFMA16(fa[bf][2 * m2 + tk], vsb[tk], c); S[(m0) + m2] = c; } } while (0)
        LD_A(0, WMs, 0, 136); LD_A(1, QG, 0, 136); SBAR;
        LD_A(2, WMs, 1, 136); SBAR; MF_W(0, 0); SBAR;
        LD_A(0, QG, 1, 136); SBAR; MF_Q(1, 0); SBAR;
        LD_A(1, WMs, 2, 136); SBAR; MF_W(2, 1); SBAR;
        LD_A(2, QG, 2, 136); SBAR; MF_Q(0, 1); SBAR;
        LD_A(0, WMs, 3, 136); SBAR; MF_W(1, 2); SBAR;
        LD_A(1, QG, 3, 136); SBAR; MF_Q(2, 2); SBAR;
        LD_B(2, QKs, 0); SBAR; MF_W(0, 3); SBAR;
        LD_B(0, QKs, 2); SBAR; MF_Q(1, 3); SBAR;
        bf16x8 vb[2], vsb[2]; f32x4 dq[4]; float eG;
        { u32x2 uw[4]; f32x4 es[4];
#pragma unroll
            for (int mt = 0; mt < 4; ++mt) { uw[mt] = *(const LAS u32x2*)(UT + (16 * w + lj) * 72 + 16 * mt + 4 * g); es[mt] = *(const LAS f32x4*)(gam + 64 + 16 * mt + 4 * g); }
            eG = gam[128];
            SBAR;
#pragma unroll
            for (int mt = 0; mt < 4; ++mt) { vn[mt][0] = bf2f(uw[mt].x & 0xffffu) - vn[mt][0]; vn[mt][1] = bf2f(uw[mt].x >> 16) - vn[mt][1]; vn[mt][2] = bf2f(uw[mt].y & 0xffffu) - vn[mt][2]; vn[mt][3] = bf2f(uw[mt].y >> 16) - vn[mt][3]; }
#pragma unroll
            for (int tk = 0; tk < 2; ++tk) { vb[tk] = packacc(vn[2 * tk], vn[2 * tk + 1]); vsb[tk] = packacc(vn[2 * tk] * es[2 * tk], vn[2 * tk + 1] * es[2 * tk + 1]); } }
        SBAR;
        LD_B(1, KT, 0); SBAR; MF_QK(2, 0); SBAR;
        LD_B(2, KT, 2); SBAR; MF_QK(0, 2); SBAR;
        LD_B(0, KT, 4); SBAR; MF_KT(1, 0); SBAR;
        LD_B(1, KT, 6); SBAR; MF_KT(2, 2); SBAR;
        MF_KT(0, 4); SBAR; MF_KT(1, 6); SBAR;
#undef LD_A
#undef LD_B
#undef MF_W
#undef MF_Q
#undef MF_QK
#undef MF_KT
#pragma unroll
        for (int mt = 0; mt < 4; ++mt) o[mt] = o[mt] * *(const LAS f32x4*)(gam + 16 * mt + 4 * g) + dq[mt];
        LAS float* tc = tot + 64 * (nl & 1);
        norm_accum(o, tc, lj, g);
        __syncthreads();
        norm_finish(o, tc, GT, gnv, LT + (size_t)(b * 1024 + 64 * nl) * LLD + L_GZ + 128 * vh, LLD, dry, sink, w, lane, lj, g);
        if (tid < 64) tot[64 * ((nl + 1) & 1) + tid] = 0.f;
        if (nl + 1 < 16) store_chunk();
    }
#pragma unroll
    for (int m = 0; m < 8; ++m) *(f32x4*)(ST + ((w * 8 + m) * 64 + lane) * 4) = S[m];
    __syncthreads();
}

DI void recur_hgrn(LAS unsigned char* lds, const KArgs& a, int j, int b, int hi_, bool dry) {
    int tid_ = threadIdx.x; asm volatile("" : "+v"(tid_));
    const int tid = tid_, lane = tid & 63, w = tid >> 6, lj = lane & 15, g = lane >> 4;
    unsigned char* ws = a.ws; u16* P = (u16*)(ws + WS_PROJ);
    LAS u16* QE = (LAS u16*)lds;
    LAS u16* KET = QE + 64 * 136;
    LAS u16* VT = KET + 128 * 72;
    LAS u16* SCs = VT + 128 * 72;
    LAS float* dec = (LAS float*)(SCs + 64 * 72);
    LAS float* tot = dec + 128;
    LAS u16* GT = (LAS u16*)(tot + 128);
    const int chain = 64 + b * 8 + hi_;
    float* ST = (float*)(ws + WS_STATE) + (size_t)chain * 16384;
    u16* sink = (u16*)(ws + WS_DUMMY) + 8 * tid;
    f32x4 S[8];
#pragma unroll
    for (int m = 0; m < 8; ++m) S[m] = (j == 0) ? (f32x4){0.f, 0.f, 0.f, 0.f} : *(const f32x4*)(ST + ((w * 8 + m) * 64 + lane) * 4);
    u32x4 R[9]; float Rd = 0.f;
    unsigned oA[2], oT[2], oS[2];
#pragma unroll
    for (int q = 0; q < 2; ++q) { const int pid = tid + 512 * q; oA[q] = (unsigned)((pid >> 4) * PLD + 8 * (pid & 15)) * 2u; const int x = pid >> 3, c = pid & 7; oT[q] = (unsigned)((x >> 1) * PLD + 64 * (x & 1) + 8 * c) * 2u;
        const int p = lane + 64 * q; oS[q] = (unsigned)((p >> 1) * PLD + 16 * w + 8 * (p & 1)) * 2u; }
    auto load_chunk = [&](int nl) {
        const int lr0 = b * 1024 + 64 * nl; const size_t item = (size_t)((b * 16 + nl) * 8 + hi_);
        const char* sc = (const char*)(ws + WS_SC) + item * 8192;
        const char* pq = (const char*)(P + (size_t)lr0 * PLD + C_HQ + 128 * hi_); const char* pk = (const char*)(P + (size_t)lr0 * PLD + C_HF + 128 * hi_);
        const char* pv = (const char*)(P + (size_t)lr0 * PLD + C_HI + 128 * hi_); const char* pg = (const char*)(P + (size_t)lr0 * PLD + C_HG + 128 * hi_);
#pragma unroll
        for (int q = 0; q < 2; ++q) { R[q] = *(const u32x4*)(pq + oA[q]); R[2 + q] = *(const u32x4*)(pk + oT[q]); R[4 + q] = *(const u32x4*)(pv + oT[q]); R[7 + q] = *(const u32x4*)(pg + oS[q]); }
        R[6] = *(const u32x4*)(sc + (unsigned)tid * 16u);
        if (tid < 128) Rd = ((const float*)(ws + WS_DEC))[item * 128 + tid];
    };
    auto store_chunk = [&]() {
#pragma unroll
        for (int q = 0; q < 2; ++q) { const int pid = tid + 512 * q; st_perm(QE + (pid >> 4) * 136, pid & 15, R[q]);
            *(LAS u32x4*)(KET + (pid >> 3) * 72 + 8 * (pid & 7)) = R[2 + q]; *(LAS u32x4*)(VT + (pid >> 3) * 72 + 8 * (pid & 7)) = R[4 + q]; }
        *(LAS u32x4*)(SCs + (tid >> 3) * 72 + 8 * (tid & 7)) = R[6];
#pragma unroll
        for (int q = 0; q < 2; ++q) { const int p = lane + 64 * q; *(LAS u32x4*)(GT + (p >> 1) * 136 + 16 * w + 8 * (p & 1)) = R[7 + q]; }
        if (tid < 128) dec[tid] = Rd;
    };
    const float gnv = a.in[I_HON][16 * w + lj];
    load_chunk(0);
    if (tid < 128) tot[tid] = 0.f;
    store_chunk();
#pragma unroll 1
    for (int nl = 0; nl < 16; ++nl) {
        __syncthreads();
        if (nl + 1 < 16) load_chunk(nl + 1);
        bf16x8 Sb[4];
#pragma unroll
        for (int kk = 0; kk < 4; ++kk) Sb[kk] = packacc(S[2 * kk], S[2 * kk + 1]);
        bf16x8 Vb[2];
#pragma unroll
        for (int tk = 0; tk < 2; ++tk) Vb[tk] = fragN(VT, 16 * w + lj, 32 * tk, g, 72);
        f32x4 o[4];
        bf16x8 fa[2][8];
#define LD_QS(bf, mt) do { _Pragma("unroll") for (int kk = 0; kk < 4; ++kk) fa[bf][kk] = fragN(QE, 16 * (mt) + lj, 32 * kk, g, 136); \
            _Pragma("unroll") for (int tk = 0; tk < 2; ++tk) fa[bf][4 + tk] = fragN(SCs, 16 * (mt) + lj, 32 * tk, g, 72); } while (0)
#define LD_KE(bf, m0) do { _Pragma("unroll") for (int m2 = 0; m2 < 4; ++m2) _Pragma("unroll") for (int tk = 0; tk < 2; ++tk) fa[bf][2 * m2 + tk] = fragN(KET, 16 * ((m0) + m2) + lj, 32 * tk, g, 72); } while (0)
#define MF_QS(bf, mt) do { f32x4 c = (f32x4){0.f, 0.f, 0.f, 0.f}; _Pragma("unroll") for (int kk = 0; kk < 4; ++kk) c = MFMA16(fa[bf][kk], Sb[kk], c); \
            _Pragma("unroll") for (int tk = 0; tk < 2; ++tk) c = MFMA16(fa[bf][4 + tk], Vb[tk], c); o[mt] = c; } while (0)
#define MF_KE(bf, m0) do { _Pragma("unroll") for (int m2 = 0; m2 < 4; ++m2) { f32x4 c = S[(m0) + m2] * *(const LAS f32x4*)(dec + 16 * ((m0) + m2) + 4 * g); \
            _Pragma("unroll") for (int tk = 0; tk < 2; ++tk) c = MFMA16(fa[bf][2 * m2 + tk], Vb[tk], c); S[(m0) + m2] = c; } } while (0)
        LD_QS(0, 0); SBAR;
        LD_QS(1, 1); SBAR; MF_QS(0, 0); SBAR;
        LD_QS(0, 2); SBAR; MF_QS(1, 1); SBAR;
        LD_QS(1, 3); SBAR; MF_QS(0, 2); SBAR;
        LD_KE(0, 0); SBAR; MF_QS(1, 3); SBAR;
        LD_KE(1, 4); SBAR; MF_KE(0, 0); SBAR;
        MF_KE(1, 4); SBAR;
#undef LD_QS
#undef LD_KE
#undef MF_QS
#undef MF_KE
        LAS float* tc = tot + 64 * (nl & 1);
        norm_accum(o, tc, lj, g);
        __syncthreads();
        norm_finish(o, tc, GT, gnv, P + (size_t)(b * 1024 + 64 * nl) * PLD + C_HG + 128 * hi_, PLD, dry, sink, w, lane, lj, g);
        if (tid < 64) tot[64 * ((nl + 1) & 1) + tid] = 0.f;
        if (nl + 1 < 16) store_chunk();
    }
#pragma unroll
    for (int m = 0; m < 8; ++m) *(f32x4*)(ST + ((w * 8 + m) * 64 + lane) * 4) = S[m];
    __syncthreads();
}

#ifdef ONLY
#define EN(k) (ONLY == (k))
#else
#define EN(k) 1
#endif
__global__ void __launch_bounds__(512, 2) mk_fwd(KArgs a) {
    extern __shared__ __attribute__((aligned(16))) unsigned char lds_raw[];
    LAS unsigned char* lds = (LAS unsigned char*)lds_raw;
    cg::grid_group grid = cg::this_grid();
    volatile LAS unsigned* bst = (volatile LAS unsigned*)(lds + LDS_BYTES - 64);
    if (threadIdx.x < 2) bst[threadIdx.x] = 0u;
    __syncthreads();
    const XcdBarrier xbar = xcd_barrier_post((unsigned*)(a.ws + WS_BAR), bst);
    int seam = 0;
#define GRID_BAR() do { if (seam == 0) grid.sync(); else xcd_barrier(xbar); ++seam; } while (0)
    const int G = gridDim.x, bx = blockIdx.x;
    unsigned char* ws = a.ws;
    float* ssb = (float*)(ws + WS_SS);
    u16* XN = (u16*)(ws + WS_XN);

#pragma unroll 1
    for (int ph = a.ph_lo; ph < a.ph_hi; ++ph) {
        const int ptype = ph == 0 ? 0 : (ph == 1 || ph == 20) ? 1 : (ph == 2 || ph == 19 || ph == 21) ? 2 : ph == 22 ? 7 : 3 + ((ph - 3) & 3);
        (void)ptype;
        {
        constexpr bool dry = false;
        int tid_ = threadIdx.x; asm volatile("" : "+v"(tid_));
        const int tid = tid_, lane = tid & 63, wave = tid >> 6;
        const int gw = bx * 8 + wave, ngw = G * 8;
        LAS float* scr = (LAS float*)(lds + wave * 16384);
        if (EN(0) && ph == 0) {
            convert_weight(a.in[I_F1WI], DM, 2 * DFF, (u16*)(ws + WS_WFI), DM, 0, 1, scr, gw, ngw, lane);
            convert_weight(a.in[I_F1WO], DFF, DM, (u16*)(ws + WS_WFO), DFF, 0, 0, scr, gw, ngw, lane);
            convert_weight(a.in[I_WIN], DM, INW, (u16*)(ws + WS_WIN), DM, 0, 2, scr, gw, ngw, lane);
            convert_weight(a.in[I_WBH], DM, DM, (u16*)(ws + WS_WB), 3072, 0, 0, scr, gw, ngw, lane);
            convert_weight(a.in[I_WBG], 2048, DM, (u16*)(ws + WS_WB), 3072, 1024, 0, scr, gw, ngw, lane);
            convert_weight(a.in[I_WOUT], DM, DM, (u16*)(ws + WS_WOUT), DM, 0, 0, scr, gw, ngw, lane);
            if (bx < 64) { const int idx = bx * 512 + tid; const int k = idx >> 5, c = idx & 31; ((u16*)(ws + WS_WAB))[c * 1024 + k] = (u16)f2bf(a.in[I_WIN][(size_t)k * INW + 8192 + c]); }
            for (int m = gw; m < T_TOK; m += ngw) {
                const f32x4* xr = (const f32x4*)(a.in[I_X] + (size_t)m * DM) + lane; const f32x4* gr = (const f32x4*)a.in[I_F1N] + lane; float s = 0.f;
                unsigned long long* o8 = (unsigned long long*)(XN + (size_t)m * DM) + lane;
#pragma unroll
                for (int q = 0; q < 4; ++q) { const f32x4 v = xr[64 * q], gg = gr[64 * q]; s += (v[0] * v[0] + v[1] * v[1]) + (v[2] * v[2] + v[3] * v[3]);
                    o8[64 * q] = (unsigned long long)pk2(v[0] * gg[0], v[1] * gg[1]) | ((unsigned long long)pk2(v[2] * gg[2], v[3] * gg[3]) << 32); }
                s = wave_sum(s);
                if (lane == 0) { ssb[m] = s; ssb[T_TOK + m] = 0.f; ssb[2 * T_TOK + m] = 0.f; ssb[3 * T_TOK + m] = 0.f; }
            }
        } else if (EN(1) && (ph == 1 || ph == 20)) {
            SchedStd S; S.A = (const char*)(ws + (ph == 1 ? WS_XN : WS_XN3)); S.B = (const char*)(ws + WS_WFI); S.lda = DM; S.ldb = DM; S.nt = 16; S.O.init(64, 22, G, bx);
            EpiSwiglu E; E.H = (u16*)(ws + WS_HID); E.ss = ssb + (ph == 1 ? 0 : 2 * T_TOK);
            pg8::gemm_phase(lds, S, E);
        } else if (EN(2) && (ph == 2 || ph == 19 || ph == 21)) {
            SchedStd S; EpiResid E;
            if (ph == 19) { S.A = (const char*)(ws + WS_XN); S.B = (const char*)(ws + WS_WOUT); S.lda = DM; S.ldb = DM; S.nt = 16;
                E.base = a.out; E.scale = 1.0f; E.xn = (u16*)(ws + WS_XN3); E.g = a.in[I_F2N]; E.ss_out = ssb + 2 * T_TOK; }
            else { S.A = (const char*)(ws + WS_HID); S.B = (const char*)(ws + WS_WFO); S.lda = DFF; S.ldb = DFF; S.nt = 44;
                E.base = ph == 2 ? a.in[I_X] : a.out; E.scale = 0.5f; E.xn = ph == 2 ? XN : nullptr; E.g = a.in[I_MIXN]; E.ss_out = ssb + (ph == 2 ? T_TOK : 3 * T_TOK); }
            E.out = a.out; E.dry = dry; E.dummy = (float*)(ws + WS_DUMMY); S.O.init(64, 4, G, bx);
            pg8::gemm_phase(lds, S, E);
        } else if (ph < 19) {
            const int j = (ph - 3) >> 2, sub = (ph - 3) & 3;
            if (EN(3) && sub == 0) {
                SchedG3 S; S.A = (const char*)XN; S.B = (const char*)(ws + WS_WIN); S.lda = DM; S.ldb = DM; S.nt = 16; S.j = j; S.pn0 = 0; S.perm = (j != 0); S.O.init(16, j == 0 ? 48 : 32, G, bx);
                EpiProj E; E.P = (u16*)(ws + WS_PROJ); E.L = (u16*)(ws + WS_LATE) + (size_t)(j & 1) * 4096 * LLD; E.ss = ssb + T_TOK; E.lbl = a.in[I_LBL]; E.halo = (u16*)(ws + WS_HALO); E.j = j; E.pn0 = 0; E.perm = (j != 0);
                pg8::gemm_phase(lds, S, E);
                if (j == 0) { for (int it = bx; it < 256; it += G) gab_item(lds, a, it * 64); }
            } else if (sub == 1) {
#pragma unroll 1
                for (int it = bx; it < 1024; it += G) {
                    if (EN(4) && it < 512) { if (!(dry && (a.probe & 0x4000))) prep_gdn(lds, a, j, it >> 7, (it >> 3) & 15, it & 7, dry); }
                    else if (EN(5) && it >= 512) { const int i2 = it - 512; if (!(dry && (a.probe & 0x8000))) prep_hgrn(lds, a, i2 >> 7, (i2 >> 3) & 15, i2 & 7, dry); }
                }
            } else if (sub == 2) {
                if (j < 3 && bx >= 96 && !dry) {
                    SchedG3 S; S.A = (const char*)XN; S.B = (const char*)(ws + WS_WIN); S.lda = DM; S.ldb = DM; S.nt = 16; S.j = j + 1; S.pn0 = 32; S.perm = 0; S.O.init(16, 16, G - 96, bx - 96);
                    EpiProj E; E.P = (u16*)(ws + WS_PROJ); E.L = (u16*)(ws + WS_LATE) + (size_t)((j + 1) & 1) * 4096 * LLD; E.ss = ssb + T_TOK; E.lbl = a.in[I_LBL]; E.halo = (u16*)(ws + WS_HALO); E.j = j + 1; E.pn0 = 32; E.perm = 0;
                    pg8::gemm_phase(lds, S, E);
                }
                if (j == 3 && bx >= 96 && !dry) {
                    const int gw2 = (bx - 96) * 8 + wave, ngw2 = (G - 96) * 8;
                    convert_weight(a.in[I_F2WI], DM, 2 * DFF, (u16*)(ws + WS_WFI), DM, 0, 1, scr, gw2, ngw2, lane);
                    convert_weight(a.in[I_F2WO], DFF, DM, (u16*)(ws + WS_WFO), DFF, 0, 0, scr, gw2, ngw2, lane);
                }
#pragma unroll 1
                for (int c = bx; c < 96; c += G) {
                    if (EN(6) && c < 64) { { const int pr = (c & 7) + 8 * (c >> 4), ch = 2 * pr + ((c >> 3) & 1); recur_gdn(lds, a, j, ch >> 4, ch & 15, false); } }
                    else if (EN(7) && c >= 64) { recur_hgrn(lds, a, j, (c - 64) >> 3, (c - 64) & 7, false); }
                }
            } else if (EN(8)) {
                SchedG4 S; S.P = (const char*)(ws + WS_PROJ); S.L = (const char*)(ws + WS_LATE) + (size_t)(j & 1) * 4096 * LLD * 2; S.B = (const char*)(ws + WS_WB); S.lda = (bx % 3 == 0) ? PLD : LLD; S.ldb = 3072; S.c = bx;
                EpiG4 E; E.L = (const u16*)(ws + WS_LATE) + (size_t)(j & 1) * 4096 * LLD; E.Y = (u16*)(ws + WS_XN); E.TMP = (u16*)(ws + (j == 3 ? WS_WM : WS_WFI)); E.flags = (unsigned*)(ws + WS_BAR) + 3584; E.j = j;
                pg8::gemm_phase(lds, S, E);
            }
        } else {
            const float* ss4 = ssb + 3 * T_TOK;
            for (int m = gw; m < T_TOK; m += ngw) { f32x4* xr = (f32x4*)(a.out + (size_t)m * DM) + lane; const f32x4* gr = (const f32x4*)a.in[I_FINN] + lane;
                f32x4* xw = dry ? (f32x4*)(ws + WS_DUMMY) + lane : xr;
                const float rs = rsqrtf(ss4[m] * (1.0f / 1024.0f) + EPS);
#pragma unroll
                for (int q = 0; q < 4; ++q) xw[dry ? 0 : 64 * q] = xr[64 * q] * gr[64 * q] * rs; }
        }
        if (dry) GRID_BAR();
        }
        if (ph + 1 < a.ph_hi) GRID_BAR();
    }
}

#ifndef PROBE_MASK
#define PROBE_MASK 0
#endif
extern "C" void kernel_launch(void* const* d_in, const int* in_sizes, int n_in, void* d_out, int out_size, void* d_ws, size_t ws_size, hipStream_t stream) {
    static int grid = 0;
    if (grid == 0) {
        if (n_in != 19 || ws_size < WS_END) { fprintf(stderr, "kernel_launch: unexpected inputs (n_in %d, ws %zu)\n", n_in, ws_size); grid = -1; return; }
        int dev = 0, cus = 0, per_cu = 0;
        hipGetDevice(&dev); hipDeviceGetAttribute(&cus, hipDeviceAttributeMultiprocessorCount, dev);
        hipFuncSetAttribute((const void*)mk_fwd, hipFuncAttributeMaxDynamicSharedMemorySize, LDS_BYTES);
        hipOccupancyMaxActiveBlocksPerMultiprocessor(&per_cu, (const void*)mk_fwd, 512, LDS_BYTES);
        if (per_cu < 1) { fprintf(stderr, "kernel_launch: occupancy query says %d blocks per CU\n", per_cu); per_cu = 1; }
        if (per_cu > 1) per_cu = 1;
        grid = cus * per_cu;
    }
    if (grid < 0) return;
    if (hipMemsetAsync((char*)d_ws + WS_BAR, 0, BAR_BYTES, stream) != hipSuccess) { fprintf(stderr, "kernel_launch: memset failed\n"); return; }
    KArgs a{};
    for (int i = 0; i < 19; ++i) a.in[i] = (const float*)d_in[i];
    a.out = (float*)d_out; a.ws = (unsigned char*)d_ws; a.ph_lo = 0; a.ph_hi = 23; a.probe = PROBE_MASK;
    void* args[] = {&a};
    hipError_t e = hipLaunchCooperativeKernel((const void*)mk_fwd, dim3(grid), dim3(512), args, LDS_BYTES, stream);
    if (e != hipSuccess) fprintf(stderr, "cooperative launch failed: %s (grid %d)\n", hipGetErrorString(e), grid);
}
```

```cpp
#define PROBE_MASK 0x0
#include <hip/hip_runtime.h>
#include <hip/hip_cooperative_groups.h>
#include <cstdio>
namespace cg = cooperative_groups;

#define DI __device__ __forceinline__
#define LAS __attribute__((address_space(3)))
typedef unsigned short u16;
typedef short bf16x8 __attribute__((ext_vector_type(8)));
typedef float f32x4 __attribute__((ext_vector_type(4)));
typedef unsigned u32x4 __attribute__((ext_vector_type(4)));
typedef unsigned u32x2 __attribute__((ext_vector_type(2)));

constexpr int T_TOK = 16384, DM = 1024, DFF = 2816, INW = 12320;
constexpr int PLD = 8192;
constexpr int LLD = 4096;
constexpr int L_GZ = 0, L_GH = 2048, L_GG = 3072;
constexpr int C_HQ = 0, C_HF = 1024, C_HI = 2048, C_HG = 3072, C_GQ = 4096, C_GK = 5120, C_GV = 6144;
constexpr float EPS = 1e-6f;
constexpr size_t MiB = 1u << 20;
constexpr size_t WS_BAR = 512 * 1024, BAR_BYTES = 16384;
constexpr size_t WS_WAB = 256 * 1024;
constexpr size_t WS_SS = 0;
constexpr size_t WS_WIN = 1 * MiB, WS_WB = 25 * MiB, WS_WOUT = 31 * MiB;
constexpr size_t WS_WFI = 33 * MiB, WS_WFO = 44 * MiB;
constexpr size_t WS_XN = 50 * MiB;
constexpr size_t WS_XN3 = 82 * MiB;
constexpr size_t WS_SC = 82 * MiB, WS_WM = 86 * MiB, WS_QK = 102 * MiB, WS_HALO = 110 * MiB;
constexpr size_t WS_HID = 114 * MiB, WS_PROJ = 114 * MiB, WS_LATE = 178 * MiB;
constexpr size_t WS_STATE = 242 * MiB, WS_GAM = 248 * MiB, WS_DEC = 248 * MiB + 512 * 1024;
constexpr size_t WS_DUMMY = 248 * MiB + 768 * 1024;
constexpr size_t WS_GBG = 249 * MiB, WS_GBB = 250 * MiB;
constexpr size_t WS_TMP = 251 * MiB;
constexpr size_t WS_END = 256 * MiB;
constexpr int LDS_BYTES = 159744;

DI unsigned f2bf(float f) { unsigned u = __float_as_uint(f); return (u + 0x7fffu + ((u >> 16) & 1u)) >> 16; }
typedef float f32x2_t __attribute__((ext_vector_type(2)));
typedef __bf16 bf16x2_t __attribute__((ext_vector_type(2)));
DI unsigned pk2(float lo, float hi) { const f32x2_t v = {lo, hi}; return __builtin_bit_cast(unsigned, __builtin_convertvector(v, bf16x2_t)); }
DI float bf2f(unsigned b) { return __uint_as_float(b << 16); }
DI void unpack8(u32x4 w, float (&f)[8]) {
    f[0] = __uint_as_float(w.x << 16); f[1] = __uint_as_float(w.x & 0xffff0000u); f[2] = __uint_as_float(w.y << 16); f[3] = __uint_as_float(w.y & 0xffff0000u);
    f[4] = __uint_as_float(w.z << 16); f[5] = __uint_as_float(w.z & 0xffff0000u); f[6] = __uint_as_float(w.w << 16); f[7] = __uint_as_float(w.w & 0xffff0000u);
}
DI u32x4 pack8(const float (&f)[8]) { u32x4 w; w.x = pk2(f[0], f[1]); w.y = pk2(f[2], f[3]); w.z = pk2(f[4], f[5]); w.w = pk2(f[6], f[7]); return w; }
DI float wave_sum(float v) {
#pragma unroll
    for (int o = 1; o < 64; o <<= 1) v += __shfl_xor(v, o);
    return v;
}
#define DPP_ROR(x, n) __builtin_bit_cast(float, __builtin_amdgcn_update_dpp(0, __builtin_bit_cast(int, (x)), 0x120 + (n), 0xf, 0xf, false))
DI float row16_sum(float x) { x += DPP_ROR(x, 8); x += DPP_ROR(x, 4); x += DPP_ROR(x, 2); x += DPP_ROR(x, 1); return x; }
DI float sigm(float x) { return __builtin_amdgcn_rcpf(1.0f + __expf(-x)); }
DI unsigned cvt_pk_bf16(float lo, float hi) { unsigned r; asm volatile("v_cvt_pk_bf16_f32 %0, %1, %2" : "=v"(r) : "v"(lo), "v"(hi)); return r; }
DI unsigned short f2h(float f) { _Float16 h = (_Float16)f; return __builtin_bit_cast(unsigned short, h); }
DI float h2f(unsigned short b) { return (float)__builtin_bit_cast(_Float16, b); }
DI void st_perm(LAS u16* row, int c, u32x4 v) { const int cc = c & 3; LAS u16* p = row + ((8 * c) & ~31) + 16 * (cc & 1) + 4 * (cc >> 1);
    u32x2 lo, hi; lo.x = v.x; lo.y = v.y; hi.x = v.z; hi.y = v.w; *(LAS u32x2*)p = lo; *(LAS u32x2*)(p + 8) = hi; }
DI size_t widx(bool dry, int tid, size_t idx) { return dry ? (size_t)tid * 8 : idx; }
DI bf16x8 mk8(u32x2 lo, u32x2 hi) { u32x4 w; w.x = lo.x; w.y = lo.y; w.z = hi.x; w.w = hi.y; return __builtin_bit_cast(bf16x8, w); }
DI bf16x8 packacc(f32x4 a, f32x4 b) { u32x4 w; w.x = pk2(a[0], a[1]); w.y = pk2(a[2], a[3]); w.z = pk2(b[0], b[1]); w.w = pk2(b[2], b[3]); return __builtin_bit_cast(bf16x8, w); }
#define MFMA16(a, b, c) __builtin_amdgcn_mfma_f32_16x16x32_bf16((a), (b), (c), 0, 0, 0)
DI bf16x8 fragN(const LAS u16* M, int row, int k0, int g, int stride) { return *(const LAS bf16x8*)(M + row * stride + k0 + 8 * g); }
DI bf16x8 fragP(const LAS u16* M, int row, int k0, int g, int stride) {
    const LAS u16* p = M + row * stride + k0 + 4 * g;
    return mk8(*(const LAS u32x2*)p, *(const LAS u32x2*)(p + 16));
}

#define XB_TMO      128
#define XB_XCNT(j)  (256  + 64 * (j))
#define XB_XSUB(j)  (1280 + 64 * (j))
#define XB_XGEN(j)  (2304 + 64 * (j))
#define XB_TOP      3328
#define XB_TOPGEN   3392
#define XCD_BAR_WORDS 3456
#define XB_SPIN_CAP (1u << 18)

__device__ __forceinline__ unsigned xb_ld(unsigned* p)              { return __hip_atomic_load(p, __ATOMIC_RELAXED, __HIP_MEMORY_SCOPE_AGENT); }
__device__ __forceinline__ unsigned xb_add(unsigned* p, unsigned v) { return __hip_atomic_fetch_add(p, v, __ATOMIC_RELAXED, __HIP_MEMORY_SCOPE_AGENT); }
__device__ __forceinline__ unsigned xb_xcc_id() { return (unsigned)__builtin_amdgcn_s_getreg((3 << 11) | 20) & 0xFu; }
#define XB_SPIN(cond, bar) do { unsigned _sp = 0; while (cond) { __builtin_amdgcn_s_sleep(1); \
    if ((++_sp & 255u) == 0u) { if (xb_ld(&(bar)[XB_TMO])) break; if (_sp > XB_SPIN_CAP) { atomicAdd(&(bar)[XB_TMO], 1u); break; } } } } while (0)

struct XcdBarrier {
    unsigned* bar; unsigned x;
    volatile LAS unsigned* st;
};

__device__ __forceinline__ XcdBarrier xcd_barrier_post(unsigned* bar, volatile LAS unsigned* st) {
    XcdBarrier b; b.bar = bar; b.x = xb_xcc_id(); b.st = st;
    if (threadIdx.x == 0) (void)xb_add(&bar[XB_XCNT(b.x)], 1u);
    return b;
}
__device__ __forceinline__ void xcd_barrier_complete(unsigned* bar, unsigned x, unsigned& nloc, unsigned& nx) {
    const unsigned G = gridDim.x * gridDim.y * gridDim.z;
    unsigned sum, cnt, mine, sp = 0u;
    for (;;) {
        sum = 0u; cnt = 0u; mine = 0u;
#pragma unroll
        for (unsigned j = 0; j < 16; ++j) { const unsigned c = xb_ld(&bar[XB_XCNT(j)]); sum += c; cnt += (c > 0u) ? 1u : 0u; mine = (j == x) ? c : mine; }
        if (sum == G) break;
        __builtin_amdgcn_s_sleep(1);
        if ((++sp & 255u) == 0u) { if (xb_ld(&bar[XB_TMO])) break; if (sp > XB_SPIN_CAP) { atomicAdd(&bar[XB_TMO], 1u); break; } }
    }
    nloc = mine > 0u ? mine : 1u; nx = cnt > 0u ? cnt : 1u;
}

__device__ __forceinline__ void xcd_barrier(const XcdBarrier& b) {
    asm volatile("s_waitcnt vmcnt(0)" ::: "memory");
    __syncthreads();
    if (threadIdx.x == 0) {
        unsigned* bar = b.bar;
        __builtin_amdgcn_s_waitcnt(0);
        unsigned nloc = b.st[0], nx = b.st[1];
        if (nloc == 0u) { xcd_barrier_complete(bar, b.x, nloc, nx); b.st[0] = nloc; b.st[1] = nx; }
        const unsigned old = xb_add(&bar[XB_XSUB(b.x)], 1u);
        const unsigned gen = old / nloc;
        if (old + 1u == (gen + 1u) * nloc) {
            __builtin_amdgcn_fence(__ATOMIC_RELEASE, "agent");
            asm volatile("s_waitcnt vmcnt(0)" ::: "memory");
            const unsigned og = xb_add(&bar[XB_TOP], 1u);
            const unsigned tg = og / nx;
            if (og + 1u == (tg + 1u) * nx) xb_add(&bar[XB_TOPGEN], 1u);
            else XB_SPIN(xb_ld(&bar[XB_TOPGEN]) == tg, bar);
            __builtin_amdgcn_fence(__ATOMIC_ACQUIRE, "agent");
            xb_add(&bar[XB_XGEN(b.x)], 1u);
            asm volatile("s_waitcnt vmcnt(0)" ::: "memory");
        } else {
            XB_SPIN(xb_ld(&bar[XB_XGEN(b.x)]) == gen, bar);
            __builtin_amdgcn_fence(__ATOMIC_ACQUIRE, "agent");
            asm volatile("s_waitcnt vmcnt(0)" ::: "memory");
        }
    }
    __syncthreads();
}


namespace pg8 {
constexpr int BM = 256, BK = 64, HALF = 128, HTB = HALF * BK * 2, NXCD = 8, WGM = 8;
DI int lds_byte(int r, int c) { const int st = (r >> 4) * 2 + (c >> 5), rr = r & 15, cc = c & 31, ob = rr * 64 + cc * 2; return st * 1024 + (ob ^ (((ob >> 9) & 1) << 5)); }
DI void stage_rc(int b, int& R, int& C) { const int st = b / 1024, sb = b % 1024, swz = sb ^ (((sb >> 9) & 1) << 5); R = (st >> 1) * 16 + swz / 64; C = (st & 1) * 32 + (swz % 64) / 2; }
DI int perm32(int rho) { const int n = rho >> 4, i = rho & 15; return 8 * (i >> 2) + 4 * n + (i & 3); }
struct Unit { int pm, pn, part; };
struct Order {
    int nM, nN, nwg, G, c;
    DI void init(int nM_, int nN_, int G_, int c_) { nM = nM_; nN = nN_; nwg = nM * nN; G = G_; c = c_; }
    DI bool next(int i, Unit& u) const {
        const long L = (long)i * G + c; if (L >= nwg) return false;
        int wgid = (int)L; { const int q = nwg / NXCD, r = nwg % NXCD, xcd = wgid % NXCD, off = wgid / NXCD; wgid = (xcd < r ? xcd * (q + 1) : r * (q + 1) + (xcd - r) * q) + off; }
        const int nig = WGM * nN, gid = wgid / nig, fm = gid * WGM, gsz = (nM - fm) < WGM ? (nM - fm) : WGM;
        u.pm = fm + ((wgid % nig) % gsz); u.pn = (wgid % nig) / gsz; u.part = 0; return true;
    }
};

template <class Epi, class Sched>
DI void gemm_phase(LAS unsigned char* lds, const Sched& S, const Epi& E) {
    int tid_ = threadIdx.x; asm volatile("" : "+v"(tid_));
    const int tid = tid_, wid = __builtin_amdgcn_readfirstlane(tid >> 6), lane = tid & 63, wr = wid >> 2, wc = wid & 3, fr = lane & 15, fq = lane >> 4;
    unsigned voffA[2], voffB[2];
#pragma unroll
    for (int i = 0; i < 2; ++i) { int R, C; stage_rc(tid * 16 + i * 8192, R, C); const int Rb = Epi::PERM ? ((R & ~31) + perm32(R & 31)) : R;
        voffA[i] = (unsigned)(R * S.lda + C) * 2u; voffB[i] = (unsigned)(Rb * S.ldb + C) * 2u; }
    const size_t kstep = (size_t)(BK * 2);
    const size_t hstepA = (size_t)HALF * S.lda * 2, hstepB = (size_t)HALF * S.ldb * 2;
    const unsigned ldsw = (unsigned)wid * 1024u;
    const int aoff = lds_byte(wr * 64 + fr, fq * 8), boff = lds_byte(wc * 32 + fr, fq * 8);
#define PG8_SA(b, h) (((b) * 2 + (h)) * HTB)
#define PG8_SB(b, h) ((4 + (b) * 2 + (h)) * HTB)
#define PG8_STAGE(bufoff, gbase, voff) do { _Pragma("unroll") for (int _i = 0; _i < 2; ++_i) \
        __builtin_amdgcn_global_load_lds((const unsigned*)((const char*)(gbase) + (voff)[_i]), (LAS unsigned*)(lds + (bufoff) + ldsw + _i * 8192), 16, 0, 0); } while (0)
#define PG8_LDA(dst, b, h) do { _Pragma("unroll") for (int m = 0; m < 4; ++m) _Pragma("unroll") for (int k = 0; k < 2; ++k) dst[m][k] = *(const LAS bf16x8*)(lds + PG8_SA(b, h) + aoff + m * 2048 + k * 1024); } while (0)
#define PG8_LDB(dst, b, h) do { _Pragma("unroll") for (int n = 0; n < 2; ++n) _Pragma("unroll") for (int k = 0; k < 2; ++k) dst[n][k] = *(const LAS bf16x8*)(lds + PG8_SB(b, h) + boff + n * 2048 + k * 1024); } while (0)
#define PG8_MMA(ai, bj, At, Bt) do { __builtin_amdgcn_s_setprio(1); _Pragma("unroll") for (int m = 0; m < 4; ++m) _Pragma("unroll") for (int n = 0; n < 2; ++n) _Pragma("unroll") for (int k = 0; k < 2; ++k) \
        acc[ai][bj][m][n] = __builtin_amdgcn_mfma_f32_16x16x32_bf16(Bt[n][k], At[m][k], acc[ai][bj][m][n], 0, 0, 0); __builtin_amdgcn_s_setprio(0); } while (0)
#define PG8_WAIT_V(n) asm volatile("s_waitcnt vmcnt(" #n ")" ::: "memory")
#define PG8_WAIT_L(n) asm volatile("s_waitcnt lgkmcnt(" #n ")" ::: "memory")
#define PG8_BAR __builtin_amdgcn_s_barrier()
#define PG8_SCHED __builtin_amdgcn_sched_barrier(0)
    Unit cur, nxt; int ui = 0;
    if (!S.next(0, cur)) return;
    f32x4 acc[2][2][4][2];
#pragma unroll
    for (int a = 0; a < 2; ++a)
#pragma unroll
        for (int b = 0; b < 2; ++b)
#pragma unroll
            for (int m = 0; m < 4; ++m)
#pragma unroll
                for (int n = 0; n < 2; ++n) acc[a][b][m][n] = (f32x4){0.f, 0.f, 0.f, 0.f};
    bf16x8 At[4][2], B0[2][2], B1[2][2];
    const char* cA; const char* cB; S.ptrs(cur, cA, cB);
    PG8_STAGE(PG8_SB(0, 0), cB, voffB); PG8_STAGE(PG8_SB(0, 1), cB + hstepB, voffB); PG8_STAGE(PG8_SA(0, 0), cA, voffA); PG8_STAGE(PG8_SA(0, 1), cA + hstepA, voffA);
    if (wr == 1) PG8_BAR;
    PG8_WAIT_V(2); PG8_BAR;
    PG8_STAGE(PG8_SB(1, 0), cB + kstep, voffB); PG8_STAGE(PG8_SA(1, 0), cA + kstep, voffA); PG8_STAGE(PG8_SB(1, 1), cB + hstepB + kstep, voffB);
    PG8_WAIT_V(6); PG8_BAR;
    for (;;) {
        const bool has_next = S.next(ui + 1, nxt); const int nt = S.ntu(cur);
        const char* nA = cA; const char* nB = cB; if (has_next) S.ptrs(nxt, nA, nB);
        for (int t = 0; t < nt; t += 2) {
            const bool last = (t == nt - 2);
            const char* a1 = cA + (size_t)(t + 1) * kstep;
            const char* a2 = last ? nA : cA + (size_t)(t + 2) * kstep; const char* b2 = last ? nB : cB + (size_t)(t + 2) * kstep;
            const char* a3 = a2 + kstep; const char* b3 = b2 + kstep;
            PG8_LDB(B0, 0, 0); PG8_LDB(B1, 0, 1); PG8_SCHED; PG8_LDA(At, 0, 0); PG8_STAGE(PG8_SA(1, 1), a1 + hstepA, voffA);
            PG8_WAIT_V(8); PG8_WAIT_L(0); PG8_BAR; PG8_MMA(0, 0, At, B0); PG8_MMA(0, 1, At, B1); PG8_BAR; PG8_SCHED;
            PG8_LDA(At, 0, 1); PG8_STAGE(PG8_SB(0, 0), b2, voffB); PG8_STAGE(PG8_SB(0, 1), b2 + hstepB, voffB); PG8_STAGE(PG8_SA(0, 0), a2, voffA);
            PG8_WAIT_V(8); PG8_WAIT_L(0); PG8_BAR; PG8_MMA(1, 0, At, B0); PG8_MMA(1, 1, At, B1); PG8_BAR; PG8_SCHED;
            PG8_LDB(B0, 1, 0); PG8_LDB(B1, 1, 1); PG8_SCHED; PG8_LDA(At, 1, 0); PG8_STAGE(PG8_SA(0, 1), a2 + hstepA, voffA);
            PG8_WAIT_V(8); PG8_WAIT_L(0); PG8_BAR; PG8_MMA(0, 0, At, B0); PG8_MMA(0, 1, At, B1); PG8_BAR; PG8_SCHED;
            PG8_LDA(At, 1, 1); PG8_STAGE(PG8_SB(1, 0), b3, voffB); PG8_STAGE(PG8_SB(1, 1), b3 + hstepB, voffB); PG8_STAGE(PG8_SA(1, 0), a3, voffA);
            PG8_WAIT_V(8); PG8_WAIT_L(0); PG8_BAR; PG8_MMA(1, 0, At, B0); PG8_MMA(1, 1, At, B1); PG8_BAR; PG8_SCHED;
        }
        if (wr == 0) PG8_BAR;
        { int fr2 = fr, fq2 = fq; asm volatile("" : "+v"(fr2), "+v"(fq2)); E(acc, cur, wr, wc, fr2, fq2); }
        if (!has_next) break;
#pragma unroll
        for (int a = 0; a < 2; ++a)
#pragma unroll
            for (int b = 0; b < 2; ++b)
#pragma unroll
                for (int m = 0; m < 4; ++m)
#pragma unroll
                    for (int n = 0; n < 2; ++n) acc[a][b][m][n] = (f32x4){0.f, 0.f, 0.f, 0.f};
        cur = nxt; cA = nA; cB = nB; ++ui;
        if (wr == 1) PG8_BAR;
    }
    PG8_WAIT_V(0);
    PG8_BAR;
#undef PG8_SA
#undef PG8_SB
#undef PG8_STAGE
#undef PG8_LDA
#undef PG8_LDB
#undef PG8_MMA
#undef PG8_WAIT_V
#undef PG8_WAIT_L
#undef PG8_BAR
#undef PG8_SCHED
}
}
using pg8::Unit;
typedef f32x4 Acc[2][2][4][2];

struct KArgs { const float* in[19]; float* out; unsigned char* ws; int ph_lo, ph_hi, probe, pad; };
enum { I_X = 0, I_F1N, I_F1WI, I_F1WO, I_MIXN, I_WIN, I_LBL, I_HON, I_CONVW, I_ALOG, I_DTB, I_GON, I_WBH, I_WBG, I_WOUT, I_F2N, I_F2WI, I_F2WO, I_FINN };

struct SchedStd {
    const char* A; const char* B; int lda, ldb, nt; pg8::Order O;
    DI bool next(int i, Unit& u) const { return O.next(i, u); }
    DI int ntu(const Unit&) const { return nt; }
    DI void ptrs(const Unit& u, const char*& a, const char*& b) const { a = A + (size_t)u.pm * 256 * lda * 2; b = B + (size_t)u.pn * 256 * ldb * 2; }
};
DI int g3_perm(int lp) {
    const int k = lp >> 3, t = lp & 7;
    if (t == 0 || t == 1 || t == 6) { const int i = 3 * k + (t == 6 ? 2 : t); return i < 8 ? i : i + 4; }
    const int i = 5 * k + (t == 7 ? 4 : t - 2); return i < 4 ? 8 + i : 12 + i;
}
DI int g3_late(int lp) { const int lt = lp - 32, k = lt >> 2, t = lt & 3; return t < 2 ? 32 + 2 * k + t : 40 + 2 * k + (t - 2); }
DI int g3_map(int perm, int lp) { return perm == 1 ? g3_perm(lp) : (perm == 3 ? g3_late(lp) : lp); }
struct SchedG3 {
    const char* A; const char* B; int lda, ldb, nt, j, pn0, perm; pg8::Order O;
    DI bool next(int i, Unit& u) const { return O.next(i, u); }
    DI int ntu(const Unit&) const { return nt; }
    DI void ptrs(const Unit& u, const char*& a, const char*& b) const {
        const size_t grow = (size_t)(u.pm >> 2) * 4096 + 1024 * j + (u.pm & 3) * 256;
        const int lp = pn0 + u.pn; a = A + grow * 1024 * 2; b = B + (size_t)g3_map(perm, lp) * 256 * 1024 * 2; }
};
struct SchedG4 {
    const char* P; const char* L; const char* B; int lda, ldb, c;
    DI bool next(int i, Unit& u) const { if (c >= 192 || i >= 1) return false; const int tile = c / 3; u.pm = tile >> 2; u.pn = tile & 3; u.part = c - 3 * tile; return true; }
    DI int ntu(const Unit&) const { return 16; }
    DI void ptrs(const Unit& u, const char*& a, const char*& b) const {
        a = u.part == 0 ? P + ((size_t)u.pm * 256 * PLD + C_HG) * 2 : L + ((size_t)u.pm * 256 * LLD + L_GZ + 1024 * (u.part - 1)) * 2;
        b = B + ((size_t)u.pn * 256 * 3072 + (size_t)u.part * 1024) * 2; }
};

struct EpiSwiglu {
    static constexpr bool PERM = true;
    u16* H; const float* ss;
    DI bool operator()(Acc& acc, const Unit& u, int wr, int wc, int fr, int fq) const {
        const int row0 = u.pm * 256 + wr * 64 + fr, hc0 = u.pn * 128 + wc * 32 + 8 * fq;
#pragma unroll
        for (int ai = 0; ai < 2; ++ai)
#pragma unroll
            for (int m = 0; m < 4; ++m) { const int row = row0 + ai * 128 + m * 16; const float rs = rsqrtf(ss[row] * (1.0f / 1024.0f) + EPS);
                float h[8];
#pragma unroll
                for (int n = 0; n < 2; ++n)
#pragma unroll
                    for (int e = 0; e < 4; ++e) { const float a = acc[ai][0][m][n][e] * rs, b = acc[ai][1][m][n][e] * rs; h[4 * n + e] = a * sigm(a) * b; }
                u32x4 w; w.x = cvt_pk_bf16(h[0], h[1]); w.y = cvt_pk_bf16(h[2], h[3]); w.z = cvt_pk_bf16(h[4], h[5]); w.w = cvt_pk_bf16(h[6], h[7]);
                *(u32x4*)(H + (size_t)row * DFF + hc0) = w; asm volatile("" ::: "memory"); }
        return true;
    }
};
struct EpiResid {
    static constexpr bool PERM = false;
    const float* base; float* out; float scale; u16* xn; const float* g; float* ss_out; bool dry; float* dummy;
    DI bool operator()(Acc& acc, const Unit& u, int wr, int wc, int fr, int fq) const {
        const int row0 = u.pm * 256 + wr * 64 + fr, col0 = u.pn * 256 + wc * 32 + 4 * fq;
#pragma unroll
        for (int ai = 0; ai < 2; ++ai)
#pragma unroll
            for (int m = 0; m < 4; ++m) { const int row = row0 + ai * 128 + m * 16; const size_t off = (size_t)row * DM + col0; float q = 0.f;
#pragma unroll
                for (int bj = 0; bj < 2; ++bj)
#pragma unroll
                    for (int n = 0; n < 2; ++n) { const int co = bj * 128 + n * 16; const f32x4 bs = *(const f32x4*)(base + off + co); const f32x4 o = bs + acc[ai][bj][m][n] * scale;
                        *(f32x4*)(dry ? dummy + 4 * (fr + 16 * fq) : out + off + co) = o; q += (o[0] * o[0] + o[1] * o[1]) + (o[2] * o[2] + o[3] * o[3]);
                        if (xn) { const f32x4 gv = *(const f32x4*)(g + col0 + co); u32x2 w; w.x = cvt_pk_bf16(o[0] * gv[0], o[1] * gv[1]); w.y = cvt_pk_bf16(o[2] * gv[2], o[3] * gv[3]); *(u32x2*)(dry ? (u16*)dummy + 4 * (fr + 16 * fq) : xn + off + co) = w; }
                        asm volatile("" ::: "memory"); }
                q += __shfl_xor(q, 16); q += __shfl_xor(q, 32);
                if (fq == 0 && !dry) atomicAdd(ss_out + row, q); asm volatile("" ::: "memory"); }
        return true;
    }
};
struct EpiProj {
    static constexpr bool PERM = true;
    u16* P; u16* L; const float* ss; const float* lbl; u16* halo; int j, pn0, perm;
    DI bool operator()(Acc& acc, const Unit& u, int wr, int wc, int fr, int fq) const {
        const int b = u.pm >> 2, tl0 = (u.pm & 3) * 256 + wr * 64 + fr;
        const int pn = g3_map(perm, pn0 + u.pn); const int kind = pn < 4 ? 0 : pn < 8 ? 1 : pn < 12 ? 2 : pn < 16 ? 3 : pn < 32 ? 4 : pn < 40 ? 5 : 6;
        float lb[2][8];
#pragma unroll
        for (int bj = 0; bj < 2; ++bj)
#pragma unroll
            for (int e = 0; e < 8; ++e) lb[bj][e] = 0.f;
        if (kind == 1) {
#pragma unroll
            for (int bj = 0; bj < 2; ++bj)
#pragma unroll
                for (int e = 0; e < 8; ++e) { const int c = pn * 256 - C_HF + bj * 128 + wc * 32 + 8 * fq + e; lb[bj][e] = __builtin_amdgcn_rcpf(1.0f + __expf(lbl[1024 + c] - lbl[c])); }
        }
        const float sc = kind == 0 ? 0.08838834764831845f : 1.0f;
#pragma unroll
        for (int ai = 0; ai < 2; ++ai)
#pragma unroll
            for (int m = 0; m < 4; ++m) { const int tl = tl0 + ai * 128 + m * 16; const int lr = b * 1024 + tl; const int gr = b * 4096 + 1024 * j + tl;
                const float rs = rsqrtf(ss[gr] * (1.0f / 1024.0f) + EPS);
#pragma unroll
                for (int bj = 0; bj < 2; ++bj) { const int col = pn * 256 + bj * 128 + wc * 32 + 8 * fq; float r[8];
#pragma unroll
                    for (int n = 0; n < 2; ++n)
#pragma unroll
                        for (int e = 0; e < 4; ++e) { const float v = acc[ai][bj][m][n][e] * rs; float o = v;
                            if (kind != 2 && kind != 4 && kind != 6) { const float s = sigm(v);
                                if (kind == 0 || kind == 3 || kind == 5) o = v * s * sc;
                                else o = __logf(lb[bj][4 * n + e] + (1.0f - lb[bj][4 * n + e]) * s); }
                            r[4 * n + e] = o; }
                    u32x4 w;
                    if (kind == 1) { w.x = f2h(r[0]) | ((unsigned)f2h(r[1]) << 16); w.y = f2h(r[2]) | ((unsigned)f2h(r[3]) << 16); w.z = f2h(r[4]) | ((unsigned)f2h(r[5]) << 16); w.w = f2h(r[6]) | ((unsigned)f2h(r[7]) << 16); }
                    else { w.x = cvt_pk_bf16(r[0], r[1]); w.y = cvt_pk_bf16(r[2], r[3]); w.z = cvt_pk_bf16(r[4], r[5]); w.w = cvt_pk_bf16(r[6], r[7]); }
                    if (pn < 32) *(u32x4*)(P + (size_t)lr * PLD + col) = w; else *(u32x4*)(L + (size_t)lr * LLD + (col - 8192)) = w;
                    if (kind == 4 && (tl & 63) >= 61) { const int n_ch = (1024 * j + tl) >> 6; *(u32x4*)(halo + ((size_t)((b * 32 + (n_ch & 31)) * 3 + (tl & 63) - 61)) * 4096 + (col - C_GQ)) = w; } }
                asm volatile("" ::: "memory"); }
        return true;
    }
};
struct EpiG4 {
    static constexpr bool PERM = true;
    const u16* L; u16* Y; u16* TMP; unsigned* flags; int j;
    DI bool operator()(Acc& acc, const Unit& u, int wr, int wc, int fr, int fq) const {
        const int b = u.pm >> 2, tl0 = (u.pm & 3) * 256 + wr * 64 + fr, col0 = u.pn * 256 + wc * 32 + 8 * fq;
        unsigned* flag = flags + (j * 64 + u.pm * 4 + u.pn);
        int part = u.part; asm volatile("" : "+s"(part));
        if (part != 0) {
            u16* T = TMP + (size_t)(part - 1) * 4096 * DM;
#pragma unroll
            for (int ai = 0; ai < 2; ++ai)
#pragma unroll
                for (int m = 0; m < 4; ++m) { const int tl = tl0 + ai * 128 + m * 16; const int lr = b * 1024 + tl;
#pragma unroll
                    for (int bj = 0; bj < 2; ++bj) { const int col = col0 + bj * 128;
                        float gg[8]; unpack8(*(const u32x4*)(L + (size_t)lr * LLD + L_GG + col), gg); float y[8];
#pragma unroll
                        for (int e = 0; e < 8; ++e) gg[e] = sigm(gg[e]);
#pragma unroll
                        for (int n = 0; n < 2; ++n)
#pragma unroll
                            for (int e = 0; e < 4; ++e) y[4 * n + e] = acc[ai][bj][m][n][e] * gg[4 * n + e];
                        u32x4 w; w.x = cvt_pk_bf16(y[0], y[1]); w.y = cvt_pk_bf16(y[2], y[3]); w.z = cvt_pk_bf16(y[4], y[5]); w.w = cvt_pk_bf16(y[6], y[7]);
                        *(u32x4*)(T + (size_t)lr * DM + col) = w; }
                    asm volatile("" ::: "memory"); }
            asm volatile("s_waitcnt vmcnt(0)" ::: "memory");
            __syncthreads();
            if (threadIdx.x == 0) { __builtin_amdgcn_fence(__ATOMIC_RELEASE, "agent"); asm volatile("s_waitcnt vmcnt(0)" ::: "memory"); (void)__hip_atomic_fetch_add(flag, 1u, __ATOMIC_RELAXED, __HIP_MEMORY_SCOPE_AGENT); }
        } else {
            if (threadIdx.x == 0) { unsigned sp = 0;
                while (__hip_atomic_load(flag, __ATOMIC_RELAXED, __HIP_MEMORY_SCOPE_AGENT) < 2u) { __builtin_amdgcn_s_sleep(2); if (++sp > (1u << 22)) break; }
                __builtin_amdgcn_fence(__ATOMIC_ACQUIRE, "agent"); asm volatile("s_waitcnt vmcnt(0)" ::: "memory"); }
            __syncthreads();
#pragma unroll
            for (int ai = 0; ai < 2; ++ai)
#pragma unroll
                for (int m = 0; m < 4; ++m) { const int tl = tl0 + ai * 128 + m * 16; const int lr = b * 1024 + tl; const int gr = b * 4096 + 1024 * j + tl;
#pragma unroll
                    for (int bj = 0; bj < 2; ++bj) { const int col = col0 + bj * 128;
                        float gh[8], t1[8], t2[8]; unpack8(*(const u32x4*)(L + (size_t)lr * LLD + L_GH + col), gh);
#pragma unroll
                        for (int e = 0; e < 8; ++e) gh[e] = sigm(gh[e]);
                        unpack8(*(const u32x4*)(TMP + (size_t)lr * DM + col), t1); unpack8(*(const u32x4*)(TMP + (size_t)4096 * DM + (size_t)lr * DM + col), t2); float y[8];
#pragma unroll
                        for (int n = 0; n < 2; ++n)
#pragma unroll
                            for (int e = 0; e < 4; ++e) y[4 * n + e] = acc[ai][bj][m][n][e] * gh[4 * n + e] + (t1[4 * n + e] + t2[4 * n + e]);
                        u32x4 w; w.x = cvt_pk_bf16(y[0], y[1]); w.y = cvt_pk_bf16(y[2], y[3]); w.z = cvt_pk_bf16(y[4], y[5]); w.w = cvt_pk_bf16(y[6], y[7]);
                        *(u32x4*)(Y + (size_t)gr * DM + col) = w; }
                    asm volatile("" ::: "memory"); }
        }
        return true;
    }
};

DI void transpose_item(const float* W, int N, u16* WT, int ldd, int koff, LAS float* scr, int kb, int nb, int lane, int mode) {
    const int k0 = 64 * kb, n0 = 32 * nb;
#pragma unroll 8
    for (int i = 0; i < 32; ++i) { const int kk = 2 * i + (lane >> 5); scr[kk * 33 + (lane & 31)] = W[(size_t)(k0 + kk) * N + n0 + (lane & 31)]; }
    asm volatile("s_waitcnt lgkmcnt(0)" ::: "memory");
    const int c = lane & 7;
#pragma unroll
    for (int jj = 0; jj < 4; ++jj) { const int n = (lane >> 3) + 8 * jj; const int cn = n0 + n; int dr = cn;
        if (mode == 1) { if (cn < DFF) dr = 256 * (cn >> 7) + (cn & 127); else { const int q = cn - DFF; dr = 256 * (q >> 7) + 128 + (q & 127); } }
        if (mode == 2) { if (cn >= 8224) dr = cn - 32; }
        const LAS float* s = scr + (8 * c) * 33 + n;
        u32x4 o; o.x = pk2(s[0 * 33], s[1 * 33]); o.y = pk2(s[2 * 33], s[3 * 33]); o.z = pk2(s[4 * 33], s[5 * 33]); o.w = pk2(s[6 * 33], s[7 * 33]);
        *(u32x4*)(WT + (size_t)dr * ldd + koff + k0 + 8 * c) = o; }
    asm volatile("s_waitcnt lgkmcnt(0)" ::: "memory");
}
DI void convert_weight(const float* W, int K, int N, u16* WT, int ldd, int koff, int mode, LAS float* scr, int gw, int ngw, int lane) {
    const int nblk = N / 32, nitems = (K / 64) * nblk;
    for (int it = gw; it < nitems; it += ngw) { const int kb = it / nblk, nb = it % nblk; if (mode == 2 && nb == 256) continue; transpose_item(W, N, WT, ldd, koff, scr, kb, nb, lane, mode); }
}

DI void gab_item(LAS unsigned char* lds, const KArgs& a, int gr0) {
    int tid_ = threadIdx.x; asm volatile("" : "+v"(tid_));
    const int tid = tid_, lane = tid & 63, wid = tid >> 6, lj = lane & 15, g = lane >> 4;
    unsigned char* ws = a.ws; const u16* XN = (const u16*)(ws + WS_XN); const u16* WAB = (const u16*)(ws + WS_WAB); const float* ss2 = (const float*)(ws + WS_SS) + T_TOK;
    LAS float* red = (LAS float*)lds;
    f32x4 acc[2][4];
#pragma unroll
    for (int nt = 0; nt < 2; ++nt)
#pragma unroll
        for (int mt = 0; mt < 4; ++mt) acc[nt][mt] = (f32x4){0.f, 0.f, 0.f, 0.f};
#pragma unroll
    for (int q = 0; q < 4; ++q) { const int kk = 4 * wid + q; bf16x8 bfr[2], afr[4];
#pragma unroll
        for (int nt = 0; nt < 2; ++nt) bfr[nt] = *(const bf16x8*)(WAB + (size_t)(16 * nt + lj) * 1024 + 32 * kk + 8 * g);
#pragma unroll
        for (int mt = 0; mt < 4; ++mt) afr[mt] = *(const bf16x8*)(XN + (size_t)(gr0 + 16 * mt + lj) * 1024 + 32 * kk + 8 * g);
#pragma unroll
        for (int nt = 0; nt < 2; ++nt)
#pragma unroll
            for (int mt = 0; mt < 4; ++mt) acc[nt][mt] = MFMA16(afr[mt], bfr[nt], acc[nt][mt]); }
#pragma unroll
    for (int nt = 0; nt < 2; ++nt)
#pragma unroll
        for (int mt = 0; mt < 4; ++mt)
#pragma unroll
            for (int r = 0; r < 4; ++r) red[(wid * 64 + 16 * mt + 4 * g + r) * 32 + 16 * nt + lj] = acc[nt][mt][r];
    __syncthreads();
#pragma unroll
    for (int q = 0; q < 4; ++q) { const int idx = tid + 512 * q, tok = idx >> 5, col = idx & 31; float sum = 0.f;
#pragma unroll
        for (int w2 = 0; w2 < 8; ++w2) sum += red[(w2 * 64 + tok) * 32 + col];
        sum *= rsqrtf(ss2[gr0 + tok] * (1.0f / 1024.0f) + EPS);
        if (col < 16) { const float xx = sum + a.in[I_DTB][col]; const float sp = xx > 20.f ? xx : log1pf(__expf(xx)); ((float*)(ws + WS_GBG))[(size_t)(gr0 + tok) * 16 + col] = -__expf(a.in[I_ALOG][col]) * sp; }
        else ((float*)(ws + WS_GBB))[(size_t)(gr0 + tok) * 16 + col - 16] = sigm(sum); }
    __syncthreads();
}
DI int swt(int v) { return ((v >> 3) ^ v) & 7; }
DI int swz(int v, int s) { return v * 64 + ((((s >> 3) ^ swt(v)) & 7) << 3) + (s & 7); }
DI void prep_gdn(LAS unsigned char* lds, const KArgs& a, int j, int b, int nl, int hq, bool dry) {
    int tid_ = threadIdx.x; asm volatile("" : "+v"(tid_));
    const int tid = tid_, lane = tid & 63, wid = tid >> 6, lj = lane & 15, g = lane >> 4;
    unsigned char* ws = a.ws;
    u16* P = (u16*)(ws + WS_PROJ); u16* Pw = dry ? (u16*)(ws + WS_DUMMY) : P; const u16* XN = (const u16*)(ws + WS_XN); const u16* halo = (const u16*)(ws + WS_HALO); const float* ss2 = (const float*)(ws + WS_SS) + T_TOK;
    const int n = 16 * j + nl, lr0 = b * 1024 + 64 * nl, gr0 = b * 4096 + 64 * n;
    LAS u16* QGs = (LAS u16*)lds;
    LAS u16* KGs = QGs + 64 * 136;
    LAS u16* VBT = KGs + 64 * 136;
    LAS u16* KBT = VBT + 2 * 128 * 64;
    LAS float* AM = (LAS float*)(KBT + 2 * 128 * 64);
    LAS u16* TM = (LAS u16*)(AM + 2 * 64 * 68);
    LAS float* gms = (LAS float*)(TM + 2 * 64 * 72);
    const bool sk1 = dry && (a.probe & 0x10000), sk2 = dry && (a.probe & 0x20000), sk3 = dry && (a.probe & 0x40000), sk4 = dry && (a.probe & 0x80000), sk5 = dry && (a.probe & 0x100000);
    const int mat = tid >> 7, tg = (tid >> 4) & 7, c8 = tid & 15, t0 = 8 * tg;
    const int cb = mat == 0 ? C_GQ + 128 * hq : (mat == 1 ? C_GK + 128 * hq : C_GV + 128 * (2 * hq + mat - 2));
    const int wcol = cb - C_GQ + 8 * c8;
    u32x4 raw[11];
#pragma unroll
    for (int rr = 0; rr < 11; ++rr) { const int tt = t0 - 3 + rr; raw[rr] = (u32x4){0u, 0u, 0u, 0u};
        if (tt >= 0) raw[rr] = *(const u32x4*)(P + (size_t)(lr0 + tt) * PLD + cb + 8 * c8);
        else if (n > 0) raw[rr] = *(const u32x4*)(halo + ((size_t)((b * 32 + ((n - 1) & 31)) * 3 + (3 + tt))) * 4096 + wcol); }
    float w[4][8];
#pragma unroll
    for (int jj = 0; jj < 4; ++jj) { const f32x4 w0 = *(const f32x4*)(a.in[I_CONVW] + jj * 4096 + wcol), w1 = *(const f32x4*)(a.in[I_CONVW] + jj * 4096 + wcol + 4);
#pragma unroll
        for (int e = 0; e < 4; ++e) { w[jj][e] = w0[e]; w[jj][4 + e] = w1[e]; } }
    if (tid < 128) { const int e = tid >> 6, tok = tid & 63;
        gms[e * 64 + tok] = ((const float*)(ws + WS_GBG))[(size_t)(gr0 + tok) * 16 + 2 * hq + e]; gms[128 + e * 64 + tok] = ((const float*)(ws + WS_GBB))[(size_t)(gr0 + tok) * 16 + 2 * hq + e]; }
    __syncthreads();
    if (wid < 2) { float v = gms[wid * 64 + lane];
#pragma unroll
        for (int o = 1; o < 64; o <<= 1) { const float t = __shfl_up(v, o); if (lane >= o) v += t; }
        gms[wid * 64 + lane] = v; }
    __syncthreads();
    if (!sk2) {
        float y[8][8];
#pragma unroll
        for (int i = 0; i < 8; ++i)
#pragma unroll
            for (int e = 0; e < 8; ++e) y[i][e] = 0.f;
#pragma unroll
        for (int rr = 0; rr < 11; ++rr) { float x[8]; unpack8(raw[rr], x);
#pragma unroll
            for (int jj = 0; jj < 4; ++jj) { const int i = rr - jj; if (i >= 0 && i < 8) {
#pragma unroll
                for (int e = 0; e < 8; ++e) y[i][e] += w[jj][e] * x[e]; } } }
#pragma unroll
        for (int i = 0; i < 8; ++i) {
#pragma unroll
            for (int e = 0; e < 8; ++e) y[i][e] = y[i][e] * sigm(y[i][e]);
            if (mat < 2) { float q = 0.f;
#pragma unroll
                for (int e = 0; e < 8; ++e) q += y[i][e] * y[i][e];
                q = row16_sum(q);
                const float sc = rsqrtf(q + EPS) * (mat == 0 ? 0.08838834764831845f : 1.0f);
#pragma unroll
                for (int e = 0; e < 8; ++e) y[i][e] *= sc;
                *(LAS u32x4*)((mat == 0 ? QGs : KGs) + (t0 + i) * 136 + 8 * c8) = pack8(y[i]); } }
        if (mat >= 1) {
#pragma unroll
            for (int ee = 0; ee < 2; ++ee) { if (mat == 1 || mat - 2 == ee) {
                float f[8];
#pragma unroll
                for (int i = 0; i < 8; ++i) f[i] = gms[128 + ee * 64 + t0 + i] * (mat == 1 ? __expf(gms[ee * 64 + t0 + i]) : 1.0f);
                LAS u16* dst = (mat == 1 ? KBT : VBT) + ee * 8192;
#pragma unroll
                for (int e = 0; e < 8; ++e) { const int v = 8 * c8 + e; float col[8];
#pragma unroll
                    for (int i = 0; i < 8; ++i) col[i] = y[i][e] * f[i];
                    *(LAS u32x4*)(dst + v * 64 + (((tg ^ swt(v)) & 7) << 3)) = pack8(col); } } }
        }
    }
    __syncthreads();
    const int cv0 = ((b * 16 + nl) * 16 + 2 * hq);
    u16* QKo = (u16*)(ws + WS_QK); u16* WMo = (u16*)(ws + WS_WM); float* GAMo = (float*)(ws + WS_GAM);
#pragma unroll
    for (int x = 0; x < 2; ++x) { if (sk3) break; const int tt = 2 * wid + x, mi = tt >> 2, ni = tt & 3;
        f32x4 kk = (f32x4){0.f, 0.f, 0.f, 0.f}, qk = (f32x4){0.f, 0.f, 0.f, 0.f};
#pragma unroll
        for (int ks = 0; ks < 4; ++ks) { const bf16x8 ka = fragN(KGs, 16 * mi + lj, 32 * ks, g, 136), kb2 = fragN(KGs, 16 * ni + lj, 32 * ks, g, 136), qb = fragN(QGs, 16 * ni + lj, 32 * ks, g, 136);
            kk = MFMA16(ka, kb2, kk); qk = MFMA16(ka, qb, qk); }
#pragma unroll
        for (int e = 0; e < 2; ++e) {
#pragma unroll
            for (int r = 0; r < 4; ++r) { const int t = 16 * mi + 4 * g + r, s = 16 * ni + lj;
                AM[e * 4352 + t * 68 + s] = (s < t) ? kk[r] * gms[128 + e * 64 + t] * __expf(gms[e * 64 + t] - gms[e * 64 + s]) : 0.f; }
            const int t = 16 * ni + lj; float o4[4];
#pragma unroll
            for (int r = 0; r < 4; ++r) { const int s = 16 * mi + 4 * g + r; o4[r] = (s <= t) ? qk[r] * __expf(gms[e * 64 + t] - gms[e * 64 + s]) : 0.f; }
            u32x2 w; w.x = pk2(o4[0], o4[1]); w.y = pk2(o4[2], o4[3]);
            *(LAS u32x2*)(TM + e * 4608 + t * 72 + 16 * mi + 4 * g) = w; } }
    __syncthreads();
#pragma unroll
    for (int q = 0; q < 2; ++q) { const int pid = tid + 512 * q, e = pid >> 9, row = (pid >> 3) & 63, c = pid & 7;
        *(u32x4*)(QKo + (size_t)(cv0 + e) * 4096 + row * 64 + 8 * c) = *(const LAS u32x4*)(TM + e * 4608 + row * 72 + 8 * c); }
    __syncthreads();
    if (wid < 2 && !sk4) { const LAS float* Ae = AM + wid * 4352; float Tc[64];
        f32x4 an[16], ac[16];
        Tc[0] = (lane == 0) ? 1.f : 0.f;
        an[0] = *(const LAS f32x4*)(Ae + 68);
#pragma unroll
        for (int i = 1; i < 64; ++i) {
#pragma unroll
            for (int q = 0; q < (i + 3) / 4; ++q) ac[q] = an[q];
            if (i + 1 < 64) {
#pragma unroll
                for (int q = 0; q < (i + 4) / 4; ++q) an[q] = *(const LAS f32x4*)(Ae + (i + 1) * 68 + 4 * q); }
            __builtin_amdgcn_sched_barrier(0);
            float s0 = (i == lane) ? 1.f : 0.f, s1 = 0.f;
#pragma unroll
            for (int jj = 0; jj < i; ++jj) { if (jj & 1) s1 -= ac[jj >> 2][jj & 3] * Tc[jj]; else s0 -= ac[jj >> 2][jj & 3] * Tc[jj]; }
            Tc[i] = s0 + s1;
            __builtin_amdgcn_sched_barrier(0);
        }
#pragma unroll
        for (int i = 0; i < 64; ++i) TM[wid * 4608 + i * 72 + lane] = (u16)f2bf(Tc[i]);
    } else if (wid >= 2) { const int t2 = tid - 128;
        for (int pid = t2; pid < 1024; pid += 384) { const int row = pid >> 4, c = pid & 15; *(u32x4*)(Pw + widx(dry, tid, (size_t)(lr0 + row) * PLD + C_GQ + 128 * hq + 8 * c)) = *(const LAS u32x4*)(QGs + row * 136 + 8 * c); }
        for (int pid = t2; pid < 1024; pid += 384) { const int k = pid >> 3, c = pid & 7; float v[8];
#pragma unroll
            for (int e = 0; e < 8; ++e) v[e] = bf2f(KGs[(8 * c + e) * 136 + k]);
            *(u32x4*)(Pw + widx(dry, tid, (size_t)(lr0 + (k >> 1)) * PLD + C_GK + 128 * hq + 64 * (k & 1) + 8 * c)) = pack8(v); }
        if (t2 < 128) GAMo[(size_t)(cv0 + (t2 >> 6)) * 64 + (t2 & 63)] = gms[t2];
    }
    __syncthreads();
    LAS u16* WMst = QGs;
    LAS u16* UTst = (LAS u16*)AM;
    if (!sk5) { const int e = wid >> 2, q = wid & 3; const LAS u16* Te = TM + e * 4608;
        bf16x8 ta[2];
#pragma unroll
        for (int ks = 0; ks < 2; ++ks) ta[ks] = fragN(Te, 16 * q + lj, 32 * ks, g, 72);
#pragma unroll
        for (int vt = 0; vt < 8; ++vt) { const int v = 16 * vt + lj; f32x4 c = (f32x4){0.f, 0.f, 0.f, 0.f};
#pragma unroll
            for (int ks = 0; ks < 2; ++ks) c = MFMA16(ta[ks], *(const LAS bf16x8*)(VBT + e * 8192 + v * 64 + ((((4 * ks + g) ^ swt(v)) & 7) << 3)), c);
            const int t = 16 * q + 4 * g; u32x2 w; w.x = pk2(c[0], c[1]); w.y = pk2(c[2], c[3]);
            *(LAS u32x2*)(UTst + e * 8192 + v * 64 + t) = w; }
        bf16x8 tb[4][2];
#pragma unroll
        for (int tt = 0; tt < 4; ++tt)
#pragma unroll
            for (int ks = 0; ks < 2; ++ks) tb[tt][ks] = fragN(Te, 16 * tt + lj, 32 * ks, g, 72);
#pragma unroll
        for (int k2 = 0; k2 < 2; ++k2) { const int kt = 2 * q + k2, k = 16 * kt + lj; bf16x8 ka[2];
#pragma unroll
            for (int ks = 0; ks < 2; ++ks) ka[ks] = *(const LAS bf16x8*)(KBT + e * 8192 + k * 64 + ((((4 * ks + g) ^ swt(k)) & 7) << 3));
#pragma unroll
            for (int tt = 0; tt < 4; ++tt) { f32x4 c = (f32x4){0.f, 0.f, 0.f, 0.f};
#pragma unroll
                for (int ks = 0; ks < 2; ++ks) c = MFMA16(ka[ks], tb[tt][ks], c);
                const int t = 16 * tt + lj, kk = 16 * kt + 4 * g; u32x2 w; w.x = pk2(c[0], c[1]); w.y = pk2(c[2], c[3]);
                *(LAS u32x2*)(WMst + e * 8704 + t * 136 + kk) = w; } }
    }
    __syncthreads();
#pragma unroll
    for (int q = 0; q < 4; ++q) { const int pid = tid + 512 * q, e = pid >> 10, r10 = pid & 1023;
        { const int v = r10 >> 3, c = r10 & 7; *(u32x4*)(Pw + widx(dry, tid, (size_t)(lr0 + (v >> 1)) * PLD + C_GV + 128 * (2 * hq + e) + 64 * (v & 1) + 8 * c)) = *(const LAS u32x4*)(UTst + e * 8192 + v * 64 + 8 * c); }
        { const int t = r10 >> 4, c = r10 & 15; *(u32x4*)(WMo + (size_t)(cv0 + e) * 8192 + t * 128 + 8 * c) = *(const LAS u32x4*)(WMst + e * 8704 + t * 136 + 8 * c); } }
    __syncthreads();
}

DI void prep_hgrn(LAS unsigned char* lds, const KArgs& a, int b, int nl, int hi_, bool dry) {
    int tid_ = threadIdx.x; asm volatile("" : "+v"(tid_));
    const int tid = tid_, lane = tid & 63, wid = tid >> 6, lj = lane & 15, g = lane >> 4;
    unsigned char* ws = a.ws; u16* P = (u16*)(ws + WS_PROJ); u16* Pw = dry ? (u16*)(ws + WS_DUMMY) : P;
    const int lr0 = b * 1024 + 64 * nl; const int item = (b * 16 + nl) * 8 + hi_;
    LAS float* segs = (LAS float*)lds;
    LAS u16* Qs = (LAS u16*)(segs + 512);
    LAS u16* Ks = Qs + 64 * 136;
    const int k = tid & 127, seg = tid >> 7;
    float q[16], lf[16], vv[16];
#pragma unroll
    for (int r = 0; r < 16; ++r) { const size_t ro = (size_t)(lr0 + 16 * seg + r) * PLD + 128 * hi_ + k;
        q[r] = bf2f(P[ro + C_HQ]); lf[r] = h2f(P[ro + C_HF]); vv[r] = bf2f(P[ro + C_HI]); }
    float cs[16]; { float s = 0.f;
#pragma unroll
        for (int r = 0; r < 16; ++r) { s += lf[r]; cs[r] = s; } }
    segs[seg * 128 + k] = cs[15];
    __syncthreads();
    const float s0 = segs[k], s1 = segs[128 + k], s2 = segs[256 + k], s3 = segs[384 + k];
    const float pre = seg == 0 ? 0.f : (seg == 1 ? s0 : (seg == 2 ? s0 + s1 : s0 + s1 + s2));
    const float bmid = s0 + s1, bend = s0 + s1 + s2 + s3;
    float ke[16], qe[16];
#pragma unroll
    for (int r = 0; r < 16; ++r) { const float bb = pre + cs[r]; const float kh = -expm1f(lf[r]); const int t = 16 * seg + r;
        qe[r] = q[r] * __expf(bb); ke[r] = kh * __expf(bend - bb);
        Qs[t * 136 + k] = (u16)f2bf(q[r] * __expf(bb - bmid)); Ks[t * 136 + k] = (u16)f2bf(kh * __expf(bmid - bb)); }
#pragma unroll
    for (int r = 0; r < 16; ++r) Pw[widx(dry, tid, (size_t)(lr0 + 16 * seg + r) * PLD + C_HQ + 128 * hi_ + k)] = (u16)f2bf(qe[r]);
    { u16* kd = Pw + widx(dry, 2 * tid, (size_t)(lr0 + (k >> 1)) * PLD + C_HF + 128 * hi_ + 64 * (k & 1) + 16 * seg); u16* vd = Pw + widx(dry, 2 * tid, (size_t)(lr0 + (k >> 1)) * PLD + C_HI + 128 * hi_ + 64 * (k & 1) + 16 * seg);
        float t8[8];
#pragma unroll
        for (int h = 0; h < 2; ++h) {
#pragma unroll
            for (int e = 0; e < 8; ++e) t8[e] = ke[8 * h + e];
            *(u32x4*)(kd + 8 * h) = pack8(t8);
#pragma unroll
            for (int e = 0; e < 8; ++e) t8[e] = vv[8 * h + e];
            *(u32x4*)(vd + 8 * h) = pack8(t8); } }
    if (seg == 0) ((float*)(ws + WS_DEC))[(size_t)item * 128 + k] = __expf(bend);
    __syncthreads();
    u16* SCo = (u16*)(ws + WS_SC) + (size_t)item * 4096;
#pragma unroll 1
    for (int x = 0; x < 2; ++x) { const int tt = 2 * wid + x, mi = tt >> 2, ni = tt & 3; f32x4 c = (f32x4){0.f, 0.f, 0.f, 0.f};
        if (mi <= ni) {
#pragma unroll
            for (int ks = 0; ks < 4; ++ks) c = MFMA16(fragN(Ks, 16 * mi + lj, 32 * ks, g, 136), fragN(Qs, 16 * ni + lj, 32 * ks, g, 136), c); }
        const int t = 16 * ni + lj; float o4[4];
#pragma unroll
        for (int r = 0; r < 4; ++r) { const int s = 16 * mi + 4 * g + r; o4[r] = (s <= t) ? c[r] : 0.f; }
        u32x2 w; w.x = pk2(o4[0], o4[1]); w.y = pk2(o4[2], o4[3]);
        *(u32x2*)(SCo + t * 64 + 16 * mi + 4 * g) = w; }
    __syncthreads();
}

DI void norm_accum(const f32x4 (&o)[4], LAS float* tot, int lj, int g) {
#pragma unroll
    for (int mt = 0; mt < 4; ++mt) { f32x4 q = o[mt] * o[mt];
        q[0] = row16_sum(q[0]); q[1] = row16_sum(q[1]); q[2] = row16_sum(q[2]); q[3] = row16_sum(q[3]);
        if (lj == 0) {
#pragma unroll
            for (int r = 0; r < 4; ++r) (void)__hip_atomic_fetch_add(tot + 16 * mt + 4 * g + r, q[r], __ATOMIC_RELAXED, __HIP_MEMORY_SCOPE_WORKGROUP); } }
}
DI void norm_finish(const f32x4 (&o)[4], const LAS float* tot, LAS u16* GT, float gnv, u16* gdst  , int pitch, bool dry, u16* sink, int w, int lane, int lj, int g) {
#pragma unroll
    for (int mt = 0; mt < 4; ++mt) { const f32x4 tt = *(const LAS f32x4*)(tot + 16 * mt + 4 * g);
#pragma unroll
        for (int r = 0; r < 4; ++r) { LAS u16* gp = GT + (16 * mt + 4 * g + r) * 136 + 16 * w + lj; *gp = (u16)pk2(o[mt][r] * rsqrtf(tt[r] * (1.0f / 128.0f) + EPS) * gnv * bf2f(*gp), 0.f); } }
    asm volatile("s_waitcnt lgkmcnt(0)" ::: "memory");
#pragma unroll
    for (int q = 0; q < 2; ++q) { const int p = lane + 64 * q, row = p >> 1, hf = p & 1; const u32x4 v = *(const LAS u32x4*)(GT + row * 136 + 16 * w + 8 * hf);
        *(u32x4*)(dry ? sink : gdst + (size_t)row * pitch + 16 * w + 8 * hf) = v; }
}

DI void recur_gdn(LAS unsigned char* lds, const KArgs& a, int j, int b, int vh, bool dry) {
    int tid_ = threadIdx.x; asm volatile("" : "+v"(tid_));
    const int tid = tid_, lane = tid & 63, w = tid >> 6, lj = lane & 15, g = lane >> 4;
    unsigned char* ws = a.ws; u16* P = (u16*)(ws + WS_PROJ); u16* LT = (u16*)(ws + WS_LATE) + (size_t)(j & 1) * 4096 * LLD;
    LAS u16* QG = (LAS u16*)lds;
    LAS u16* WMs = QG + 64 * 136;
    LAS u16* KT = WMs + 64 * 136;
    LAS u16* UT = KT + 128 * 72;
    LAS u16* QKs = UT + 128 * 72;
    LAS float* gam = (LAS float*)(QKs + 64 * 72);
    LAS float* tot = gam + 192;
    LAS u16* GT = (LAS u16*)(tot + 128);
    const int hq = vh >> 1; const int chain = b * 16 + vh;
    float* ST = (float*)(ws + WS_STATE) + (size_t)chain * 16384;
    u16* sink = (u16*)(ws + WS_DUMMY) + 8 * tid;
    f32x4 S[8];
#pragma unroll
    for (int m = 0; m < 8; ++m) S[m] = (j == 0) ? (f32x4){0.f, 0.f, 0.f, 0.f} : *(const f32x4*)(ST + ((w * 8 + m) * 64 + lane) * 4);
    u32x4 R[11]; float Rg = 0.f;
    unsigned oA[2], oT[2], oS[2];
#pragma unroll
    for (int q = 0; q < 2; ++q) { const int pid = tid + 512 * q; oA[q] = (unsigned)((pid >> 4) * PLD + 8 * (pid & 15)) * 2u; const int x = pid >> 3, c = pid & 7; oT[q] = (unsigned)((x >> 1) * PLD + 64 * (x & 1) + 8 * c) * 2u;
        const int p = lane + 64 * q; oS[q] = (unsigned)((p >> 1) * LLD + 16 * w + 8 * (p & 1)) * 2u; }
    auto load_chunk = [&](int nl) {
        const int lr0 = b * 1024 + 64 * nl; const size_t cv = (size_t)((b * 16 + nl) * 16 + vh);
        const char* wm = (const char*)(ws + WS_WM) + cv * 16384; const char* qk = (const char*)(ws + WS_QK) + cv * 8192;
        const char* pq = (const char*)(P + (size_t)lr0 * PLD + C_GQ + 128 * hq); const char* pk = (const char*)(P + (size_t)lr0 * PLD + C_GK + 128 * hq);
        const char* pv = (const char*)(P + (size_t)lr0 * PLD + C_GV + 128 * vh); const char* pg = (const char*)(LT + (size_t)lr0 * LLD + L_GZ + 128 * vh);
#pragma unroll
        for (int q = 0; q < 2; ++q) { R[q] = *(const u32x4*)(pq + oA[q]); R[2 + q] = *(const u32x4*)(wm + (unsigned)(tid + 512 * q) * 16u); R[4 + q] = *(const u32x4*)(pk + oT[q]); R[6 + q] = *(const u32x4*)(pv + oT[q]); R[9 + q] = *(const u32x4*)(pg + oS[q]); }
        R[8] = *(const u32x4*)(qk + (unsigned)tid * 16u);
        if (tid < 64) Rg = ((const float*)(ws + WS_GAM))[cv * 64 + tid];
    };
    auto store_chunk = [&]() {
#pragma unroll
        for (int q = 0; q < 2; ++q) { const int pid = tid + 512 * q; st_perm(QG + (pid >> 4) * 136, pid & 15, R[q]); st_perm(WMs + (pid >> 4) * 136, pid & 15, R[2 + q]);
            st_perm(KT + (pid >> 3) * 72, pid & 7, R[4 + q]); *(LAS u32x4*)(UT + (pid >> 3) * 72 + 8 * (pid & 7)) = R[6 + q]; }
        st_perm(QKs + (tid >> 3) * 72, tid & 7, R[8]);
#pragma unroll
        for (int q = 0; q < 2; ++q) { const int p = lane + 64 * q; *(LAS u32x4*)(GT + (p >> 1) * 136 + 16 * w + 8 * (p & 1)) = R[9 + q]; }
        if (tid < 64) { const float ge = __shfl(Rg, 63); gam[tid] = __expf(Rg); gam[64 + tid] = __expf(ge - Rg); if (tid == 63) gam[128] = __expf(ge); }
    };
    const float gnv = a.in[I_GON][16 * w + lj];
    load_chunk(0);
    if (tid < 128) tot[tid] = 0.f;
    store_chunk();
#pragma unroll 1
    for (int nl = 0; nl < 16; ++nl) {
        __syncthreads();
        if (nl + 1 < 16) load_chunk(nl + 1);
        f32x4 vn[4], o[4];
        bf16x8 Sb[4];
#pragma unroll
        for (int kk = 0; kk < 4; ++kk) Sb[kk] = packacc(S[2 * kk], S[2 * kk + 1]);
        bf16x8 fa[3][4];
#define SBAR __builtin_amdgcn_sched_barrier(0)
#define LD_A(bf, M, mt, st) do { _Pragma("unroll") for (int kk = 0; kk < 4; ++kk) fa[bf][kk] = fragN(M, 16 * (mt) + lj, 32 * kk, g, st); } while (0)
#define LD_B(bf, M, m0) do { _Pragma("unroll") for (int m2 = 0; m2 < 2; ++m2) _Pragma("unroll") for (int tk = 0; tk < 2; ++tk) fa[bf][2 * m2 + tk] = fragN(M, 16 * ((m0) + m2) + lj, 32 * tk, g, 72); } while (0)
#define MF_W(bf, mt) do { f32x4 c = (f32x4){0.f, 0.f, 0.f, 0.f}; _Pragma("unroll") for (int kk = 0; kk < 4; ++kk) c = MFMA16(fa[bf][kk], Sb[kk], c); vn[mt] = c; } while (0)
#define MF_Q(bf, mt) do { f32x4 c2 = (f32x4){0.f, 0.f, 0.f, 0.f}; _Pragma("unroll") for (int kk = 0; kk < 4; ++kk) c2 = MFMA16(fa[bf][kk], Sb[kk], c2); \
            o[mt] = c2; } while (0)
#define MF_QK(bf, m0) do { _Pragma("unroll") for (int m2 = 0; m2 < 2; ++m2) { f32x4 c = (f32x4){0.f, 0.f, 0.f, 0.f}; _Pragma("unroll") for (int tk = 0; tk < 2; ++tk) c = MFMA16(fa[bf][2 * m2 + tk], vb[tk], c); dq[(m0) + m2] = c; } } while (0)
#define MF_KT(bf, m0) do { _Pragma("unroll") for (int m2 = 0; m2 < 2; ++m2) { f32x4 c = S[(m0) + m2] * eG; _Pragma("unroll") for (int tk = 0; tk < 2; ++tk) c = MFMA16(fa[bf][2 * m2 + tk], vsb[tk], c); S[(m0) + m2] = c; } } while (0)
        LD_A(0, WMs, 0, 136); LD_A(1, QG, 0, 136); SBAR;
        LD_A(2, WMs, 1, 136); SBAR; MF_W(0, 0); SBAR;
        LD_A(0, QG, 1, 136); SBAR; MF_Q(1, 0); SBAR;
        LD_A(1, WMs, 2, 136); SBAR; MF_W(2, 1); SBAR;
        LD_A(2, QG, 2, 136); SBAR; MF_Q(0, 1); SBAR;
        LD_A(0, WMs, 3, 136); SBAR; MF_W(1, 2); SBAR;
        LD_A(1, QG, 3, 136); SBAR; MF_Q(2, 2); SBAR;
        LD_B(2, QKs, 0); SBAR; MF_W(0, 3); SBAR;
        LD_B(0, QKs, 2); SBAR; MF_Q(1, 3); SBAR;
        bf16x8 vb[2], vsb[2]; f32x4 dq[4]; float eG;
        { u32x2 uw[4]; f32x4 es[4];
#pragma unroll
            for (int mt = 0; mt < 4; ++mt) { uw[mt] = *(const LAS u32x2*)(UT + (16 * w + lj) * 72 + 16 * mt + 4 * g); es[mt] = *(const LAS f32x4*)(gam + 64 + 16 * mt + 4 * g); }
            eG = gam[128];
            SBAR;
#pragma unroll
            for (int mt = 0; mt < 4; ++mt) { vn[mt][0] = bf2f(uw[mt].x & 0xffffu) - vn[mt][0]; vn[mt][1] = bf2f(uw[mt].x >> 16) - vn[mt][1]; vn[mt][2] = bf2f(uw[mt].y & 0xffffu) - vn[mt][2]; vn[mt][3] = bf2f(uw[mt].y >> 16) - vn[mt][3]; }
#pragma unroll
            for (int tk = 0; tk < 2; ++tk) { vb[tk] = packacc(vn[2 * tk], vn[2 * tk + 1]); vsb[tk] = packacc(vn[2 * tk] * es[2 * tk], vn[2 * tk + 1] * es[2 * tk + 1]); } }
        SBAR;
        LD_B(1, KT, 0); SBAR; MF_QK(2, 0); SBAR;
        LD_B(2, KT, 2); SBAR; MF_QK(0, 2); SBAR;
        LD_B(0, KT, 4); SBAR; MF_KT(1, 0); SBAR;
        LD_B(1, KT, 6); SBAR; MF_KT(2, 2); SBAR;
        MF_KT(0, 4); SBAR; MF_KT(1, 6); SBAR;
#undef LD_A
#undef LD_B
#undef MF_W
#undef MF_Q
#undef MF_QK
#undef MF_KT
#pragma unroll
        for (int mt = 0; mt < 4; ++mt) o[mt] = o[mt] * *(const LAS f32x4*)(gam + 16 * mt + 4 * g) + dq[mt];
        LAS float* tc = tot + 64 * (nl & 1);
        norm_accum(o, tc, lj, g);
        __syncthreads();
        norm_finish(o, tc, GT, gnv, LT + (size_t)(b * 1024 + 64 * nl) * LLD + L_GZ + 128 * vh, LLD, dry, sink, w, lane, lj, g);
        if (tid < 64) tot[64 * ((nl + 1) & 1) + tid] = 0.f;
        if (nl + 1 < 16) store_chunk();
    }
#pragma unroll
    for (int m = 0; m < 8; ++m) *(f32x4*)(ST + ((w * 8 + m) * 64 + lane) * 4) = S[m];
    __syncthreads();
}

DI void recur_hgrn(LAS unsigned char* lds, const KArgs& a, int j, int b, int hi_, bool dry) {
    int tid_ = threadIdx.x; asm volatile("" : "+v"(tid_));
    const int tid = tid_, lane = tid & 63, w = tid >> 6, lj = lane & 15, g = lane >> 4;
    unsigned char* ws = a.ws; u16* P = (u16*)(ws + WS_PROJ);
    LAS u16* QE = (LAS u16*)lds;
    LAS u16* KET = QE + 64 * 136;
    LAS u16* VT = KET + 128 * 72;
    LAS u16* SCs = VT + 128 * 72;
    LAS float* dec = (LAS float*)(SCs + 64 * 72);
    LAS float* tot = dec + 128;
    LAS u16* GT = (LAS u16*)(tot + 128);
    const int chain = 64 + b * 8 + hi_;
    float* ST = (float*)(ws + WS_STATE) + (size_t)chain * 16384;
    u16* sink = (u16*)(ws + WS_DUMMY) + 8 * tid;
    f32x4 S[8];
#pragma unroll
    for (int m = 0; m < 8; ++m) S[m] = (j == 0) ? (f32x4){0.f, 0.f, 0.f, 0.f} : *(const f32x4*)(ST + ((w * 8 + m) * 64 + lane) * 4);
    u32x4 R[9]; float Rd = 0.f;
    unsigned oA[2], oT[2], oS[2];
#pragma unroll
    for (int q = 0; q < 2; ++q) { const int pid = tid + 512 * q; oA[q] = (unsigned)((pid >> 4) * PLD + 8 * (pid & 15)) * 2u; const int x = pid >> 3, c = pid & 7; oT[q] = (unsigned)((x >> 1) * PLD + 64 * (x & 1) + 8 * c) * 2u;
        const int p = lane + 64 * q; oS[q] = (unsigned)((p >> 1) * PLD + 16 * w + 8 * (p & 1)) * 2u; }
    auto load_chunk = [&](int nl) {
        const int lr0 = b * 1024 + 64 * nl; const size_t item = (size_t)((b * 16 + nl) * 8 + hi_);
        const char* sc = (const char*)(ws + WS_SC) + item * 8192;
        const char* pq = (const char*)(P + (size_t)lr0 * PLD + C_HQ + 128 * hi_); const char* pk = (const char*)(P + (size_t)lr0 * PLD + C_HF + 128 * hi_);
        const char* pv = (const char*)(P + (size_t)lr0 * PLD + C_HI + 128 * hi_); const char* pg = (const char*)(P + (size_t)lr0 * PLD + C_HG + 128 * hi_);
#pragma unroll
        for (int q = 0; q < 2; ++q) { R[q] = *(const u32x4*)(pq + oA[q]); R[2 + q] = *(const u32x4*)(pk + oT[q]); R[4 + q] = *(const u32x4*)(pv + oT[q]); R[7 + q] = *(const u32x4*)(pg + oS[q]); }
        R[6] = *(const u32x4*)(sc + (unsigned)tid * 16u);
        if (tid < 128) Rd = ((const float*)(ws + WS_DEC))[item * 128 + tid];
    };
    auto store_chunk = [&]() {
#pragma unroll
        for (int q = 0; q < 2; ++q) { const int pid = tid + 512 * q; st_perm(QE + (pid >> 4) * 136, pid & 15, R[q]);
            *(LAS u32x4*)(KET + (pid >> 3) * 72 + 8 * (pid & 7)) = R[2 + q]; *(LAS u32x4*)(VT + (pid >> 3) * 72 + 8 * (pid & 7)) = R[4 + q]; }
        *(LAS u32x4*)(SCs + (tid >> 3) * 72 + 8 * (tid & 7)) = R[6];
#pragma unroll
        for (int q = 0; q < 2; ++q) { const int p = lane + 64 * q; *(LAS u32x4*)(GT + (p >> 1) * 136 + 16 * w + 8 * (p & 1)) = R[7 + q]; }
        if (tid < 128) dec[tid] = Rd;
    };
    const float gnv = a.in[I_HON][16 * w + lj];
    load_chunk(0);
    if (tid < 128) tot[tid] = 0.f;
    store_chunk();
#pragma unroll 1
    for (int nl = 0; nl < 16; ++nl) {
        __syncthreads();
        if (nl + 1 < 16) load_chunk(nl + 1);
        bf16x8 Sb[4];
#pragma unroll
        for (int kk = 0; kk < 4; ++kk) Sb[kk] = packacc(S[2 * kk], S[2 * kk + 1]);
        bf16x8 Vb[2];
#pragma unroll
        for (int tk = 0; tk < 2; ++tk) Vb[tk] = fragN(VT, 16 * w + lj, 32 * tk, g, 72);
        f32x4 o[4];
        bf16x8 fa[2][8];
#define LD_QS(bf, mt) do { _Pragma("unroll") for (int kk = 0; kk < 4; ++kk) fa[bf][kk] = fragN(QE, 16 * (mt) + lj, 32 * kk, g, 136); \
            _Pragma("unroll") for (int tk = 0; tk < 2; ++tk) fa[bf][4 + tk] = fragN(SCs, 16 * (mt) + lj, 32 * tk, g, 72); } while (0)
#define LD_KE(bf, m0) do { _Pragma("unroll") for (int m2 = 0; m2 < 4; ++m2) _Pragma("unroll") for (int tk = 0; tk < 2; ++tk) fa[bf][2 * m2 + tk] = fragN(KET, 16 * ((m0) + m2) + lj, 32 * tk, g, 72); } while (0)
#define MF_QS(bf, mt) do { f32x4 c = (f32x4){0.f, 0.f, 0.f, 0.f}; _Pragma("unroll") for (int kk = 0; kk < 4; ++kk) c = MFMA16(fa[bf][kk], Sb[kk], c); \
            _Pragma("unroll") for (int tk = 0; tk < 2; ++tk) c = MFMA16(fa[bf][4 + tk], Vb[tk], c); o[mt] = c; } while (0)
#define MF_KE(bf, m0) do { _Pragma("unroll") for (int m2 = 0; m2 < 4; ++m2) { f32x4 c = S[(m0) + m2] * *(const LAS f32x4*)(dec + 16 * ((m0) + m2) + 4 * g); \
            _Pragma("unroll") for (int tk = 0; tk < 2; ++tk) c = MFMA16(fa[bf][2 * m2 + tk], Vb[tk], c); S[(m0) + m2] = c; } } while (0)
        LD_QS(0, 0); SBAR;
        LD_QS(1, 1); SBAR; MF_QS(0, 0); SBAR;
        LD_QS(0, 2); SBAR; MF_QS(1, 1); SBAR;
        LD_QS(1, 3); SBAR; MF_QS(0, 2); SBAR;
        LD_KE(0, 0); SBAR; MF_QS(1, 3); SBAR;
        LD_KE(1, 4); SBAR; MF_KE(0, 0); SBAR;
        MF_KE(1, 4); SBAR;
#undef LD_QS
#undef LD_KE
#undef MF_QS
#undef MF_KE
        LAS float* tc = tot + 64 * (nl & 1);
        norm_accum(o, tc, lj, g);
        __syncthreads();
        norm_finish(o, tc, GT, gnv, P + (size_t)(b * 1024 + 64 * nl) * PLD + C_HG + 128 * hi_, PLD, dry, sink, w, lane, lj, g);
        if (tid < 64) tot[64 * ((nl + 1) & 1) + tid] = 0.f;
        if (nl + 1 < 16) store_chunk();
    }
#pragma unroll
    for (int m = 0; m < 8; ++m) *(f32x4*)(ST + ((w * 8 + m) * 64 + lane) * 4) = S[m];
    __syncthreads();
}

#ifdef ONLY
#define EN(k) (ONLY == (k))
#else
#define EN(k) 1
#endif
__global__ void __launch_bounds__(512, 2) mk_fwd(KArgs a) {
    extern __shared__ __attribute__((aligned(16))) unsigned char lds_raw[];
    LAS unsigned char* lds = (LAS unsigned char*)lds_raw;
    cg::grid_group grid = cg::this_grid();
    volatile LAS unsigned* bst = (volatile LAS unsigned*)(lds + LDS_BYTES - 64);
    if (threadIdx.x < 2) bst[threadIdx.x] = 0u;
    __syncthreads();
    const XcdBarrier xbar = xcd_barrier_post((unsigned*)(a.ws + WS_BAR), bst);
    int seam = 0;
#define GRID_BAR() do { if (seam == 0) grid.sync(); else xcd_barrier(xbar); ++seam; } while (0)
    const int G = gridDim.x, bx = blockIdx.x;
    unsigned char* ws = a.ws;
    float* ssb = (float*)(ws + WS_SS);
    u16* XN = (u16*)(ws + WS_XN);

#pragma unroll 1
    for (int ph = a.ph_lo; ph < a.ph_hi; ++ph) {
        const int ptype = ph == 0 ? 0 : (ph == 1 || ph == 20) ? 1 : (ph == 2 || ph == 19 || ph == 21) ? 2 : ph == 22 ? 7 : 3 + ((ph - 3) & 3);
        (void)ptype;
        {
        constexpr bool dry = false;
        int tid_ = threadIdx.x; asm volatile("" : "+v"(tid_));
        const int tid = tid_, lane = tid & 63, wave = tid >> 6;
        const int gw = bx * 8 + wave, ngw = G * 8;
        LAS float* scr = (LAS float*)(lds + wave * 16384);
        if (EN(0) && ph == 0) {
            convert_weight(a.in[I_F1WI], DM, 2 * DFF, (u16*)(ws + WS_WFI), DM, 0, 1, scr, gw, ngw, lane);
            convert_weight(a.in[I_F1WO], DFF, DM, (u16*)(ws + WS_WFO), DFF, 0, 0, scr, gw, ngw, lane);
            convert_weight(a.in[I_WIN], DM, INW, (u16*)(ws + WS_WIN), DM, 0, 2, scr, gw, ngw, lane);
            convert_weight(a.in[I_WBH], DM, DM, (u16*)(ws + WS_WB), 3072, 0, 0, scr, gw, ngw, lane);
            convert_weight(a.in[I_WBG], 2048, DM, (u16*)(ws + WS_WB), 3072, 1024, 0, scr, gw, ngw, lane);
            convert_weight(a.in[I_WOUT], DM, DM, (u16*)(ws + WS_WOUT), DM, 0, 0, scr, gw, ngw, lane);
            if (bx < 64) { const int idx = bx * 512 + tid; const int k = idx >> 5, c = idx & 31; ((u16*)(ws + WS_WAB))[c * 1024 + k] = (u16)f2bf(a.in[I_WIN][(size_t)k * INW + 8192 + c]); }
            for (int m = gw; m < T_TOK; m += ngw) {
                const f32x4* xr = (const f32x4*)(a.in[I_X] + (size_t)m * DM) + lane; const f32x4* gr = (const f32x4*)a.in[I_F1N] + lane; float s = 0.f;
                unsigned long long* o8 = (unsigned long long*)(XN + (size_t)m * DM) + lane;
#pragma unroll
                for (int q = 0; q < 4; ++q) { const f32x4 v = xr[64 * q], gg = gr[64 * q]; s += (v[0] * v[0] + v[1] * v[1]) + (v[2] * v[2] + v[3] * v[3]);
                    o8[64 * q] = (unsigned long long)pk2(v[0] * gg[0], v[1] * gg[1]) | ((unsigned long long)pk2(v[2] * gg[2], v[3] * gg[3]) << 32); }
                s = wave_sum(s);
                if (lane == 0) { ssb[m] = s; ssb[T_TOK + m] = 0.f; ssb[2 * T_TOK + m] = 0.f; ssb[3 * T_TOK + m] = 0.f; }
            }
        } else if (EN(1) && (ph == 1 || ph == 20)) {
            SchedStd S; S.A = (const char*)(ws + (ph == 1 ? WS_XN : WS_XN3)); S.B = (const char*)(ws + WS_WFI); S.lda = DM; S.ldb = DM; S.nt = 16; S.O.init(64, 22, G, bx);
            EpiSwiglu E; E.H = (u16*)(ws + WS_HID); E.ss = ssb + (ph == 1 ? 0 : 2 * T_TOK);
            pg8::gemm_phase(lds, S, E);
        } else if (EN(2) && (ph == 2 || ph == 19 || ph == 21)) {
            SchedStd S; EpiResid E;
            if (ph == 19) { S.A = (const char*)(ws + WS_XN); S.B = (const char*)(ws + WS_WOUT); S.lda = DM; S.ldb = DM; S.nt = 16;
                E.base = a.out; E.scale = 1.0f; E.xn = (u16*)(ws + WS_XN3); E.g = a.in[I_F2N]; E.ss_out = ssb + 2 * T_TOK; }
            else { S.A = (const char*)(ws + WS_HID); S.B = (const char*)(ws + WS_WFO); S.lda = DFF; S.ldb = DFF; S.nt = 44;
                E.base = ph == 2 ? a.in[I_X] : a.out; E.scale = 0.5f; E.xn = ph == 2 ? XN : nullptr; E.g = a.in[I_MIXN]; E.ss_out = ssb + (ph == 2 ? T_TOK : 3 * T_TOK); }
            E.out = a.out; E.dry = dry; E.dummy = (float*)(ws + WS_DUMMY); S.O.init(64, 4, G, bx);
            pg8::gemm_phase(lds, S, E);
        } else if (ph < 19) {
            const int j = (ph - 3) >> 2, sub = (ph - 3) & 3;
            if (EN(3) && sub == 0) {
                SchedG3 S; S.A = (const char*)XN; S.B = (const char*)(ws + WS_WIN); S.lda = DM; S.ldb = DM; S.nt = 16; S.j = j; S.pn0 = 0; S.perm = (j != 0); S.O.init(16, j == 0 ? 48 : 32, G, bx);
                EpiProj E; E.P = (u16*)(ws + WS_PROJ); E.L = (u16*)(ws + WS_LATE) + (size_t)(j & 1) * 4096 * LLD; E.ss = ssb + T_TOK; E.lbl = a.in[I_LBL]; E.halo = (u16*)(ws + WS_HALO); E.j = j; E.pn0 = 0; E.perm = (j != 0);
                pg8::gemm_phase(lds, S, E);
                if (j == 0) { for (int it = bx; it < 256; it += G) gab_item(lds, a, it * 64); }
            } else if (sub == 1) {
#pragma unroll 1
                for (int it = bx; it < 1024; it += G) {
                    if (EN(4) && it < 512) { if (!(dry && (a.probe & 0x4000))) prep_gdn(lds, a, j, it >> 7, (it >> 3) & 15, it & 7, dry); }
                    else if (EN(5) && it >= 512) { const int i2 = it - 512; if (!(dry && (a.probe & 0x8000))) prep_hgrn(lds, a, i2 >> 7, (i2 >> 3) & 15, i2 & 7, dry); }
                }
            } else if (sub == 2) {
                if (j < 3 && bx >= 96 && !dry) {
                    SchedG3 S; S.A = (const char*)XN; S.B = (const char*)(ws + WS_WIN); S.lda = DM; S.ldb = DM; S.nt = 16; S.j = j + 1; S.pn0 = 32; S.perm = 3; S.O.init(16, 16, G - 96, bx - 96);
                    EpiProj E; E.P = (u16*)(ws + WS_PROJ); E.L = (u16*)(ws + WS_LATE) + (size_t)((j + 1) & 1) * 4096 * LLD; E.ss = ssb + T_TOK; E.lbl = a.in[I_LBL]; E.halo = (u16*)(ws + WS_HALO); E.j = j + 1; E.pn0 = 32; E.perm = 3;
                    pg8::gemm_phase(lds, S, E);
                }
                if (j == 3 && bx >= 96 && !dry) {
                    const int gw2 = (bx - 96) * 8 + wave, ngw2 = (G - 96) * 8;
                    convert_weight(a.in[I_F2WI], DM, 2 * DFF, (u16*)(ws + WS_WFI), DM, 0, 1, scr, gw2, ngw2, lane);
                    convert_weight(a.in[I_F2WO], DFF, DM, (u16*)(ws + WS_WFO), DFF, 0, 0, scr, gw2, ngw2, lane);
                }
#pragma unroll 1
                for (int c = bx; c < 96; c += G) {
                    if (EN(6) && c < 64) { recur_gdn(lds, a, j, c >> 4, c & 15, false); }
                    else if (EN(7) && c >= 64) { recur_hgrn(lds, a, j, (c - 64) >> 3, (c - 64) & 7, false); }
                }
            } else if (EN(8)) {
                SchedG4 S; S.P = (const char*)(ws + WS_PROJ); S.L = (const char*)(ws + WS_LATE) + (size_t)(j & 1) * 4096 * LLD * 2; S.B = (const char*)(ws + WS_WB); S.lda = (bx % 3 == 0) ? PLD : LLD; S.ldb = 3072; S.c = bx;
                EpiG4 E; E.L = (const u16*)(ws + WS_LATE) + (size_t)(j & 1) * 4096 * LLD; E.Y = (u16*)(ws + WS_XN); E.TMP = (u16*)(ws + (j == 3 ? WS_WM : WS_WFI)); E.flags = (unsigned*)(ws + WS_BAR) + 3584; E.j = j;
                pg8::gemm_phase(lds, S, E);
            }
        } else {
            const float* ss4 = ssb + 3 * T_TOK;
            for (int m = gw; m < T_TOK; m += ngw) { f32x4* xr = (f32x4*)(a.out + (size_t)m * DM) + lane; const f32x4* gr = (const f32x4*)a.in[I_FINN] + lane;
                f32x4* xw = dry ? (f32x4*)(ws + WS_DUMMY) + lane : xr;
                const float rs = rsqrtf(ss4[m] * (1.0f / 1024.0f) + EPS);
#pragma unroll
                for (int q = 0; q < 4; ++q) xw[dry ? 0 : 64 * q] = xr[64 * q] * gr[64 * q] * rs; }
        }
        if (dry) GRID_BAR();
        }
        if (ph + 1 < a.ph_hi) GRID_BAR();
    }
}

#ifndef PROBE_MASK
#define PROBE_MASK 0
#endif
extern "C" void kernel_launch(void* const* d_in, const int* in_sizes, int n_in, void* d_out, int out_size, void* d_ws, size_t ws_size, hipStream_t stream) {
    static int grid = 0;
    if (grid == 0) {
        if (n_in != 19 || ws_size < WS_END) { fprintf(stderr, "kernel_launch: unexpected inputs (n_in %d, ws %zu)\n", n_in, ws_size); grid = -1; return; }
        int dev = 0, cus = 0, per_cu = 0;
        hipGetDevice(&dev); hipDeviceGetAttribute(&cus, hipDeviceAttributeMultiprocessorCount, dev);
        hipFuncSetAttribute((const void*)mk_fwd, hipFuncAttributeMaxDynamicSharedMemorySize, LDS_BYTES);
        hipOccupancyMaxActiveBlocksPerMultiprocessor(&per_cu, (const void*)mk_fwd, 512, LDS_BYTES);
        if (per_cu < 1) { fprintf(stderr, "kernel_launch: occupancy query says %d blocks per CU\n", per_cu); per_cu = 1; }
        if (per_cu > 1) per_cu = 1;
        grid = cus * per_cu;
    }
    if (grid < 0) return;
    if (hipMemsetAsync((char*)d_ws + WS_BAR, 0, BAR_BYTES, stream) != hipSuccess) { fprintf(stderr, "kernel_launch: memset failed\n"); return; }
    KArgs a{};
    for (int i = 0; i < 19; ++i) a.in[i] = (const float*)d_in[i];
    a.out = (float*)d_out; a.ws = (unsigned char*)d_ws; a.ph_lo = 0; a.ph_hi = 23; a.probe = PROBE_MASK;
    void* args[] = {&a};
    hipError_t e = hipLaunchCooperativeKernel((const void*)mk_fwd, dim3(grid), dim3(512), args, LDS_BYTES, stream);
    if (e != hipSuccess) fprintf(stderr, "cooperative launch failed: %s (grid %d)\n", hipGetErrorString(e), grid);
}
```

```cpp
#define PROBE_MASK 0x0
#include <hip/hip_runtime.h>
#include <hip/hip_cooperative_groups.h>
#include <cstdio>
namespace cg = cooperative_groups;

#define DI __device__ __forceinline__
#define LAS __attribute__((address_space(3)))
typedef unsigned short u16;
typedef short bf16x8 __attribute__((ext_vector_type(8)));
typedef float f32x4 __attribute__((ext_vector_type(4)));
typedef unsigned u32x4 __attribute__((ext_vector_type(4)));
typedef unsigned u32x2 __attribute__((ext_vector_type(2)));

constexpr int T_TOK = 16384, DM = 1024, DFF = 2816, INW = 12320;
constexpr int PLD = 8192;
constexpr int LLD = 4096;
constexpr int L_GZ = 0, L_GH = 2048, L_GG = 3072;
constexpr int C_HQ = 0, C_HF = 1024, C_HI = 2048, C_HG = 3072, C_GQ = 4096, C_GK = 5120, C_GV = 6144;
constexpr float EPS = 1e-6f;
constexpr size_t MiB = 1u << 20;
constexpr size_t WS_BAR = 512 * 1024, BAR_BYTES = 16384;
constexpr size_t WS_WAB = 256 * 1024;
constexpr size_t WS_SS = 0;
constexpr size_t WS_WIN = 1 * MiB, WS_WB = 25 * MiB, WS_WOUT = 31 * MiB;
constexpr size_t WS_WFI = 33 * MiB, WS_WFO = 44 * MiB;
constexpr size_t WS_XN = 50 * MiB;
constexpr size_t WS_XN3 = 82 * MiB;
constexpr size_t WS_SC = 82 * MiB, WS_WM = 86 * MiB, WS_QK = 102 * MiB, WS_HALO = 110 * MiB;
constexpr size_t WS_HID = 114 * MiB, WS_PROJ = 114 * MiB, WS_LATE = 178 * MiB;
constexpr size_t WS_STATE = 242 * MiB, WS_GAM = 248 * MiB, WS_DEC = 248 * MiB + 512 * 1024;
constexpr size_t WS_DUMMY = 248 * MiB + 768 * 1024;
constexpr size_t WS_GBG = 249 * MiB, WS_GBB = 250 * MiB;
constexpr size_t WS_TMP = 251 * MiB;
constexpr size_t WS_END = 256 * MiB;
constexpr int LDS_BYTES = 159744;

DI unsigned f2bf(float f) { unsigned u = __float_as_uint(f); return (u + 0x7fffu + ((u >> 16) & 1u)) >> 16; }
typedef float f32x2_t __attribute__((ext_vector_type(2)));
typedef __bf16 bf16x2_t __attribute__((ext_vector_type(2)));
DI unsigned pk2(float lo, float hi) { const f32x2_t v = {lo, hi}; return __builtin_bit_cast(unsigned, __builtin_convertvector(v, bf16x2_t)); }
DI float bf2f(unsigned b) { return __uint_as_float(b << 16); }
DI void unpack8(u32x4 w, float (&f)[8]) {
    f[0] = __uint_as_float(w.x << 16); f[1] = __uint_as_float(w.x & 0xffff0000u); f[2] = __uint_as_float(w.y << 16); f[3] = __uint_as_float(w.y & 0xffff0000u);
    f[4] = __uint_as_float(w.z << 16); f[5] = __uint_as_float(w.z & 0xffff0000u); f[6] = __uint_as_float(w.w << 16); f[7] = __uint_as_float(w.w & 0xffff0000u);
}
DI u32x4 pack8(const float (&f)[8]) { u32x4 w; w.x = pk2(f[0], f[1]); w.y = pk2(f[2], f[3]); w.z = pk2(f[4], f[5]); w.w = pk2(f[6], f[7]); return w; }
DI float wave_sum(float v) {
#pragma unroll
    for (int o = 1; o < 64; o <<= 1) v += __shfl_xor(v, o);
    return v;
}
#define DPP_ROR(x, n) __builtin_bit_cast(float, __builtin_amdgcn_update_dpp(0, __builtin_bit_cast(int, (x)), 0x120 + (n), 0xf, 0xf, false))
DI float row16_sum(float x) { x += DPP_ROR(x, 8); x += DPP_ROR(x, 4); x += DPP_ROR(x, 2); x += DPP_ROR(x, 1); return x; }
DI float sigm(float x) { return __builtin_amdgcn_rcpf(1.0f + __expf(-x)); }
DI unsigned cvt_pk_bf16(float lo, float hi) { unsigned r; asm volatile("v_cvt_pk_bf16_f32 %0, %1, %2" : "=v"(r) : "v"(lo), "v"(hi)); return r; }
DI unsigned short f2h(float f) { _Float16 h = (_Float16)f; return __builtin_bit_cast(unsigned short, h); }
DI float h2f(unsigned short b) { return (float)__builtin_bit_cast(_Float16, b); }
DI void st_perm(LAS u16* row, int c, u32x4 v) { const int cc = c & 3; LAS u16* p = row + ((8 * c) & ~31) + 16 * (cc & 1) + 4 * (cc >> 1);
    u32x2 lo, hi; lo.x = v.x; lo.y = v.y; hi.x = v.z; hi.y = v.w; *(LAS u32x2*)p = lo; *(LAS u32x2*)(p + 8) = hi; }
DI size_t widx(bool dry, int tid, size_t idx) { return dry ? (size_t)tid * 8 : idx; }
DI bf16x8 mk8(u32x2 lo, u32x2 hi) { u32x4 w; w.x = lo.x; w.y = lo.y; w.z = hi.x; w.w = hi.y; return __builtin_bit_cast(bf16x8, w); }
DI bf16x8 packacc(f32x4 a, f32x4 b) { u32x4 w; w.x = pk2(a[0], a[1]); w.y = pk2(a[2], a[3]); w.z = pk2(b[0], b[1]); w.w = pk2(b[2], b[3]); return __builtin_bit_cast(bf16x8, w); }
#define MFMA16(a, b, c) __builtin_amdgcn_mfma_f32_16x16x32_bf16((a), (b), (c), 0, 0, 0)
DI bf16x8 fragN(const LAS u16* M, int row, int k0, int g, int stride) { return *(const LAS bf16x8*)(M + row * stride + k0 + 8 * g); }
DI bf16x8 fragP(const LAS u16* M, int row, int k0, int g, int stride) {
    const LAS u16* p = M + row * stride + k0 + 4 * g;
    return mk8(*(const LAS u32x2*)p, *(const LAS u32x2*)(p + 16));
}

#define XB_TMO      128
#define XB_XCNT(j)  (256  + 64 * (j))
#define XB_XSUB(j)  (1280 + 64 * (j))
#define XB_XGEN(j)  (2304 + 64 * (j))
#define XB_TOP      3328
#define XB_TOPGEN   3392
#define XCD_BAR_WORDS 3456
#define XB_SPIN_CAP (1u << 18)

__device__ __forceinline__ unsigned xb_ld(unsigned* p)              { return __hip_atomic_load(p, __ATOMIC_RELAXED, __HIP_MEMORY_SCOPE_AGENT); }
__device__ __forceinline__ unsigned xb_add(unsigned* p, unsigned v) { return __hip_atomic_fetch_add(p, v, __ATOMIC_RELAXED, __HIP_MEMORY_SCOPE_AGENT); }
__device__ __forceinline__ unsigned xb_xcc_id() { return (unsigned)__builtin_amdgcn_s_getreg((3 << 11) | 20) & 0xFu; }
#define XB_SPIN(cond, bar) do { unsigned _sp = 0; while (cond) { __builtin_amdgcn_s_sleep(1); \
    if ((++_sp & 255u) == 0u) { if (xb_ld(&(bar)[XB_TMO])) break; if (_sp > XB_SPIN_CAP) { atomicAdd(&(bar)[XB_TMO], 1u); break; } } } } while (0)

struct XcdBarrier {
    unsigned* bar; unsigned x;
    volatile LAS unsigned* st;
};

__device__ __forceinline__ XcdBarrier xcd_barrier_post(unsigned* bar, volatile LAS unsigned* st) {
    XcdBarrier b; b.bar = bar; b.x = xb_xcc_id(); b.st = st;
    if (threadIdx.x == 0) (void)xb_add(&bar[XB_XCNT(b.x)], 1u);
    return b;
}
__device__ __forceinline__ void xcd_barrier_complete(unsigned* bar, unsigned x, unsigned& nloc, unsigned& nx) {
    const unsigned G = gridDim.x * gridDim.y * gridDim.z;
    unsigned sum, cnt, mine, sp = 0u;
    for (;;) {
        sum = 0u; cnt = 0u; mine = 0u;
#pragma unroll
        for (unsigned j = 0; j < 16; ++j) { const unsigned c = xb_ld(&bar[XB_XCNT(j)]); sum += c; cnt += (c > 0u) ? 1u : 0u; mine = (j == x) ? c : mine; }
        if (sum == G) break;
        __builtin_amdgcn_s_sleep(1);
        if ((++sp & 255u) == 0u) { if (xb_ld(&bar[XB_TMO])) break; if (sp > XB_SPIN_CAP) { atomicAdd(&bar[XB_TMO], 1u); break; } }
    }
    nloc = mine > 0u ? mine : 1u; nx = cnt > 0u ? cnt : 1u;
}

__device__ __forceinline__ void xcd_barrier(const XcdBarrier& b) {
    asm volatile("s_waitcnt vmcnt(0)" ::: "memory");
    __syncthreads();
    if (threadIdx.x == 0) {
        unsigned* bar = b.bar;
        __builtin_amdgcn_s_waitcnt(0);
        unsigned nloc = b.st[0], nx = b.st[1];
        if (nloc == 0u) { xcd_barrier_complete(bar, b.x, nloc, nx); b.st[0] = nloc; b.st[1] = nx; }
        const unsigned old = xb_add(&bar[XB_XSUB(b.x)], 1u);
        const unsigned gen = old / nloc;
        if (old + 1u == (gen + 1u) * nloc) {
            __builtin_amdgcn_fence(__ATOMIC_RELEASE, "agent");
            asm volatile("s_waitcnt vmcnt(0)" ::: "memory");
            const unsigned og = xb_add(&bar[XB_TOP], 1u);
            const unsigned tg = og / nx;
            if (og + 1u == (tg + 1u) * nx) xb_add(&bar[XB_TOPGEN], 1u);
            else XB_SPIN(xb_ld(&bar[XB_TOPGEN]) == tg, bar);
            __builtin_amdgcn_fence(__ATOMIC_ACQUIRE, "agent");
            xb_add(&bar[XB_XGEN(b.x)], 1u);
            asm volatile("s_waitcnt vmcnt(0)" ::: "memory");
        } else {
            XB_SPIN(xb_ld(&bar[XB_XGEN(b.x)]) == gen, bar);
            __builtin_amdgcn_fence(__ATOMIC_ACQUIRE, "agent");
            asm volatile("s_waitcnt vmcnt(0)" ::: "memory");
        }
    }
    __syncthreads();
}


namespace pg8 {
constexpr int BM = 256, BK = 64, HALF = 128, HTB = HALF * BK * 2, NXCD = 8, WGM = 8;
DI int lds_byte(int r, int c) { const int st = (r >> 4) * 2 + (c >> 5), rr = r & 15, cc = c & 31, ob = rr * 64 + cc * 2; return st * 1024 + (ob ^ (((ob >> 9) & 1) << 5)); }
DI void stage_rc(int b, int& R, int& C) { const int st = b / 1024, sb = b % 1024, swz = sb ^ (((sb >> 9) & 1) << 5); R = (st >> 1) * 16 + swz / 64; C = (st & 1) * 32 + (swz % 64) / 2; }
DI int perm32(int rho) { const int n = rho >> 4, i = rho & 15; return 8 * (i >> 2) + 4 * n + (i & 3); }
struct Unit { int pm, pn, part; };
struct Order {
    int nM, nN, nwg, G, c;
    DI void init(int nM_, int nN_, int G_, int c_) { nM = nM_; nN = nN_; nwg = nM * nN; G = G_; c = c_; }
    DI bool next(int i, Unit& u) const {
        const long L = (long)i * G + c; if (L >= nwg) return false;
        int wgid = (int)L; { const int q = nwg / NXCD, r = nwg % NXCD, xcd = wgid % NXCD, off = wgid / NXCD; wgid = (xcd < r ? xcd * (q + 1) : r * (q + 1) + (xcd - r) * q) + off; }
        const int nig = WGM * nN, gid = wgid / nig, fm = gid * WGM, gsz = (nM - fm) < WGM ? (nM - fm) : WGM;
        u.pm = fm + ((wgid % nig) % gsz); u.pn = (wgid % nig) / gsz; u.part = 0; return true;
    }
};

template <class Epi, class Sched>
DI void gemm_phase(LAS unsigned char* lds, const Sched& S, const Epi& E) {
    int tid_ = threadIdx.x; asm volatile("" : "+v"(tid_));
    const int tid = tid_, wid = __builtin_amdgcn_readfirstlane(tid >> 6), lane = tid & 63, wr = wid >> 2, wc = wid & 3, fr = lane & 15, fq = lane >> 4;
    unsigned voffA[2], voffB[2];
#pragma unroll
    for (int i = 0; i < 2; ++i) { int R, C; stage_rc(tid * 16 + i * 8192, R, C); const int Rb = Epi::PERM ? ((R & ~31) + perm32(R & 31)) : R;
        voffA[i] = (unsigned)(R * S.lda + C) * 2u; voffB[i] = (unsigned)(Rb * S.ldb + C) * 2u; }
    const size_t kstep = (size_t)(BK * 2);
    const size_t hstepA = (size_t)HALF * S.lda * 2, hstepB = (size_t)HALF * S.ldb * 2;
    const unsigned ldsw = (unsigned)wid * 1024u;
    const int aoff = lds_byte(wr * 64 + fr, fq * 8), boff = lds_byte(wc * 32 + fr, fq * 8);
#define PG8_SA(b, h) (((b) * 2 + (h)) * HTB)
#define PG8_SB(b, h) ((4 + (b) * 2 + (h)) * HTB)
#define PG8_STAGE(bufoff, gbase, voff) do { _Pragma("unroll") for (int _i = 0; _i < 2; ++_i) \
        __builtin_amdgcn_global_load_lds((const unsigned*)((const char*)(gbase) + (voff)[_i]), (LAS unsigned*)(lds + (bufoff) + ldsw + _i * 8192), 16, 0, 0); } while (0)
#define PG8_LDA(dst, b, h) do { _Pragma("unroll") for (int m = 0; m < 4; ++m) _Pragma("unroll") for (int k = 0; k < 2; ++k) dst[m][k] = *(const LAS bf16x8*)(lds + PG8_SA(b, h) + aoff + m * 2048 + k * 1024); } while (0)
#define PG8_LDB(dst, b, h) do { _Pragma("unroll") for (int n = 0; n < 2; ++n) _Pragma("unroll") for (int k = 0; k < 2; ++k) dst[n][k] = *(const LAS bf16x8*)(lds + PG8_SB(b, h) + boff + n * 2048 + k * 1024); } while (0)
#define PG8_MMA(ai, bj, At, Bt) do { __builtin_amdgcn_s_setprio(1); _Pragma("unroll") for (int m = 0; m < 4; ++m) _Pragma("unroll") for (int n = 0; n < 2; ++n) _Pragma("unroll") for (int k = 0; k < 2; ++k) \
        acc[ai][bj][m][n] = __builtin_amdgcn_mfma_f32_16x16x32_bf16(Bt[n][k], At[m][k], acc[ai][bj][m][n], 0, 0, 0); __builtin_amdgcn_s_setprio(0); } while (0)
#define PG8_WAIT_V(n) asm volatile("s_waitcnt vmcnt(" #n ")" ::: "memory")
#define PG8_WAIT_L(n) asm volatile("s_waitcnt lgkmcnt(" #n ")" ::: "memory")
#define PG8_BAR __builtin_amdgcn_s_barrier()
#define PG8_SCHED __builtin_amdgcn_sched_barrier(0)
    Unit cur, nxt; int ui = 0;
    if (!S.next(0, cur)) return;
    f32x4 acc[2][2][4][2];
#pragma unroll
    for (int a = 0; a < 2; ++a)
#pragma unroll
        for (int b = 0; b < 2; ++b)
#pragma unroll
            for (int m = 0; m < 4; ++m)
#pragma unroll
                for (int n = 0; n < 2; ++n) acc[a][b][m][n] = (f32x4){0.f, 0.f, 0.f, 0.f};
    bf16x8 At[4][2], B0[2][2], B1[2][2];
    const char* cA; const char* cB; S.ptrs(cur, cA, cB);
    PG8_STAGE(PG8_SB(0, 0), cB, voffB); PG8_STAGE(PG8_SB(0, 1), cB + hstepB, voffB); PG8_STAGE(PG8_SA(0, 0), cA, voffA); PG8_STAGE(PG8_SA(0, 1), cA + hstepA, voffA);
    if (wr == 1) PG8_BAR;
    PG8_WAIT_V(2); PG8_BAR;
    PG8_STAGE(PG8_SB(1, 0), cB + kstep, voffB); PG8_STAGE(PG8_SA(1, 0), cA + kstep, voffA); PG8_STAGE(PG8_SB(1, 1), cB + hstepB + kstep, voffB);
    PG8_WAIT_V(6); PG8_BAR;
    for (;;) {
        const bool has_next = S.next(ui + 1, nxt); const int nt = S.ntu(cur);
        const char* nA = cA; const char* nB = cB; if (has_next) S.ptrs(nxt, nA, nB);
        for (int t = 0; t < nt; t += 2) {
            const bool last = (t == nt - 2);
            const char* a1 = cA + (size_t)(t + 1) * kstep;
            const char* a2 = last ? nA : cA + (size_t)(t + 2) * kstep; const char* b2 = last ? nB : cB + (size_t)(t + 2) * kstep;
            const char* a3 = a2 + kstep; const char* b3 = b2 + kstep;
            PG8_LDB(B0, 0, 0); PG8_LDB(B1, 0, 1); PG8_SCHED; PG8_LDA(At, 0, 0); PG8_STAGE(PG8_SA(1, 1), a1 + hstepA, voffA);
            PG8_WAIT_V(8); PG8_WAIT_L(0); PG8_BAR; PG8_MMA(0, 0, At, B0); PG8_MMA(0, 1, At, B1); PG8_BAR; PG8_SCHED;
            PG8_LDA(At, 0, 1); PG8_STAGE(PG8_SB(0, 0), b2, voffB); PG8_STAGE(PG8_SB(0, 1), b2 + hstepB, voffB); PG8_STAGE(PG8_SA(0, 0), a2, voffA);
            PG8_WAIT_V(8); PG8_WAIT_L(0); PG8_BAR; PG8_MMA(1, 0, At, B0); PG8_MMA(1, 1, At, B1); PG8_BAR; PG8_SCHED;
            PG8_LDB(B0, 1, 0); PG8_LDB(B1, 1, 1); PG8_SCHED; PG8_LDA(At, 1, 0); PG8_STAGE(PG8_SA(0, 1), a2 + hstepA, voffA);
            PG8_WAIT_V(8); PG8_WAIT_L(0); PG8_BAR; PG8_MMA(0, 0, At, B0); PG8_MMA(0, 1, At, B1); PG8_BAR; PG8_SCHED;
            PG8_LDA(At, 1, 1); PG8_STAGE(PG8_SB(1, 0), b3, voffB); PG8_STAGE(PG8_SB(1, 1), b3 + hstepB, voffB); PG8_STAGE(PG8_SA(1, 0), a3, voffA);
            PG8_WAIT_V(8); PG8_WAIT_L(0); PG8_BAR; PG8_MMA(1, 0, At, B0); PG8_MMA(1, 1, At, B1); PG8_BAR; PG8_SCHED;
        }
        if (wr == 0) PG8_BAR;
        { int fr2 = fr, fq2 = fq; asm volatile("" : "+v"(fr2), "+v"(fq2)); E(acc, cur, wr, wc, fr2, fq2); }
        if (!has_next) break;
#pragma unroll
        for (int a = 0; a < 2; ++a)
#pragma unroll
            for (int b = 0; b < 2; ++b)
#pragma unroll
                for (int m = 0; m < 4; ++m)
#pragma unroll
                    for (int n = 0; n < 2; ++n) acc[a][b][m][n] = (f32x4){0.f, 0.f, 0.f, 0.f};
        cur = nxt; cA = nA; cB = nB; ++ui;
        if (wr == 1) PG8_BAR;
    }
    PG8_WAIT_V(0);
    PG8_BAR;
#undef PG8_SA
#undef PG8_SB
#undef PG8_STAGE
#undef PG8_LDA
#undef PG8_LDB
#undef PG8_MMA
#undef PG8_WAIT_V
#undef PG8_WAIT_L
#undef PG8_BAR
#undef PG8_SCHED
}
}
using pg8::Unit;
typedef f32x4 Acc[2][2][4][2];

struct KArgs { const float* in[19]; float* out; unsigned char* ws; int ph_lo, ph_hi, probe, pad; };
enum { I_X = 0, I_F1N, I_F1WI, I_F1WO, I_MIXN, I_WIN, I_LBL, I_HON, I_CONVW, I_ALOG, I_DTB, I_GON, I_WBH, I_WBG, I_WOUT, I_F2N, I_F2WI, I_F2WO, I_FINN };

struct SchedStd {
    const char* A; const char* B; int lda, ldb, nt; pg8::Order O;
    DI bool next(int i, Unit& u) const { return O.next(i, u); }
    DI int ntu(const Unit&) const { return nt; }
    DI void ptrs(const Unit& u, const char*& a, const char*& b) const { a = A + (size_t)u.pm * 256 * lda * 2; b = B + (size_t)u.pn * 256 * ldb * 2; }
};
DI int g3_perm(int lp) {
    const int k = lp >> 3, t = lp & 7;
    if (t == 0 || t == 1 || t == 6) { const int i = 3 * k + (t == 6 ? 2 : t); return i < 8 ? i : i + 4; }
    const int i = 5 * k + (t == 7 ? 4 : t - 2); return i < 4 ? 8 + i : 12 + i;
}
DI int g3_late(int lp) { const int lt = lp - 32, k = lt >> 2, t = lt & 3; return t < 2 ? 32 + 2 * k + t : 40 + 2 * k + (t - 2); }
DI int g3_map(int perm, int lp) { return perm == 1 ? g3_perm(lp) : (perm == 3 ? g3_late(lp) : lp); }
struct SchedG3 {
    const char* A; const char* B; int lda, ldb, nt, j, pn0, perm; pg8::Order O;
    DI bool next(int i, Unit& u) const { return O.next(i, u); }
    DI int ntu(const Unit&) const { return nt; }
    DI void ptrs(const Unit& u, const char*& a, const char*& b) const {
        const size_t grow = (size_t)(u.pm >> 2) * 4096 + 1024 * j + (u.pm & 3) * 256;
        const int lp = pn0 + u.pn; a = A + grow * 1024 * 2; b = B + (size_t)g3_map(perm, lp) * 256 * 1024 * 2; }
};
struct SchedG4 {
    const char* P; const char* L; const char* B; int lda, ldb, c;
    DI bool next(int i, Unit& u) const { if (c >= 192 || i >= 1) return false; const int tile = c / 3; u.pm = tile >> 2; u.pn = tile & 3; u.part = c - 3 * tile; return true; }
    DI int ntu(const Unit&) const { return 16; }
    DI void ptrs(const Unit& u, const char*& a, const char*& b) const {
        a = u.part == 0 ? P + ((size_t)u.pm * 256 * PLD + C_HG) * 2 : L + ((size_t)u.pm * 256 * LLD + L_GZ + 1024 * (u.part - 1)) * 2;
        b = B + ((size_t)u.pn * 256 * 3072 + (size_t)u.part * 1024) * 2; }
};

struct EpiSwiglu {
    static constexpr bool PERM = true;
    u16* H; const float* ss;
    DI bool operator()(Acc& acc, const Unit& u, int wr, int wc, int fr, int fq) const {
        const int row0 = u.pm * 256 + wr * 64 + fr, hc0 = u.pn * 128 + wc * 32 + 8 * fq;
#pragma unroll
        for (int ai = 0; ai < 2; ++ai)
#pragma unroll
            for (int m = 0; m < 4; ++m) { const int row = row0 + ai * 128 + m * 16; const float rs = rsqrtf(ss[row] * (1.0f / 1024.0f) + EPS);
                float h[8];
#pragma unroll
                for (int n = 0; n < 2; ++n)
#pragma unroll
                    for (int e = 0; e < 4; ++e) { const float a = acc[ai][0][m][n][e] * rs, b = acc[ai][1][m][n][e] * rs; h[4 * n + e] = a * sigm(a) * b; }
                u32x4 w; w.x = cvt_pk_bf16(h[0], h[1]); w.y = cvt_pk_bf16(h[2], h[3]); w.z = cvt_pk_bf16(h[4], h[5]); w.w = cvt_pk_bf16(h[6], h[7]);
                *(u32x4*)(H + (size_t)row * DFF + hc0) = w; asm volatile("" ::: "memory"); }
        return true;
    }
};
struct EpiResid {
    static constexpr bool PERM = false;
    const float* base; float* out; float scale; u16* xn; const float* g; float* ss_out; bool dry; float* dummy;
    DI bool operator()(Acc& acc, const Unit& u, int wr, int wc, int fr, int fq) const {
        const int row0 = u.pm * 256 + wr * 64 + fr, col0 = u.pn * 256 + wc * 32 + 4 * fq;
#pragma unroll
        for (int ai = 0; ai < 2; ++ai)
#pragma unroll
            for (int m = 0; m < 4; ++m) { const int row = row0 + ai * 128 + m * 16; const size_t off = (size_t)row * DM + col0; float q = 0.f;
#pragma unroll
                for (int bj = 0; bj < 2; ++bj)
#pragma unroll
                    for (int n = 0; n < 2; ++n) { const int co = bj * 128 + n * 16; const f32x4 bs = *(const f32x4*)(base + off + co); const f32x4 o = bs + acc[ai][bj][m][n] * scale;
                        *(f32x4*)(dry ? dummy + 4 * (fr + 16 * fq) : out + off + co) = o; q += (o[0] * o[0] + o[1] * o[1]) + (o[2] * o[2] + o[3] * o[3]);
                        if (xn) { const f32x4 gv = *(const f32x4*)(g + col0 + co); u32x2 w; w.x = cvt_pk_bf16(o[0] * gv[0], o[1] * gv[1]); w.y = cvt_pk_bf16(o[2] * gv[2], o[3] * gv[3]); *(u32x2*)(dry ? (u16*)dummy + 4 * (fr + 16 * fq) : xn + off + co) = w; }
                        asm volatile("" ::: "memory"); }
                q += __shfl_xor(q, 16); q += __shfl_xor(q, 32);
                if (fq == 0 && !dry) atomicAdd(ss_out + row, q); asm volatile("" ::: "memory"); }
        return true;
    }
};
struct EpiProj {
    static constexpr bool PERM = true;
    u16* P; u16* L; const float* ss; const float* lbl; u16* halo; int j, pn0, perm;
    DI bool operator()(Acc& acc, const Unit& u, int wr, int wc, int fr, int fq) const {
        const int b = u.pm >> 2, tl0 = (u.pm & 3) * 256 + wr * 64 + fr;
        const int pn = g3_map(perm, pn0 + u.pn); const int kind = pn < 4 ? 0 : pn < 8 ? 1 : pn < 12 ? 2 : pn < 16 ? 3 : pn < 32 ? 4 : pn < 40 ? 5 : 6;
        float lb[2][8];
#pragma unroll
        for (int bj = 0; bj < 2; ++bj)
#pragma unroll
            for (int e = 0; e < 8; ++e) lb[bj][e] = 0.f;
        const float sc = kind == 0 ? 0.08838834764831845f : 1.0f;
#pragma unroll
        for (int ai = 0; ai < 2; ++ai)
#pragma unroll
            for (int m = 0; m < 4; ++m) { const int tl = tl0 + ai * 128 + m * 16; const int lr = b * 1024 + tl; const int gr = b * 4096 + 1024 * j + tl;
                const float rs = rsqrtf(ss[gr] * (1.0f / 1024.0f) + EPS);
#pragma unroll
                for (int bj = 0; bj < 2; ++bj) { const int col = pn * 256 + bj * 128 + wc * 32 + 8 * fq; float r[8];
#pragma unroll
                    for (int n = 0; n < 2; ++n)
#pragma unroll
                        for (int e = 0; e < 4; ++e) { const float v = acc[ai][bj][m][n][e] * rs; float o = v;
                            if (kind == 5) o = v * sigm(v);
                            r[4 * n + e] = o; }
                    u32x4 w;
                    if (kind == 1) { w.x = f2h(r[0]) | ((unsigned)f2h(r[1]) << 16); w.y = f2h(r[2]) | ((unsigned)f2h(r[3]) << 16); w.z = f2h(r[4]) | ((unsigned)f2h(r[5]) << 16); w.w = f2h(r[6]) | ((unsigned)f2h(r[7]) << 16); }
                    else { w.x = cvt_pk_bf16(r[0], r[1]); w.y = cvt_pk_bf16(r[2], r[3]); w.z = cvt_pk_bf16(r[4], r[5]); w.w = cvt_pk_bf16(r[6], r[7]); }
                    if (pn < 32) *(u32x4*)(P + (size_t)lr * PLD + col) = w; else *(u32x4*)(L + (size_t)lr * LLD + (col - 8192)) = w;
                    if (kind == 4 && (tl & 63) >= 61) { const int n_ch = (1024 * j + tl) >> 6; *(u32x4*)(halo + ((size_t)((b * 32 + (n_ch & 31)) * 3 + (tl & 63) - 61)) * 4096 + (col - C_GQ)) = w; } }
                asm volatile("" ::: "memory"); }
        return true;
    }
};
struct EpiG4 {
    static constexpr bool PERM = true;
    const u16* L; u16* Y; u16* TMP; unsigned* flags; int j;
    DI bool operator()(Acc& acc, const Unit& u, int wr, int wc, int fr, int fq) const {
        const int b = u.pm >> 2, tl0 = (u.pm & 3) * 256 + wr * 64 + fr, col0 = u.pn * 256 + wc * 32 + 8 * fq;
        unsigned* flag = flags + (j * 64 + u.pm * 4 + u.pn);
        int part = u.part; asm volatile("" : "+s"(part));
        if (part != 0) {
            u16* T = TMP + (size_t)(part - 1) * 4096 * DM;
#pragma unroll
            for (int ai = 0; ai < 2; ++ai)
#pragma unroll
                for (int m = 0; m < 4; ++m) { const int tl = tl0 + ai * 128 + m * 16; const int lr = b * 1024 + tl;
#pragma unroll
                    for (int bj = 0; bj < 2; ++bj) { const int col = col0 + bj * 128;
                        float gg[8]; unpack8(*(const u32x4*)(L + (size_t)lr * LLD + L_GG + col), gg); float y[8];
#pragma unroll
                        for (int e = 0; e < 8; ++e) gg[e] = sigm(gg[e]);
#pragma unroll
                        for (int n = 0; n < 2; ++n)
#pragma unroll
                            for (int e = 0; e < 4; ++e) y[4 * n + e] = acc[ai][bj][m][n][e] * gg[4 * n + e];
                        u32x4 w; w.x = cvt_pk_bf16(y[0], y[1]); w.y = cvt_pk_bf16(y[2], y[3]); w.z = cvt_pk_bf16(y[4], y[5]); w.w = cvt_pk_bf16(y[6], y[7]);
                        *(u32x4*)(T + (size_t)lr * DM + col) = w; }
                    asm volatile("" ::: "memory"); }
            asm volatile("s_waitcnt vmcnt(0)" ::: "memory");
            __syncthreads();
            if (threadIdx.x == 0) { __builtin_amdgcn_fence(__ATOMIC_RELEASE, "agent"); asm volatile("s_waitcnt vmcnt(0)" ::: "memory"); (void)__hip_atomic_fetch_add(flag, 1u, __ATOMIC_RELAXED, __HIP_MEMORY_SCOPE_AGENT); }
        } else {
            if (threadIdx.x == 0) { unsigned sp = 0;
                while (__hip_atomic_load(flag, __ATOMIC_RELAXED, __HIP_MEMORY_SCOPE_AGENT) < 2u) { __builtin_amdgcn_s_sleep(2); if (++sp > (1u << 22)) break; }
                __builtin_amdgcn_fence(__ATOMIC_ACQUIRE, "agent"); asm volatile("s_waitcnt vmcnt(0)" ::: "memory"); }
            __syncthreads();
#pragma unroll
            for (int ai = 0; ai < 2; ++ai)
#pragma unroll
                for (int m = 0; m < 4; ++m) { const int tl = tl0 + ai * 128 + m * 16; const int lr = b * 1024 + tl; const int gr = b * 4096 + 1024 * j + tl;
#pragma unroll
                    for (int bj = 0; bj < 2; ++bj) { const int col = col0 + bj * 128;
                        float gh[8], t1[8], t2[8]; unpack8(*(const u32x4*)(L + (size_t)lr * LLD + L_GH + col), gh);
#pragma unroll
                        for (int e = 0; e < 8; ++e) gh[e] = sigm(gh[e]);
                        unpack8(*(const u32x4*)(TMP + (size_t)lr * DM + col), t1); unpack8(*(const u32x4*)(TMP + (size_t)4096 * DM + (size_t)lr * DM + col), t2); float y[8];
#pragma unroll
                        for (int n = 0; n < 2; ++n)
#pragma unroll
                            for (int e = 0; e < 4; ++e) y[4 * n + e] = acc[ai][bj][m][n][e] * gh[4 * n + e] + (t1[4 * n + e] + t2[4 * n + e]);
                        u32x4 w; w.x = cvt_pk_bf16(y[0], y[1]); w.y = cvt_pk_bf16(y[2], y[3]); w.z = cvt_pk_bf16(y[4], y[5]); w.w = cvt_pk_bf16(y[6], y[7]);
                        *(u32x4*)(Y + (size_t)gr * DM + col) = w; }
                    asm volatile("" ::: "memory"); }
        }
        return true;
    }
};

DI void transpose_item(const float* W, int N, u16* WT, int ldd, int koff, LAS float* scr, int kb, int nb, int lane, int mode) {
    const int k0 = 64 * kb, n0 = 32 * nb;
#pragma unroll 8
    for (int i = 0; i < 32; ++i) { const int kk = 2 * i + (lane >> 5); scr[kk * 33 + (lane & 31)] = W[(size_t)(k0 + kk) * N + n0 + (lane & 31)]; }
    asm volatile("s_waitcnt lgkmcnt(0)" ::: "memory");
    const int c = lane & 7;
#pragma unroll
    for (int jj = 0; jj < 4; ++jj) { const int n = (lane >> 3) + 8 * jj; const int cn = n0 + n; int dr = cn;
        if (mode == 1) { if (cn < DFF) dr = 256 * (cn >> 7) + (cn & 127); else { const int q = cn - DFF; dr = 256 * (q >> 7) + 128 + (q & 127); } }
        if (mode == 2) { if (cn >= 8224) dr = cn - 32; }
        const LAS float* s = scr + (8 * c) * 33 + n;
        u32x4 o; o.x = pk2(s[0 * 33], s[1 * 33]); o.y = pk2(s[2 * 33], s[3 * 33]); o.z = pk2(s[4 * 33], s[5 * 33]); o.w = pk2(s[6 * 33], s[7 * 33]);
        *(u32x4*)(WT + (size_t)dr * ldd + koff + k0 + 8 * c) = o; }
    asm volatile("s_waitcnt lgkmcnt(0)" ::: "memory");
}
DI void convert_weight(const float* W, int K, int N, u16* WT, int ldd, int koff, int mode, LAS float* scr, int gw, int ngw, int lane) {
    const int nblk = N / 32, nitems = (K / 64) * nblk;
    for (int it = gw; it < nitems; it += ngw) { const int kb = it / nblk, nb = it % nblk; if (mode == 2 && nb == 256) continue; transpose_item(W, N, WT, ldd, koff, scr, kb, nb, lane, mode); }
}

DI void gab_item(LAS unsigned char* lds, const KArgs& a, int gr0) {
    int tid_ = threadIdx.x; asm volatile("" : "+v"(tid_));
    const int tid = tid_, lane = tid & 63, wid = tid >> 6, lj = lane & 15, g = lane >> 4;
    unsigned char* ws = a.ws; const u16* XN = (const u16*)(ws + WS_XN); const u16* WAB = (const u16*)(ws + WS_WAB); const float* ss2 = (const float*)(ws + WS_SS) + T_TOK;
    LAS float* red = (LAS float*)lds;
    f32x4 acc[2][4];
#pragma unroll
    for (int nt = 0; nt < 2; ++nt)
#pragma unroll
        for (int mt = 0; mt < 4; ++mt) acc[nt][mt] = (f32x4){0.f, 0.f, 0.f, 0.f};
#pragma unroll
    for (int q = 0; q < 4; ++q) { const int kk = 4 * wid + q; bf16x8 bfr[2], afr[4];
#pragma unroll
        for (int nt = 0; nt < 2; ++nt) bfr[nt] = *(const bf16x8*)(WAB + (size_t)(16 * nt + lj) * 1024 + 32 * kk + 8 * g);
#pragma unroll
        for (int mt = 0; mt < 4; ++mt) afr[mt] = *(const bf16x8*)(XN + (size_t)(gr0 + 16 * mt + lj) * 1024 + 32 * kk + 8 * g);
#pragma unroll
        for (int nt = 0; nt < 2; ++nt)
#pragma unroll
            for (int mt = 0; mt < 4; ++mt) acc[nt][mt] = MFMA16(afr[mt], bfr[nt], acc[nt][mt]); }
#pragma unroll
    for (int nt = 0; nt < 2; ++nt)
#pragma unroll
        for (int mt = 0; mt < 4; ++mt)
#pragma unroll
            for (int r = 0; r < 4; ++r) red[(wid * 64 + 16 * mt + 4 * g + r) * 32 + 16 * nt + lj] = acc[nt][mt][r];
    __syncthreads();
#pragma unroll
    for (int q = 0; q < 4; ++q) { const int idx = tid + 512 * q, tok = idx >> 5, col = idx & 31; float sum = 0.f;
#pragma unroll
        for (int w2 = 0; w2 < 8; ++w2) sum += red[(w2 * 64 + tok) * 32 + col];
        sum *= rsqrtf(ss2[gr0 + tok] * (1.0f / 1024.0f) + EPS);
        if (col < 16) { const float xx = sum + a.in[I_DTB][col]; const float sp = xx > 20.f ? xx : log1pf(__expf(xx)); ((float*)(ws + WS_GBG))[(size_t)(gr0 + tok) * 16 + col] = -__expf(a.in[I_ALOG][col]) * sp; }
        else ((float*)(ws + WS_GBB))[(size_t)(gr0 + tok) * 16 + col - 16] = sigm(sum); }
    __syncthreads();
}
DI int swt(int v) { return ((v >> 3) ^ v) & 7; }
DI int swz(int v, int s) { return v * 64 + ((((s >> 3) ^ swt(v)) & 7) << 3) + (s & 7); }
DI void prep_gdn(LAS unsigned char* lds, const KArgs& a, int j, int b, int nl, int hq, bool dry) {
    int tid_ = threadIdx.x; asm volatile("" : "+v"(tid_));
    const int tid = tid_, lane = tid & 63, wid = tid >> 6, lj = lane & 15, g = lane >> 4;
    unsigned char* ws = a.ws;
    u16* P = (u16*)(ws + WS_PROJ); u16* Pw = dry ? (u16*)(ws + WS_DUMMY) : P; const u16* XN = (const u16*)(ws + WS_XN); const u16* halo = (const u16*)(ws + WS_HALO); const float* ss2 = (const float*)(ws + WS_SS) + T_TOK;
    const int n = 16 * j + nl, lr0 = b * 1024 + 64 * nl, gr0 = b * 4096 + 64 * n;
    LAS u16* QGs = (LAS u16*)lds;
    LAS u16* KGs = QGs + 64 * 136;
    LAS u16* VBT = KGs + 64 * 136;
    LAS u16* KBT = VBT + 2 * 128 * 64;
    LAS float* AM = (LAS float*)(KBT + 2 * 128 * 64);
    LAS u16* TM = (LAS u16*)(AM + 2 * 64 * 68);
    LAS float* gms = (LAS float*)(TM + 2 * 64 * 72);
    const bool sk1 = dry && (a.probe & 0x10000), sk2 = dry && (a.probe & 0x20000), sk3 = dry && (a.probe & 0x40000), sk4 = dry && (a.probe & 0x80000), sk5 = dry && (a.probe & 0x100000);
    const int mat = tid >> 7, tg = (tid >> 4) & 7, c8 = tid & 15, t0 = 8 * tg;
    const int cb = mat == 0 ? C_GQ + 128 * hq : (mat == 1 ? C_GK + 128 * hq : C_GV + 128 * (2 * hq + mat - 2));
    const int wcol = cb - C_GQ + 8 * c8;
    u32x4 raw[11];
#pragma unroll
    for (int rr = 0; rr < 11; ++rr) { const int tt = t0 - 3 + rr; raw[rr] = (u32x4){0u, 0u, 0u, 0u};
        if (tt >= 0) raw[rr] = *(const u32x4*)(P + (size_t)(lr0 + tt) * PLD + cb + 8 * c8);
        else if (n > 0) raw[rr] = *(const u32x4*)(halo + ((size_t)((b * 32 + ((n - 1) & 31)) * 3 + (3 + tt))) * 4096 + wcol); }
    float w[4][8];
#pragma unroll
    for (int jj = 0; jj < 4; ++jj) { const f32x4 w0 = *(const f32x4*)(a.in[I_CONVW] + jj * 4096 + wcol), w1 = *(const f32x4*)(a.in[I_CONVW] + jj * 4096 + wcol + 4);
#pragma unroll
        for (int e = 0; e < 4; ++e) { w[jj][e] = w0[e]; w[jj][4 + e] = w1[e]; } }
    if (tid < 128) { const int e = tid >> 6, tok = tid & 63;
        gms[e * 64 + tok] = ((const float*)(ws + WS_GBG))[(size_t)(gr0 + tok) * 16 + 2 * hq + e]; gms[128 + e * 64 + tok] = ((const float*)(ws + WS_GBB))[(size_t)(gr0 + tok) * 16 + 2 * hq + e]; }
    __syncthreads();
    if (wid < 2) { float v = gms[wid * 64 + lane];
#pragma unroll
        for (int o = 1; o < 64; o <<= 1) { const float t = __shfl_up(v, o); if (lane >= o) v += t; }
        gms[wid * 64 + lane] = v; }
    __syncthreads();
    if (!sk2) {
        float y[8][8];
#pragma unroll
        for (int i = 0; i < 8; ++i)
#pragma unroll
            for (int e = 0; e < 8; ++e) y[i][e] = 0.f;
#pragma unroll
        for (int rr = 0; rr < 11; ++rr) { float x[8]; unpack8(raw[rr], x);
#pragma unroll
            for (int jj = 0; jj < 4; ++jj) { const int i = rr - jj; if (i >= 0 && i < 8) {
#pragma unroll
                for (int e = 0; e < 8; ++e) y[i][e] += w[jj][e] * x[e]; } } }
#pragma unroll
        for (int i = 0; i < 8; ++i) {
#pragma unroll
            for (int e = 0; e < 8; ++e) y[i][e] = y[i][e] * sigm(y[i][e]);
            if (mat < 2) { float q = 0.f;
#pragma unroll
                for (int e = 0; e < 8; ++e) q += y[i][e] * y[i][e];
                q = row16_sum(q);
                const float sc = rsqrtf(q + EPS) * (mat == 0 ? 0.08838834764831845f : 1.0f);
#pragma unroll
                for (int e = 0; e < 8; ++e) y[i][e] *= sc;
                *(LAS u32x4*)((mat == 0 ? QGs : KGs) + (t0 + i) * 136 + 8 * c8) = pack8(y[i]); } }
        if (mat >= 1) {
#pragma unroll
            for (int ee = 0; ee < 2; ++ee) { if (mat == 1 || mat - 2 == ee) {
                float f[8];
#pragma unroll
                for (int i = 0; i < 8; ++i) f[i] = gms[128 + ee * 64 + t0 + i] * (mat == 1 ? __expf(gms[ee * 64 + t0 + i]) : 1.0f);
                LAS u16* dst = (mat == 1 ? KBT : VBT) + ee * 8192;
#pragma unroll
                for (int e = 0; e < 8; ++e) { const int v = 8 * c8 + e; float col[8];
#pragma unroll
                    for (int i = 0; i < 8; ++i) col[i] = y[i][e] * f[i];
                    *(LAS u32x4*)(dst + v * 64 + (((tg ^ swt(v)) & 7) << 3)) = pack8(col); } } }
        }
    }
    __syncthreads();
    const int cv0 = ((b * 16 + nl) * 16 + 2 * hq);
    u16* QKo = (u16*)(ws + WS_QK); u16* WMo = (u16*)(ws + WS_WM); float* GAMo = (float*)(ws + WS_GAM);
#pragma unroll
    for (int x = 0; x < 2; ++x) { if (sk3) break; const int tt = 2 * wid + x, mi = tt >> 2, ni = tt & 3;
        f32x4 kk = (f32x4){0.f, 0.f, 0.f, 0.f}, qk = (f32x4){0.f, 0.f, 0.f, 0.f};
#pragma unroll
        for (int ks = 0; ks < 4; ++ks) { const bf16x8 ka = fragN(KGs, 16 * mi + lj, 32 * ks, g, 136), kb2 = fragN(KGs, 16 * ni + lj, 32 * ks, g, 136), qb = fragN(QGs, 16 * ni + lj, 32 * ks, g, 136);
            kk = MFMA16(ka, kb2, kk); qk = MFMA16(ka, qb, qk); }
#pragma unroll
        for (int e = 0; e < 2; ++e) {
#pragma unroll
            for (int r = 0; r < 4; ++r) { const int t = 16 * mi + 4 * g + r, s = 16 * ni + lj;
                AM[e * 4352 + t * 68 + s] = (s < t) ? kk[r] * gms[128 + e * 64 + t] * __expf(gms[e * 64 + t] - gms[e * 64 + s]) : 0.f; }
            const int t = 16 * ni + lj; float o4[4];
#pragma unroll
            for (int r = 0; r < 4; ++r) { const int s = 16 * mi + 4 * g + r; o4[r] = (s <= t) ? qk[r] * __expf(gms[e * 64 + t] - gms[e * 64 + s]) : 0.f; }
            u32x2 w; w.x = pk2(o4[0], o4[1]); w.y = pk2(o4[2], o4[3]);
            *(LAS u32x2*)(TM + e * 4608 + t * 72 + 16 * mi + 4 * g) = w; } }
    __syncthreads();
#pragma unroll
    for (int q = 0; q < 2; ++q) { const int pid = tid + 512 * q, e = pid >> 9, row = (pid >> 3) & 63, c = pid & 7;
        *(u32x4*)(QKo + (size_t)(cv0 + e) * 4096 + row * 64 + 8 * c) = *(const LAS u32x4*)(TM + e * 4608 + row * 72 + 8 * c); }
    __syncthreads();
    if (wid < 2 && !sk4) { const LAS float* Ae = AM + wid * 4352; float Tc[64];
        f32x4 an[16], ac[16];
        Tc[0] = (lane == 0) ? 1.f : 0.f;
        an[0] = *(const LAS f32x4*)(Ae + 68);
#pragma unroll
        for (int i = 1; i < 64; ++i) {
#pragma unroll
            for (int q = 0; q < (i + 3) / 4; ++q) ac[q] = an[q];
            if (i + 1 < 64) {
#pragma unroll
                for (int q = 0; q < (i + 4) / 4; ++q) an[q] = *(const LAS f32x4*)(Ae + (i + 1) * 68 + 4 * q); }
            __builtin_amdgcn_sched_barrier(0);
            float s0 = (i == lane) ? 1.f : 0.f, s1 = 0.f;
#pragma unroll
            for (int jj = 0; jj < i; ++jj) { if (jj & 1) s1 -= ac[jj >> 2][jj & 3] * Tc[jj]; else s0 -= ac[jj >> 2][jj & 3] * Tc[jj]; }
            Tc[i] = s0 + s1;
            __builtin_amdgcn_sched_barrier(0);
        }
#pragma unroll
        for (int i = 0; i < 64; ++i) TM[wid * 4608 + i * 72 + lane] = (u16)f2bf(Tc[i]);
    } else if (wid >= 2) { const int t2 = tid - 128;
        for (int pid = t2; pid < 1024; pid += 384) { const int row = pid >> 4, c = pid & 15; *(u32x4*)(Pw + widx(dry, tid, (size_t)(lr0 + row) * PLD + C_GQ + 128 * hq + 8 * c)) = *(const LAS u32x4*)(QGs + row * 136 + 8 * c); }
        for (int pid = t2; pid < 1024; pid += 384) { const int k = pid >> 3, c = pid & 7; float v[8];
#pragma unroll
            for (int e = 0; e < 8; ++e) v[e] = bf2f(KGs[(8 * c + e) * 136 + k]);
            *(u32x4*)(Pw + widx(dry, tid, (size_t)(lr0 + (k >> 1)) * PLD + C_GK + 128 * hq + 64 * (k & 1) + 8 * c)) = pack8(v); }
        if (t2 < 128) GAMo[(size_t)(cv0 + (t2 >> 6)) * 64 + (t2 & 63)] = gms[t2];
    }
    __syncthreads();
    LAS u16* WMst = QGs;
    LAS u16* UTst = (LAS u16*)AM;
    if (!sk5) { const int e = wid >> 2, q = wid & 3; const LAS u16* Te = TM + e * 4608;
        bf16x8 ta[2];
#pragma unroll
        for (int ks = 0; ks < 2; ++ks) ta[ks] = fragN(Te, 16 * q + lj, 32 * ks, g, 72);
#pragma unroll
        for (int vt = 0; vt < 8; ++vt) { const int v = 16 * vt + lj; f32x4 c = (f32x4){0.f, 0.f, 0.f, 0.f};
#pragma unroll
            for (int ks = 0; ks < 2; ++ks) c = MFMA16(ta[ks], *(const LAS bf16x8*)(VBT + e * 8192 + v * 64 + ((((4 * ks + g) ^ swt(v)) & 7) << 3)), c);
            const int t = 16 * q + 4 * g; u32x2 w; w.x = pk2(c[0], c[1]); w.y = pk2(c[2], c[3]);
            *(LAS u32x2*)(UTst + e * 8192 + v * 64 + t) = w; }
        bf16x8 tb[4][2];
#pragma unroll
        for (int tt = 0; tt < 4; ++tt)
#pragma unroll
            for (int ks = 0; ks < 2; ++ks) tb[tt][ks] = fragN(Te, 16 * tt + lj, 32 * ks, g, 72);
#pragma unroll
        for (int k2 = 0; k2 < 2; ++k2) { const int kt = 2 * q + k2, k = 16 * kt + lj; bf16x8 ka[2];
#pragma unroll
            for (int ks = 0; ks < 2; ++ks) ka[ks] = *(const LAS bf16x8*)(KBT + e * 8192 + k * 64 + ((((4 * ks + g) ^ swt(k)) & 7) << 3));
#pragma unroll
            for (int tt = 0; tt < 4; ++tt) { f32x4 c = (f32x4){0.f, 0.f, 0.f, 0.f};
#pragma unroll
                for (int ks = 0; ks < 2; ++ks) c = MFMA16(ka[ks], tb[tt][ks], c);
                const int t = 16 * tt + lj, kk = 16 * kt + 4 * g; u32x2 w; w.x = pk2(c[0], c[1]); w.y = pk2(c[2], c[3]);
                *(LAS u32x2*)(WMst + e * 8704 + t * 136 + kk) = w; } }
    }
    __syncthreads();
#pragma unroll
    for (int q = 0; q < 4; ++q) { const int pid = tid + 512 * q, e = pid >> 10, r10 = pid & 1023;
        { const int v = r10 >> 3, c = r10 & 7; *(u32x4*)(Pw + widx(dry, tid, (size_t)(lr0 + (v >> 1)) * PLD + C_GV + 128 * (2 * hq + e) + 64 * (v & 1) + 8 * c)) = *(const LAS u32x4*)(UTst + e * 8192 + v * 64 + 8 * c); }
        { const int t = r10 >> 4, c = r10 & 15; *(u32x4*)(WMo + (size_t)(cv0 + e) * 8192 + t * 128 + 8 * c) = *(const LAS u32x4*)(WMst + e * 8704 + t * 136 + 8 * c); } }
    __syncthreads();
}

DI void prep_hgrn(LAS unsigned char* lds, const KArgs& a, int b, int nl, int hi_, bool dry) {
    int tid_ = threadIdx.x; asm volatile("" : "+v"(tid_));
    const int tid = tid_, lane = tid & 63, wid = tid >> 6, lj = lane & 15, g = lane >> 4;
    unsigned char* ws = a.ws; u16* P = (u16*)(ws + WS_PROJ); u16* Pw = dry ? (u16*)(ws + WS_DUMMY) : P;
    const int lr0 = b * 1024 + 64 * nl; const int item = (b * 16 + nl) * 8 + hi_;
    LAS float* segs = (LAS float*)lds;
    LAS u16* Qs = (LAS u16*)(segs + 512);
    LAS u16* Ks = Qs + 64 * 136;
    const int k = tid & 127, seg = tid >> 7;
    const float lbk = __builtin_amdgcn_rcpf(1.0f + __expf(a.in[I_LBL][1024 + 128 * hi_ + k] - a.in[I_LBL][128 * hi_ + k]));
    float q[16], lf[16], vv[16];
#pragma unroll
    for (int r = 0; r < 16; ++r) { const size_t ro = (size_t)(lr0 + 16 * seg + r) * PLD + 128 * hi_ + k;
        const float qv = bf2f(P[ro + C_HQ]), fv = h2f(P[ro + C_HF]); q[r] = qv * sigm(qv) * 0.08838834764831845f; lf[r] = __logf(lbk + (1.0f - lbk) * sigm(fv)); vv[r] = bf2f(P[ro + C_HI]); }
    float cs[16]; { float s = 0.f;
#pragma unroll
        for (int r = 0; r < 16; ++r) { s += lf[r]; cs[r] = s; } }
    segs[seg * 128 + k] = cs[15];
    __syncthreads();
    const float s0 = segs[k], s1 = segs[128 + k], s2 = segs[256 + k], s3 = segs[384 + k];
    const float pre = seg == 0 ? 0.f : (seg == 1 ? s0 : (seg == 2 ? s0 + s1 : s0 + s1 + s2));
    const float bmid = s0 + s1, bend = s0 + s1 + s2 + s3;
    float ke[16], qe[16];
#pragma unroll
    for (int r = 0; r < 16; ++r) { const float bb = pre + cs[r]; const float kh = -expm1f(lf[r]); const int t = 16 * seg + r;
        qe[r] = q[r] * __expf(bb); ke[r] = kh * __expf(bend - bb);
        Qs[t * 136 + k] = (u16)f2bf(q[r] * __expf(bb - bmid)); Ks[t * 136 + k] = (u16)f2bf(kh * __expf(bmid - bb)); }
#pragma unroll
    for (int r = 0; r < 16; ++r) Pw[widx(dry, tid, (size_t)(lr0 + 16 * seg + r) * PLD + C_HQ + 128 * hi_ + k)] = (u16)f2bf(qe[r]);
    { u16* kd = Pw + widx(dry, 2 * tid, (size_t)(lr0 + (k >> 1)) * PLD + C_HF + 128 * hi_ + 64 * (k & 1) + 16 * seg); u16* vd = Pw + widx(dry, 2 * tid, (size_t)(lr0 + (k >> 1)) * PLD + C_HI + 128 * hi_ + 64 * (k & 1) + 16 * seg);
        float t8[8];
#pragma unroll
        for (int h = 0; h < 2; ++h) {
#pragma unroll
            for (int e = 0; e < 8; ++e) t8[e] = ke[8 * h + e];
            *(u32x4*)(kd + 8 * h) = pack8(t8);
#pragma unroll
            for (int e = 0; e < 8; ++e) t8[e] = vv[8 * h + e];
            *(u32x4*)(vd + 8 * h) = pack8(t8); } }
    if (seg == 0) ((float*)(ws + WS_DEC))[(size_t)item * 128 + k] = __expf(bend);
    __syncthreads();
    u16* SCo = (u16*)(ws + WS_SC) + (size_t)item * 4096;
#pragma unroll 1
    for (int x = 0; x < 2; ++x) { const int tt = 2 * wid + x, mi = tt >> 2, ni = tt & 3; f32x4 c = (f32x4){0.f, 0.f, 0.f, 0.f};
        if (mi <= ni) {
#pragma unroll
            for (int ks = 0; ks < 4; ++ks) c = MFMA16(fragN(Ks, 16 * mi + lj, 32 * ks, g, 136), fragN(Qs, 16 * ni + lj, 32 * ks, g, 136), c); }
        const int t = 16 * ni + lj; float o4[4];
#pragma unroll
        for (int r = 0; r < 4; ++r) { const int s = 16 * mi + 4 * g + r; o4[r] = (s <= t) ? c[r] : 0.f; }
        u32x2 w; w.x = pk2(o4[0], o4[1]); w.y = pk2(o4[2], o4[3]);
        *(u32x2*)(SCo + t * 64 + 16 * mi + 4 * g) = w; }
    __syncthreads();
}

DI void norm_accum(const f32x4 (&o)[4], LAS float* tot, int lj, int g) {
#pragma unroll
    for (int mt = 0; mt < 4; ++mt) { f32x4 q = o[mt] * o[mt];
        q[0] = row16_sum(q[0]); q[1] = row16_sum(q[1]); q[2] = row16_sum(q[2]); q[3] = row16_sum(q[3]);
        if (lj == 0) {
#pragma unroll
            for (int r = 0; r < 4; ++r) (void)__hip_atomic_fetch_add(tot + 16 * mt + 4 * g + r, q[r], __ATOMIC_RELAXED, __HIP_MEMORY_SCOPE_WORKGROUP); } }
}
DI void norm_finish(const f32x4 (&o)[4], const LAS float* tot, LAS u16* GT, float gnv, u16* gdst  , int pitch, bool dry, u16* sink, int w, int lane, int lj, int g, bool silu_gate) {
#pragma unroll
    for (int mt = 0; mt < 4; ++mt) { const f32x4 tt = *(const LAS f32x4*)(tot + 16 * mt + 4 * g);
#pragma unroll
        for (int r = 0; r < 4; ++r) { LAS u16* gp = GT + (16 * mt + 4 * g + r) * 136 + 16 * w + lj; float gt = bf2f(*gp); if (silu_gate) gt = gt * sigm(gt); *gp = (u16)pk2(o[mt][r] * rsqrtf(tt[r] * (1.0f / 128.0f) + EPS) * gnv * gt, 0.f); } }
    asm volatile("s_waitcnt lgkmcnt(0)" ::: "memory");
#pragma unroll
    for (int q = 0; q < 2; ++q) { const int p = lane + 64 * q, row = p >> 1, hf = p & 1; const u32x4 v = *(const LAS u32x4*)(GT + row * 136 + 16 * w + 8 * hf);
        *(u32x4*)(dry ? sink : gdst + (size_t)row * pitch + 16 * w + 8 * hf) = v; }
}

DI void recur_gdn(LAS unsigned char* lds, const KArgs& a, int j, int b, int vh, bool dry) {
    int tid_ = threadIdx.x; asm volatile("" : "+v"(tid_));
    const int tid = tid_, lane = tid & 63, w = tid >> 6, lj = lane & 15, g = lane >> 4;
    unsigned char* ws = a.ws; u16* P = (u16*)(ws + WS_PROJ); u16* LT = (u16*)(ws + WS_LATE) + (size_t)(j & 1) * 4096 * LLD;
    LAS u16* QG = (LAS u16*)lds;
    LAS u16* WMs = QG + 64 * 136;
    LAS u16* KT = WMs + 64 * 136;
    LAS u16* UT = KT + 128 * 72;
    LAS u16* QKs = UT + 128 * 72;
    LAS float* gam = (LAS float*)(QKs + 64 * 72);
    LAS float* tot = gam + 192;
    LAS u16* GT = (LAS u16*)(tot + 128);
    const int hq = vh >> 1; const int chain = b * 16 + vh;
    float* ST = (float*)(ws + WS_STATE) + (size_t)chain * 16384;
    u16* sink = (u16*)(ws + WS_DUMMY) + 8 * tid;
    f32x4 S[8];
#pragma unroll
    for (int m = 0; m < 8; ++m) S[m] = (j == 0) ? (f32x4){0.f, 0.f, 0.f, 0.f} : *(const f32x4*)(ST + ((w * 8 + m) * 64 + lane) * 4);
    u32x4 R[11]; float Rg = 0.f;
    unsigned oA[2], oT[2], oS[2];
#pragma unroll
    for (int q = 0; q < 2; ++q) { const int pid = tid + 512 * q; oA[q] = (unsigned)((pid >> 4) * PLD + 8 * (pid & 15)) * 2u; const int x = pid >> 3, c = pid & 7; oT[q] = (unsigned)((x >> 1) * PLD + 64 * (x & 1) + 8 * c) * 2u;
        const int p = lane + 64 * q; oS[q] = (unsigned)((p >> 1) * LLD + 16 * w + 8 * (p & 1)) * 2u; }
    auto load_chunk = [&](int nl) {
        const int lr0 = b * 1024 + 64 * nl; const size_t cv = (size_t)((b * 16 + nl) * 16 + vh);
        const char* wm = (const char*)(ws + WS_WM) + cv * 16384; const char* qk = (const char*)(ws + WS_QK) + cv * 8192;
        const char* pq = (const char*)(P + (size_t)lr0 * PLD + C_GQ + 128 * hq); const char* pk = (const char*)(P + (size_t)lr0 * PLD + C_GK + 128 * hq);
        const char* pv = (const char*)(P + (size_t)lr0 * PLD + C_GV + 128 * vh); const char* pg = (const char*)(LT + (size_t)lr0 * LLD + L_GZ + 128 * vh);
#pragma unroll
        for (int q = 0; q < 2; ++q) { R[q] = *(const u32x4*)(pq + oA[q]); R[2 + q] = *(const u32x4*)(wm + (unsigned)(tid + 512 * q) * 16u); R[4 + q] = *(const u32x4*)(pk + oT[q]); R[6 + q] = *(const u32x4*)(pv + oT[q]); R[9 + q] = *(const u32x4*)(pg + oS[q]); }
        R[8] = *(const u32x4*)(qk + (unsigned)tid * 16u);
        if (tid < 64) Rg = ((const float*)(ws + WS_GAM))[cv * 64 + tid];
    };
    auto store_chunk = [&]() {
#pragma unroll
        for (int q = 0; q < 2; ++q) { const int pid = tid + 512 * q; st_perm(QG + (pid >> 4) * 136, pid & 15, R[q]); st_perm(WMs + (pid >> 4) * 136, pid & 15, R[2 + q]);
            st_perm(KT + (pid >> 3) * 72, pid & 7, R[4 + q]); *(LAS u32x4*)(UT + (pid >> 3) * 72 + 8 * (pid & 7)) = R[6 + q]; }
        st_perm(QKs + (tid >> 3) * 72, tid & 7, R[8]);
#pragma unroll
        for (int q = 0; q < 2; ++q) { const int p = lane + 64 * q; *(LAS u32x4*)(GT + (p >> 1) * 136 + 16 * w + 8 * (p & 1)) = R[9 + q]; }
        if (tid < 64) { const float ge = __shfl(Rg, 63); gam[tid] = __expf(Rg); gam[64 + tid] = __expf(ge - Rg); if (tid == 63) gam[128] = __expf(ge); }
    };
    const float gnv = a.in[I_GON][16 * w + lj];
    load_chunk(0);
    if (tid < 128) tot[tid] = 0.f;
    store_chunk();
#pragma unroll 1
    for (int nl = 0; nl < 16; ++nl) {
        __syncthreads();
        if (nl + 1 < 16) load_chunk(nl + 1);
        f32x4 vn[4], o[4];
        bf16x8 Sb[4];
#pragma unroll
        for (int kk = 0; kk < 4; ++kk) Sb[kk] = packacc(S[2 * kk], S[2 * kk + 1]);
        bf16x8 fa[3][4];
#define SBAR __builtin_amdgcn_sched_barrier(0)
#define LD_A(bf, M, mt, st) do { _Pragma("unroll") for (int kk = 0; kk < 4; ++kk) fa[bf][kk] = fragN(M, 16 * (mt) + lj, 32 * kk, g, st); } while (0)
#define LD_B(bf, M, m0) do { _Pragma("unroll") for (int m2 = 0; m2 < 2; ++m2) _Pragma("unroll") for (int tk = 0; tk < 2; ++tk) fa[bf][2 * m2 + tk] = fragN(M, 16 * ((m0) + m2) + lj, 32 * tk, g, 72); } while (0)
#define MF_W(bf, mt) do { f32x4 c = (f32x4){0.f, 0.f, 0.f, 0.f}; _Pragma("unroll") for (int kk = 0; kk < 4; ++kk) c = MFMA16(fa[bf][kk], Sb[kk], c); vn[mt] = c; } while (0)
#define MF_Q(bf, mt) do { f32x4 c2 = (f32x4){0.f, 0.f, 0.f, 0.f}; _Pragma("unroll") for (int kk = 0; kk < 4; ++kk) c2 = MFMA16(fa[bf][kk], Sb[kk], c2); \
            o[mt] = c2; } while (0)
#define MF_QK(bf, m0) do { _Pragma("unroll") for (int m2 = 0; m2 < 2; ++m2) { f32x4 c = (f32x4){0.f, 0.f, 0.f, 0.f}; _Pragma("unroll") for (int tk = 0; tk < 2; ++tk) c = MFMA16(fa[bf][2 * m2 + tk], vb[tk], c); dq[(m0) + m2] = c; } } while (0)
#define MF_KT(bf, m0) do { _Pragma("unroll") for (int m2 = 0; m2 < 2; ++m2) { f32x4 c = S[(m0) + m2] * eG; _Pragma("unroll") for (int tk = 0; tk < 2; ++tk) c = MFMA16(fa[bf][2 * m2 + tk], vsb[tk], c); S[(m0) + m2] = c; } } while (0)
        LD_A(0, WMs, 0, 136); LD_A(1, QG, 0, 136); SBAR;
        LD_A(2, WMs, 1, 136); SBAR; MF_W(0, 0); SBAR;
        LD_A(0, QG, 1, 136); SBAR; MF_Q(1, 0); SBAR;
        LD_A(1, WMs, 2, 136); SBAR; MF_W(2, 1); SBAR;
        LD_A(2, QG, 2, 136); SBAR; MF_Q(0, 1); SBAR;
        LD_A(0, WMs, 3, 136); SBAR; MF_W(1, 2); SBAR;
        LD_A(1, QG, 3, 136); SBAR; MF_Q(2, 2); SBAR;
        LD_B(2, QKs, 0); SBAR; MF_W(0, 3); SBAR;
        LD_B(0, QKs, 2); SBAR; MF_Q(1, 3); SBAR;
        bf16x8 vb[2], vsb[2]; f32x4 dq[4]; float eG;
        { u32x2 uw[4]; f32x4 es[4];
#pragma unroll
            for (int mt = 0; mt < 4; ++mt) { uw[mt] = *(const LAS u32x2*)(UT + (16 * w + lj) * 72 + 16 * mt + 4 * g); es[mt] = *(const LAS f32x4*)(gam + 64 + 16 * mt + 4 * g); }
            eG = gam[128];
            SBAR;
#pragma unroll
            for (int mt = 0; mt < 4; ++mt) { vn[mt][0] = bf2f(uw[mt].x & 0xffffu) - vn[mt][0]; vn[mt][1] = bf2f(uw[mt].x >> 16) - vn[mt][1]; vn[mt][2] = bf2f(uw[mt].y & 0xffffu) - vn[mt][2]; vn[mt][3] = bf2f(uw[mt].y >> 16) - vn[mt][3]; }
#pragma unroll
            for (int tk = 0; tk < 2; ++tk) { vb[tk] = packacc(vn[2 * tk], vn[2 * tk + 1]); vsb[tk] = packacc(vn[2 * tk] * es[2 * tk], vn[2 * tk + 1] * es[2 * tk + 1]); } }
        SBAR;
        LD_B(1, KT, 0); SBAR; MF_QK(2, 0); SBAR;
        LD_B(2, KT, 2); SBAR; MF_QK(0, 2); SBAR;
        LD_B(0, KT, 4); SBAR; MF_KT(1, 0); SBAR;
        LD_B(1, KT, 6); SBAR; MF_KT(2, 2); SBAR;
        MF_KT(0, 4); SBAR; MF_KT(1, 6); SBAR;
#undef LD_A
#undef LD_B
#undef MF_W
#undef MF_Q
#undef MF_QK
#undef MF_KT
#pragma unroll
        for (int mt = 0; mt < 4; ++mt) o[mt] = o[mt] * *(const LAS f32x4*)(gam + 16 * mt + 4 * g) + dq[mt];
        LAS float* tc = tot + 64 * (nl & 1);
        norm_accum(o, tc, lj, g);
        __syncthreads();
        norm_finish(o, tc, GT, gnv, LT + (size_t)(b * 1024 + 64 * nl) * LLD + L_GZ + 128 * vh, LLD, dry, sink, w, lane, lj, g, false);
        if (tid < 64) tot[64 * ((nl + 1) & 1) + tid] = 0.f;
        if (nl + 1 < 16) store_chunk();
    }
#pragma unroll
    for (int m = 0; m < 8; ++m) *(f32x4*)(ST + ((w * 8 + m) * 64 + lane) * 4) = S[m];
    __syncthreads();
}

DI void recur_hgrn(LAS unsigned char* lds, const KArgs& a, int j, int b, int hi_, bool dry) {
    int tid_ = threadIdx.x; asm volatile("" : "+v"(tid_));
    const int tid = tid_, lane = tid & 63, w = tid >> 6, lj = lane & 15, g = lane >> 4;
    unsigned char* ws = a.ws; u16* P = (u16*)(ws + WS_PROJ);
    LAS u16* QE = (LAS u16*)lds;
    LAS u16* KET = QE + 64 * 136;
    LAS u16* VT = KET + 128 * 72;
    LAS u16* SCs = VT + 128 * 72;
    LAS float* dec = (LAS float*)(SCs + 64 * 72);
    LAS float* tot = dec + 128;
    LAS u16* GT = (LAS u16*)(tot + 128);
    const int chain = 64 + b * 8 + hi_;
    float* ST = (float*)(ws + WS_STATE) + (size_t)chain * 16384;
    u16* sink = (u16*)(ws + WS_DUMMY) + 8 * tid;
    f32x4 S[8];
#pragma unroll
    for (int m = 0; m < 8; ++m) S[m] = (j == 0) ? (f32x4){0.f, 0.f, 0.f, 0.f} : *(const f32x4*)(ST + ((w * 8 + m) * 64 + lane) * 4);
    u32x4 R[9]; float Rd = 0.f;
    unsigned oA[2], oT[2], oS[2];
#pragma unroll
    for (int q = 0; q < 2; ++q) { const int pid = tid + 512 * q; oA[q] = (unsigned)((pid >> 4) * PLD + 8 * (pid & 15)) * 2u; const int x = pid >> 3, c = pid & 7; oT[q] = (unsigned)((x >> 1) * PLD + 64 * (x & 1) + 8 * c) * 2u;
        const int p = lane + 64 * q; oS[q] = (unsigned)((p >> 1) * PLD + 16 * w + 8 * (p & 1)) * 2u; }
    auto load_chunk = [&](int nl) {
        const int lr0 = b * 1024 + 64 * nl; const size_t item = (size_t)((b * 16 + nl) * 8 + hi_);
        const char* sc = (const char*)(ws + WS_SC) + item * 8192;
        const char* pq = (const char*)(P + (size_t)lr0 * PLD + C_HQ + 128 * hi_); const char* pk = (const char*)(P + (size_t)lr0 * PLD + C_HF + 128 * hi_);
        const char* pv = (const char*)(P + (size_t)lr0 * PLD + C_HI + 128 * hi_); const char* pg = (const char*)(P + (size_t)lr0 * PLD + C_HG + 128 * hi_);
#pragma unroll
        for (int q = 0; q < 2; ++q) { R[q] = *(const u32x4*)(pq + oA[q]); R[2 + q] = *(const u32x4*)(pk + oT[q]); R[4 + q] = *(const u32x4*)(pv + oT[q]); R[7 + q] = *(const u32x4*)(pg + oS[q]); }
        R[6] = *(const u32x4*)(sc + (unsigned)tid * 16u);
        if (tid < 128) Rd = ((const float*)(ws + WS_DEC))[item * 128 + tid];
    };
    auto store_chunk = [&]() {
#pragma unroll
        for (int q = 0; q < 2; ++q) { const int pid = tid + 512 * q; st_perm(QE + (pid >> 4) * 136, pid & 15, R[q]);
            *(LAS u32x4*)(KET + (pid >> 3) * 72 + 8 * (pid & 7)) = R[2 + q]; *(LAS u32x4*)(VT + (pid >> 3) * 72 + 8 * (pid & 7)) = R[4 + q]; }
        *(LAS u32x4*)(SCs + (tid >> 3) * 72 + 8 * (tid & 7)) = R[6];
#pragma unroll
        for (int q = 0; q < 2; ++q) { const int p = lane + 64 * q; *(LAS u32x4*)(GT + (p >> 1) * 136 + 16 * w + 8 * (p & 1)) = R[7 + q]; }
        if (tid < 128) dec[tid] = Rd;
    };
    const float gnv = a.in[I_HON][16 * w + lj];
    load_chunk(0);
    if (tid < 128) tot[tid] = 0.f;
    store_chunk();
#pragma unroll 1
    for (int nl = 0; nl < 16; ++nl) {
        __syncthreads();
        if (nl + 1 < 16) load_chunk(nl + 1);
        bf16x8 Sb[4];
#pragma unroll
        for (int kk = 0; kk < 4; ++kk) Sb[kk] = packacc(S[2 * kk], S[2 * kk + 1]);
        bf16x8 Vb[2];
#pragma unroll
        for (int tk = 0; tk < 2; ++tk) Vb[tk] = fragN(VT, 16 * w + lj, 32 * tk, g, 72);
        f32x4 o[4];
        bf16x8 fa[2][8];
#define LD_QS(bf, mt) do { _Pragma("unroll") for (int kk = 0; kk < 4; ++kk) fa[bf][kk] = fragN(QE, 16 * (mt) + lj, 32 * kk, g, 136); \
            _Pragma("unroll") for (int tk = 0; tk < 2; ++tk) fa[bf][4 + tk] = fragN(SCs, 16 * (mt) + lj, 32 * tk, g, 72); } while (0)
#define LD_KE(bf, m0) do { _Pragma("unroll") for (int m2 = 0; m2 < 4; ++m2) _Pragma("unroll") for (int tk = 0; tk < 2; ++tk) fa[bf][2 * m2 + tk] = fragN(KET, 16 * ((m0) + m2) + lj, 32 * tk, g, 72); } while (0)
#define MF_QS(bf, mt) do { f32x4 c = (f32x4){0.f, 0.f, 0.f, 0.f}; _Pragma("unroll") for (int kk = 0; kk < 4; ++kk) c = MFMA16(fa[bf][kk], Sb[kk], c); \
            _Pragma("unroll") for (int tk = 0; tk < 2; ++tk) c = MFMA16(fa[bf][4 + tk], Vb[tk], c); o[mt] = c; } while (0)
#define MF_KE(bf, m0) do { _Pragma("unroll") for (int m2 = 0; m2 < 4; ++m2) { f32x4 c = S[(m0) + m2] * *(const LAS f32x4*)(dec + 16 * ((m0) + m2) + 4 * g); \
            _Pragma("unroll") for (int tk = 0; tk < 2; ++tk) c = MFMA16(fa[bf][2 * m2 + tk], Vb[tk], c); S[(m0) + m2] = c; } } while (0)
        LD_QS(0, 0); SBAR;
        LD_QS(1, 1); SBAR; MF_QS(0, 0); SBAR;
        LD_QS(0, 2); SBAR; MF_QS(1, 1); SBAR;
        LD_QS(1, 3); SBAR; MF_QS(0, 2); SBAR;
        LD_KE(0, 0); SBAR; MF_QS(1, 3); SBAR;
        LD_KE(1, 4); SBAR; MF_KE(0, 0); SBAR;
        MF_KE(1, 4); SBAR;
#undef LD_QS
#undef LD_KE
#undef MF_QS
#undef MF_KE
        LAS float* tc = tot + 64 * (nl & 1);
        norm_accum(o, tc, lj, g);
        __syncthreads();
        norm_finish(o, tc, GT, gnv, P + (size_t)(b * 1024 + 64 * nl) * PLD + C_HG + 128 * hi_, PLD, dry, sink, w, lane, lj, g, true);
        if (tid < 64) tot[64 * ((nl + 1) & 1) + tid] = 0.f;
        if (nl + 1 < 16) store_chunk();
    }
#pragma unroll
    for (int m = 0; m < 8; ++m) *(f32x4*)(ST + ((w * 8 + m) * 64 + lane) * 4) = S[m];
    __syncthreads();
}

#ifdef ONLY
#define EN(k) (ONLY == (k))
#else
#define EN(k) 1
#endif
__global__ void __launch_bounds__(512, 2) mk_fwd(KArgs a) {
    extern __shared__ __attribute__((aligned(16))) unsigned char lds_raw[];
    LAS unsigned char* lds = (LAS unsigned char*)lds_raw;
    cg::grid_group grid = cg::this_grid();
    volatile LAS unsigned* bst = (volatile LAS unsigned*)(lds + LDS_BYTES - 64);
    if (threadIdx.x < 2) bst[threadIdx.x] = 0u;
    __syncthreads();
    const XcdBarrier xbar = xcd_barrier_post((unsigned*)(a.ws + WS_BAR), bst);
    int seam = 0;
#define GRID_BAR() do { if (seam == 0) grid.sync(); else xcd_barrier(xbar); ++seam; } while (0)
    const int G = gridDim.x, bx = blockIdx.x;
    unsigned char* ws = a.ws;
    float* ssb = (float*)(ws + WS_SS);
    u16* XN = (u16*)(ws + WS_XN);

#pragma unroll 1
    for (int ph = a.ph_lo; ph < a.ph_hi; ++ph) {
        const int ptype = ph == 0 ? 0 : (ph == 1 || ph == 20) ? 1 : (ph == 2 || ph == 19 || ph == 21) ? 2 : ph == 22 ? 7 : 3 + ((ph - 3) & 3);
        (void)ptype;
        {
        constexpr bool dry = false;
        int tid_ = threadIdx.x; asm volatile("" : "+v"(tid_));
        const int tid = tid_, lane = tid & 63, wave = tid >> 6;
        const int gw = bx * 8 + wave, ngw = G * 8;
        LAS float* scr = (LAS float*)(lds + wave * 16384);
        if (EN(0) && ph == 0) {
            convert_weight(a.in[I_F1WI], DM, 2 * DFF, (u16*)(ws + WS_WFI), DM, 0, 1, scr, gw, ngw, lane);
            convert_weight(a.in[I_F1WO], DFF, DM, (u16*)(ws + WS_WFO), DFF, 0, 0, scr, gw, ngw, lane);
            convert_weight(a.in[I_WIN], DM, INW, (u16*)(ws + WS_WIN), DM, 0, 2, scr, gw, ngw, lane);
            convert_weight(a.in[I_WBH], DM, DM, (u16*)(ws + WS_WB), 3072, 0, 0, scr, gw, ngw, lane);
            convert_weight(a.in[I_WBG], 2048, DM, (u16*)(ws + WS_WB), 3072, 1024, 0, scr, gw, ngw, lane);
            convert_weight(a.in[I_WOUT], DM, DM, (u16*)(ws + WS_WOUT), DM, 0, 0, scr, gw, ngw, lane);
            if (bx < 64) { const int idx = bx * 512 + tid; const int k = idx >> 5, c = idx & 31; ((u16*)(ws + WS_WAB))[c * 1024 + k] = (u16)f2bf(a.in[I_WIN][(size_t)k * INW + 8192 + c]); }
            for (int m = gw; m < T_TOK; m += ngw) {
                const f32x4* xr = (const f32x4*)(a.in[I_X] + (size_t)m * DM) + lane; const f32x4* gr = (const f32x4*)a.in[I_F1N] + lane; float s = 0.f;
                unsigned long long* o8 = (unsigned long long*)(XN + (size_t)m * DM) + lane;
#pragma unroll
                for (int q = 0; q < 4; ++q) { const f32x4 v = xr[64 * q], gg = gr[64 * q]; s += (v[0] * v[0] + v[1] * v[1]) + (v[2] * v[2] + v[3] * v[3]);
                    o8[64 * q] = (unsigned long long)pk2(v[0] * gg[0], v[1] * gg[1]) | ((unsigned long long)pk2(v[2] * gg[2], v[3] * gg[3]) << 32); }
                s = wave_sum(s);
                if (lane == 0) { ssb[m] = s; ssb[T_TOK + m] = 0.f; ssb[2 * T_TOK + m] = 0.f; ssb[3 * T_TOK + m] = 0.f; }
            }
        } else if (EN(1) && (ph == 1 || ph == 20)) {
            SchedStd S; S.A = (const char*)(ws + (ph == 1 ? WS_XN : WS_XN3)); S.B = (const char*)(ws + WS_WFI); S.lda = DM; S.ldb = DM; S.nt = 16; S.O.init(64, 22, G, bx);
            EpiSwiglu E; E.H = (u16*)(ws + WS_HID); E.ss = ssb + (ph == 1 ? 0 : 2 * T_TOK);
            pg8::gemm_phase(lds, S, E);
        } else if (EN(2) && (ph == 2 || ph == 19 || ph == 21)) {
            SchedStd S; EpiResid E;
            if (ph == 19) { S.A = (const char*)(ws + WS_XN); S.B = (const char*)(ws + WS_WOUT); S.lda = DM; S.ldb = DM; S.nt = 16;
                E.base = a.out; E.scale = 1.0f; E.xn = (u16*)(ws + WS_XN3); E.g = a.in[I_F2N]; E.ss_out = ssb + 2 * T_TOK; }
            else { S.A = (const char*)(ws + WS_HID); S.B = (const char*)(ws + WS_WFO); S.lda = DFF; S.ldb = DFF; S.nt = 44;
                E.base = ph == 2 ? a.in[I_X] : a.out; E.scale = 0.5f; E.xn = ph == 2 ? XN : nullptr; E.g = a.in[I_MIXN]; E.ss_out = ssb + (ph == 2 ? T_TOK : 3 * T_TOK); }
            E.out = a.out; E.dry = dry; E.dummy = (float*)(ws + WS_DUMMY); S.O.init(64, 4, G, bx);
            pg8::gemm_phase(lds, S, E);
        } else if (ph < 19) {
            const int j = (ph - 3) >> 2, sub = (ph - 3) & 3;
            if (EN(3) && sub == 0) {
                SchedG3 S; S.A = (const char*)XN; S.B = (const char*)(ws + WS_WIN); S.lda = DM; S.ldb = DM; S.nt = 16; S.j = j; S.pn0 = 0; S.perm = (j != 0); S.O.init(16, j == 0 ? 48 : 32, G, bx);
                EpiProj E; E.P = (u16*)(ws + WS_PROJ); E.L = (u16*)(ws + WS_LATE) + (size_t)(j & 1) * 4096 * LLD; E.ss = ssb + T_TOK; E.lbl = a.in[I_LBL]; E.halo = (u16*)(ws + WS_HALO); E.j = j; E.pn0 = 0; E.perm = (j != 0);
                pg8::gemm_phase(lds, S, E);
                if (j == 0) { for (int it = bx; it < 256; it += G) gab_item(lds, a, it * 64); }
            } else if (sub == 1) {
#pragma unroll 1
                for (int it = bx; it < 1024; it += G) {
                    if (EN(4) && it < 512) { if (!(dry && (a.probe & 0x4000))) prep_gdn(lds, a, j, it >> 7, (it >> 3) & 15, it & 7, dry); }
                    else if (EN(5) && it >= 512) { const int i2 = it - 512; if (!(dry && (a.probe & 0x8000))) prep_hgrn(lds, a, i2 >> 7, (i2 >> 3) & 15, i2 & 7, dry); }
                }
            } else if (sub == 2) {
                if (j < 3 && bx >= 96 && !dry) {
                    SchedG3 S; S.A = (const char*)XN; S.B = (const char*)(ws + WS_WIN); S.lda = DM; S.ldb = DM; S.nt = 16; S.j = j + 1; S.pn0 = 32; S.perm = 3; S.O.init(16, 16, G - 96, bx - 96);
                    EpiProj E; E.P = (u16*)(ws + WS_PROJ); E.L = (u16*)(ws + WS_LATE) + (size_t)((j + 1) & 1) * 4096 * LLD; E.ss = ssb + T_TOK; E.lbl = a.in[I_LBL]; E.halo = (u16*)(ws + WS_HALO); E.j = j + 1; E.pn0 = 32; E.perm = 3;
                    pg8::gemm_phase(lds, S, E);
                }
                if (j == 3 && bx >= 96 && !dry) {
                    const int gw2 = (bx - 96) * 8 + wave, ngw2 = (G - 96) * 8;
                    convert_weight(a.in[I_F2WI], DM, 2 * DFF, (u16*)(ws + WS_WFI), DM, 0, 1, scr, gw2, ngw2, lane);
                    convert_weight(a.in[I_F2WO], DFF, DM, (u16*)(ws + WS_WFO), DFF, 0, 0, scr, gw2, ngw2, lane);
                }
#pragma unroll 1
                for (int c = bx; c < 96; c += G) {
                    if (EN(6) && c < 64) { recur_gdn(lds, a, j, c >> 4, c & 15, false); }
                    else if (EN(7) && c >= 64) { recur_hgrn(lds, a, j, (c - 64) >> 3, (c - 64) & 7, false); }
                }
            } else if (EN(8)) {
                SchedG4 S; S.P = (const char*)(ws + WS_PROJ); S.L = (const char*)(ws + WS_LATE) + (size_t)(j & 1) * 4096 * LLD * 2; S.B = (const char*)(ws + WS_WB); S.lda = (bx % 3 == 0) ? PLD : LLD; S.ldb = 3072; S.c = bx;
                EpiG4 E; E.L = (const u16*)(ws + WS_LATE) + (size_t)(j & 1) * 4096 * LLD; E.Y = (u16*)(ws + WS_XN); E.TMP = (u16*)(ws + (j == 3 ? WS_WM : WS_WFI)); E.flags = (unsigned*)(ws + WS_BAR) + 3584; E.j = j;
                pg8::gemm_phase(lds, S, E);
            }
        } else {
            const float* ss4 = ssb + 3 * T_TOK;
            for (int m = gw; m < T_TOK; m += ngw) { f32x4* xr = (f32x4*)(a.out + (size_t)m * DM) + lane; const f32x4* gr = (const f32x4*)a.in[I_FINN] + lane;
                f32x4* xw = dry ? (f32x4*)(ws + WS_DUMMY) + lane : xr;
                const float rs = rsqrtf(ss4[m] * (1.0f / 1024.0f) + EPS);
#pragma unroll
                for (int q = 0; q < 4; ++q) xw[dry ? 0 : 64 * q] = xr[64 * q] * gr[64 * q] * rs; }
        }
        if (dry) GRID_BAR();
        }
        if (ph + 1 < a.ph_hi) GRID_BAR();
    }
}

#ifndef PROBE_MASK
#define PROBE_MASK 0
#endif
extern "C" void kernel_launch(void* const* d_in, const int* in_sizes, int n_in, void* d_out, int out_size, void* d_ws, size_t ws_size, hipStream_t stream) {
    static int grid = 0;
    if (grid == 0) {
        if (n_in != 19 || ws_size < WS_END) { fprintf(stderr, "kernel_launch: unexpected inputs (n_in %d, ws %zu)\n", n_in, ws_size); grid = -1; return; }
        int dev = 0, cus = 0, per_cu = 0;
        hipGetDevice(&dev); hipDeviceGetAttribute(&cus, hipDeviceAttributeMultiprocessorCount, dev);
        hipFuncSetAttribute((const void*)mk_fwd, hipFuncAttributeMaxDynamicSharedMemorySize, LDS_BYTES);
        hipOccupancyMaxActiveBlocksPerMultiprocessor(&per_cu, (const void*)mk_fwd, 512, LDS_BYTES);
        if (per_cu < 1) { fprintf(stderr, "kernel_launch: occupancy query says %d blocks per CU\n", per_cu); per_cu = 1; }
        if (per_cu > 1) per_cu = 1;
        grid = cus * per_cu;
    }
    if (grid < 0) return;
    if (hipMemsetAsync((char*)d_ws + WS_BAR, 0, BAR_BYTES, stream) != hipSuccess) { fprintf(stderr, "kernel_launch: memset failed\n"); return; }
    KArgs a{};
    for (int i = 0; i < 19; ++i) a.in[i] = (const float*)d_in[i];
    a.out = (float*)d_out; a.ws = (unsigned char*)d_ws; a.ph_lo = 0; a.ph_hi = 23; a.probe = PROBE_MASK;
    void* args[] = {&a};
    hipError_t e = hipLaunchCooperativeKernel((const void*)mk_fwd, dim3(grid), dim3(512), args, LDS_BYTES, stream);
    if (e != hipSuccess) fprintf(stderr, "cooperative launch failed: %s (grid %d)\n", hipGetErrorString(e), grid);
}
```

```cpp
#define PROBE_MASK 0x0
#include <hip/hip_runtime.h>
#include <hip/hip_cooperative_groups.h>
#include <cstdio>
namespace cg = cooperative_groups;

#define DI __device__ __forceinline__
#define LAS __attribute__((address_space(3)))
typedef unsigned short u16;
typedef short bf16x8 __attribute__((ext_vector_type(8)));
typedef float f32x4 __attribute__((ext_vector_type(4)));
typedef unsigned u32x4 __attribute__((ext_vector_type(4)));
typedef unsigned u32x2 __attribute__((ext_vector_type(2)));

constexpr int T_TOK = 16384, DM = 1024, DFF = 2816, INW = 12320;
constexpr int PLD = 8192;
constexpr int LLD = 4096;
constexpr int L_GZ = 0, L_GH = 2048, L_GG = 3072;
constexpr int C_HQ = 0, C_HF = 1024, C_HI = 2048, C_HG = 3072, C_GQ = 4096, C_GK = 5120, C_GV = 6144;
constexpr float EPS = 1e-6f;
constexpr size_t MiB = 1u << 20;
constexpr size_t WS_BAR = 512 * 1024, BAR_BYTES = 16384;
constexpr size_t WS_WAB = 256 * 1024;
constexpr size_t WS_SS = 0;
constexpr size_t WS_WIN = 1 * MiB, WS_WB = 25 * MiB, WS_WOUT = 31 * MiB;
constexpr size_t WS_WFI = 33 * MiB, WS_WFO = 44 * MiB;
constexpr size_t WS_XN = 50 * MiB;
constexpr size_t WS_XN3 = 82 * MiB;
constexpr size_t WS_SC = 82 * MiB, WS_WM = 86 * MiB, WS_QK = 102 * MiB, WS_HALO = 110 * MiB;
constexpr size_t WS_HID = 114 * MiB, WS_PROJ = 114 * MiB, WS_LATE = 178 * MiB;
constexpr size_t WS_STATE = 242 * MiB, WS_GAM = 248 * MiB, WS_DEC = 248 * MiB + 512 * 1024;
constexpr size_t WS_DUMMY = 248 * MiB + 768 * 1024;
constexpr size_t WS_GBG = 249 * MiB, WS_GBB = 250 * MiB;
constexpr size_t WS_TMP = 251 * MiB;
constexpr size_t WS_END = 256 * MiB;
constexpr int LDS_BYTES = 159744;

DI unsigned f2bf(float f) { unsigned u = __float_as_uint(f); return (u + 0x7fffu + ((u >> 16) & 1u)) >> 16; }
typedef float f32x2_t __attribute__((ext_vector_type(2)));
typedef __bf16 bf16x2_t __attribute__((ext_vector_type(2)));
DI unsigned pk2(float lo, float hi) { const f32x2_t v = {lo, hi}; return __builtin_bit_cast(unsigned, __builtin_convertvector(v, bf16x2_t)); }
DI float bf2f(unsigned b) { return __uint_as_float(b << 16); }
DI void unpack8(u32x4 w, float (&f)[8]) {
    f[0] = __uint_as_float(w.x << 16); f[1] = __uint_as_float(w.x & 0xffff0000u); f[2] = __uint_as_float(w.y << 16); f[3] = __uint_as_float(w.y & 0xffff0000u);
    f[4] = __uint_as_float(w.z << 16); f[5] = __uint_as_float(w.z & 0xffff0000u); f[6] = __uint_as_float(w.w << 16); f[7] = __uint_as_float(w.w & 0xffff0000u);
}
DI u32x4 pack8(const float (&f)[8]) { u32x4 w; w.x = pk2(f[0], f[1]); w.y = pk2(f[2], f[3]); w.z = pk2(f[4], f[5]); w.w = pk2(f[6], f[7]); return w; }
DI float wave_sum(float v) {
#pragma unroll
    for (int o = 1; o < 64; o <<= 1) v += __shfl_xor(v, o);
    return v;
}
#define DPP_ROR(x, n) __builtin_bit_cast(float, __builtin_amdgcn_update_dpp(0, __builtin_bit_cast(int, (x)), 0x120 + (n), 0xf, 0xf, false))
DI float row16_sum(float x) { x += DPP_ROR(x, 8); x += DPP_ROR(x, 4); x += DPP_ROR(x, 2); x += DPP_ROR(x, 1); return x; }
DI float sigm(float x) { return __builtin_amdgcn_rcpf(1.0f + __expf(-x)); }
DI unsigned cvt_pk_bf16(float lo, float hi) { unsigned r; asm volatile("v_cvt_pk_bf16_f32 %0, %1, %2" : "=v"(r) : "v"(lo), "v"(hi)); return r; }
DI unsigned short f2h(float f) { _Float16 h = (_Float16)f; return __builtin_bit_cast(unsigned short, h); }
DI float h2f(unsigned short b) { return (float)__builtin_bit_cast(_Float16, b); }
DI void st_perm(LAS u16* row, int c, u32x4 v) { const int cc = c & 3; LAS u16* p = row + ((8 * c) & ~31) + 16 * (cc & 1) + 4 * (cc >> 1);
    u32x2 lo, hi; lo.x = v.x; lo.y = v.y; hi.x = v.z; hi.y = v.w; *(LAS u32x2*)p = lo; *(LAS u32x2*)(p + 8) = hi; }
DI size_t widx(bool dry, int tid, size_t idx) { return dry ? (size_t)tid * 8 : idx; }
DI bf16x8 mk8(u32x2 lo, u32x2 hi) { u32x4 w; w.x = lo.x; w.y = lo.y; w.z = hi.x; w.w = hi.y; return __builtin_bit_cast(bf16x8, w); }
DI bf16x8 packacc(f32x4 a, f32x4 b) { u32x4 w; w.x = pk2(a[0], a[1]); w.y = pk2(a[2], a[3]); w.z = pk2(b[0], b[1]); w.w = pk2(b[2], b[3]); return __builtin_bit_cast(bf16x8, w); }
#define MFMA16(a, b, c) __builtin_amdgcn_mfma_f32_16x16x32_bf16((a), (b), (c), 0, 0, 0)
DI bf16x8 fragN(const LAS u16* M, int row, int k0, int g, int stride) { return *(const LAS bf16x8*)(M + row * stride + k0 + 8 * g); }
DI bf16x8 fragP(const LAS u16* M, int row, int k0, int g, int stride) {
    const LAS u16* p = M + row * stride + k0 + 4 * g;
    return mk8(*(const LAS u32x2*)p, *(const LAS u32x2*)(p + 16));
}

#define XB_TMO      128
#define XB_XCNT(j)  (256  + 64 * (j))
#define XB_XSUB(j)  (1280 + 64 * (j))
#define XB_XGEN(j)  (2304 + 64 * (j))
#define XB_TOP      3328
#define XB_TOPGEN   3392
#define XCD_BAR_WORDS 3456
#define XB_SPIN_CAP (1u << 18)

__device__ __forceinline__ unsigned xb_ld(unsigned* p)              { return __hip_atomic_load(p, __ATOMIC_RELAXED, __HIP_MEMORY_SCOPE_AGENT); }
__device__ __forceinline__ unsigned xb_add(unsigned* p, unsigned v) { return __hip_atomic_fetch_add(p, v, __ATOMIC_RELAXED, __HIP_MEMORY_SCOPE_AGENT); }
__device__ __forceinline__ unsigned xb_xcc_id() { return (unsigned)__builtin_amdgcn_s_getreg((3 << 11) | 20) & 0xFu; }
#define XB_SPIN(cond, bar) do { unsigned _sp = 0; while (cond) { __builtin_amdgcn_s_sleep(1); \
    if ((++_sp & 255u) == 0u) { if (xb_ld(&(bar)[XB_TMO])) break; if (_sp > XB_SPIN_CAP) { atomicAdd(&(bar)[XB_TMO], 1u); break; } } } } while (0)

struct XcdBarrier {
    unsigned* bar; unsigned x;
    volatile LAS unsigned* st;
};

__device__ __forceinline__ XcdBarrier xcd_barrier_post(unsigned* bar, volatile LAS unsigned* st) {
    XcdBarrier b; b.bar = bar; b.x = xb_xcc_id(); b.st = st;
    if (threadIdx.x == 0) (void)xb_add(&bar[XB_XCNT(b.x)], 1u);
    return b;
}
__device__ __forceinline__ void xcd_barrier_complete(unsigned* bar, unsigned x, unsigned& nloc, unsigned& nx) {
    const unsigned G = gridDim.x * gridDim.y * gridDim.z;
    unsigned sum, cnt, mine, sp = 0u;
    for (;;) {
        sum = 0u; cnt = 0u; mine = 0u;
#pragma unroll
        for (unsigned j = 0; j < 16; ++j) { const unsigned c = xb_ld(&bar[XB_XCNT(j)]); sum += c; cnt += (c > 0u) ? 1u : 0u; mine = (j == x) ? c : mine; }
        if (sum == G) break;
        __builtin_amdgcn_s_sleep(1);
        if ((++sp & 255u) == 0u) { if (xb_ld(&bar[XB_TMO])) break; if (sp > XB_SPIN_CAP) { atomicAdd(&bar[XB_TMO], 1u); break; } }
    }
    nloc = mine > 0u ? mine : 1u; nx = cnt > 0u ? cnt : 1u;
}

__device__ __forceinline__ void xcd_barrier(const XcdBarrier& b) {
    asm volatile("s_waitcnt vmcnt(0)" ::: "memory");
    __syncthreads();
    if (threadIdx.x == 0) {
        unsigned* bar = b.bar;
        __builtin_amdgcn_s_waitcnt(0);
        unsigned nloc = b.st[0], nx = b.st[1];
        if (nloc == 0u) { xcd_barrier_complete(bar, b.x, nloc, nx); b.st[0] = nloc; b.st[1] = nx; }
        const unsigned old = xb_add(&bar[XB_XSUB(b.x)], 1u);
        const unsigned gen = old / nloc;
        if (old + 1u == (gen + 1u) * nloc) {
            __builtin_amdgcn_fence(__ATOMIC_RELEASE, "agent");
            asm volatile("s_waitcnt vmcnt(0)" ::: "memory");
            const unsigned og = xb_add(&bar[XB_TOP], 1u);
            const unsigned tg = og / nx;
            if (og + 1u == (tg + 1u) * nx) xb_add(&bar[XB_TOPGEN], 1u);
            else XB_SPIN(xb_ld(&bar[XB_TOPGEN]) == tg, bar);
            __builtin_amdgcn_fence(__ATOMIC_ACQUIRE, "agent");
            xb_add(&bar[XB_XGEN(b.x)], 1u);
            asm volatile("s_waitcnt vmcnt(0)" ::: "memory");
        } else {
            XB_SPIN(xb_ld(&bar[XB_XGEN(b.x)]) == gen, bar);
            __builtin_amdgcn_fence(__ATOMIC_ACQUIRE, "agent");
            asm volatile("s_waitcnt vmcnt(0)" ::: "memory");
        }
    }
    __syncthreads();
}


namespace pg8 {
constexpr int BM = 256, BK = 64, HALF = 128, HTB = HALF * BK * 2, NXCD = 8, WGM = 8;
DI int lds_byte(int r, int c) { const int st = (r >> 4) * 2 + (c >> 5), rr = r & 15, cc = c & 31, ob = rr * 64 + cc * 2; return st * 1024 + (ob ^ (((ob >> 9) & 1) << 5)); }
DI void stage_rc(int b, int& R, int& C) { const int st = b / 1024, sb = b % 1024, swz = sb ^ (((sb >> 9) & 1) << 5); R = (st >> 1) * 16 + swz / 64; C = (st & 1) * 32 + (swz % 64) / 2; }
DI int perm32(int rho) { const int n = rho >> 4, i = rho & 15; return 8 * (i >> 2) + 4 * n + (i & 3); }
struct Unit { int pm, pn, part; };
struct Order {
    int nM, nN, nwg, G, c;
    DI void init(int nM_, int nN_, int G_, int c_) { nM = nM_; nN = nN_; nwg = nM * nN; G = G_; c = c_; }
    DI bool next(int i, Unit& u) const {
        const long L = (long)i * G + c; if (L >= nwg) return false;
        int wgid = (int)L; { const int q = nwg / NXCD, r = nwg % NXCD, xcd = wgid % NXCD, off = wgid / NXCD; wgid = (xcd < r ? xcd * (q + 1) : r * (q + 1) + (xcd - r) * q) + off; }
        const int nig = WGM * nN, gid = wgid / nig, fm = gid * WGM, gsz = (nM - fm) < WGM ? (nM - fm) : WGM;
        u.pm = fm + ((wgid % nig) % gsz); u.pn = (wgid % nig) / gsz; u.part = 0; return true;
    }
};

template <class Epi, class Sched>
DI void gemm_phase(LAS unsigned char* lds, const Sched& S, const Epi& E) {
    int tid_ = threadIdx.x; asm volatile("" : "+v"(tid_));
    const int tid = tid_, wid = __builtin_amdgcn_readfirstlane(tid >> 6), lane = tid & 63, wr = wid >> 2, wc = wid & 3, fr = lane & 15, fq = lane >> 4;
    unsigned voffA[2], voffB[2];
#pragma unroll
    for (int i = 0; i < 2; ++i) { int R, C; stage_rc(tid * 16 + i * 8192, R, C); const int Rb = Epi::PERM ? ((R & ~31) + perm32(R & 31)) : R;
        voffA[i] = (unsigned)(R * S.lda + C) * 2u; voffB[i] = (unsigned)(Rb * S.ldb + C) * 2u; }
    const size_t kstep = (size_t)(BK * 2);
    const size_t hstepA = (size_t)HALF * S.lda * 2, hstepB = (size_t)HALF * S.ldb * 2;
    const unsigned ldsw = (unsigned)wid * 1024u;
    const int aoff = lds_byte(wr * 64 + fr, fq * 8), boff = lds_byte(wc * 32 + fr, fq * 8);
#define PG8_SA(b, h) (((b) * 2 + (h)) * HTB)
#define PG8_SB(b, h) ((4 + (b) * 2 + (h)) * HTB)
#define PG8_STAGE(bufoff, gbase, voff) do { _Pragma("unroll") for (int _i = 0; _i < 2; ++_i) \
        __builtin_amdgcn_global_load_lds((const unsigned*)((const char*)(gbase) + (voff)[_i]), (LAS unsigned*)(lds + (bufoff) + ldsw + _i * 8192), 16, 0, 0); } while (0)
#define PG8_LDA(dst, b, h) do { _Pragma("unroll") for (int m = 0; m < 4; ++m) _Pragma("unroll") for (int k = 0; k < 2; ++k) dst[m][k] = *(const LAS bf16x8*)(lds + PG8_SA(b, h) + aoff + m * 2048 + k * 1024); } while (0)
#define PG8_LDB(dst, b, h) do { _Pragma("unroll") for (int n = 0; n < 2; ++n) _Pragma("unroll") for (int k = 0; k < 2; ++k) dst[n][k] = *(const LAS bf16x8*)(lds + PG8_SB(b, h) + boff + n * 2048 + k * 1024); } while (0)
#define PG8_MMA(ai, bj, At, Bt) do { __builtin_amdgcn_s_setprio(1); _Pragma("unroll") for (int m = 0; m < 4; ++m) _Pragma("unroll") for (int n = 0; n < 2; ++n) _Pragma("unroll") for (int k = 0; k < 2; ++k) \
        acc[ai][bj][m][n] = __builtin_amdgcn_mfma_f32_16x16x32_bf16(Bt[n][k], At[m][k], acc[ai][bj][m][n], 0, 0, 0); __builtin_amdgcn_s_setprio(0); } while (0)
#define PG8_WAIT_V(n) asm volatile("s_waitcnt vmcnt(" #n ")" ::: "memory")
#define PG8_WAIT_L(n) asm volatile("s_waitcnt lgkmcnt(" #n ")" ::: "memory")
#define PG8_BAR __builtin_amdgcn_s_barrier()
#define PG8_SCHED __builtin_amdgcn_sched_barrier(0)
    Unit cur, nxt; int ui = 0;
    if (!S.next(0, cur)) return;
    f32x4 acc[2][2][4][2];
#pragma unroll
    for (int a = 0; a < 2; ++a)
#pragma unroll
        for (int b = 0; b < 2; ++b)
#pragma unroll
            for (int m = 0; m < 4; ++m)
#pragma unroll
                for (int n = 0; n < 2; ++n) acc[a][b][m][n] = (f32x4){0.f, 0.f, 0.f, 0.f};
    bf16x8 At[4][2], B0[2][2], B1[2][2];
    const char* cA; const char* cB; S.ptrs(cur, cA, cB);
    PG8_STAGE(PG8_SB(0, 0), cB, voffB); PG8_STAGE(PG8_SB(0, 1), cB + hstepB, voffB); PG8_STAGE(PG8_SA(0, 0), cA, voffA); PG8_STAGE(PG8_SA(0, 1), cA + hstepA, voffA);
    if (wr == 1) PG8_BAR;
    PG8_WAIT_V(2); PG8_BAR;
    PG8_STAGE(PG8_SB(1, 0), cB + kstep, voffB); PG8_STAGE(PG8_SA(1, 0), cA + kstep, voffA); PG8_STAGE(PG8_SB(1, 1), cB + hstepB + kstep, voffB);
    PG8_WAIT_V(6); PG8_BAR;
    for (;;) {
        const bool has_next = S.next(ui + 1, nxt); const int nt = S.ntu(cur);
        const char* nA = cA; const char* nB = cB; if (has_next) S.ptrs(nxt, nA, nB);
        for (int t = 0; t < nt; t += 2) {
            const bool last = (t == nt - 2);
            const char* a1 = cA + (size_t)(t + 1) * kstep;
            const char* a2 = last ? nA : cA + (size_t)(t + 2) * kstep; const char* b2 = last ? nB : cB + (size_t)(t + 2) * kstep;
            const char* a3 = a2 + kstep; const char* b3 = b2 + kstep;
            PG8_LDB(B0, 0, 0); PG8_LDB(B1, 0, 1); PG8_SCHED; PG8_LDA(At, 0, 0); PG8_STAGE(PG8_SA(1, 1), a1 + hstepA, voffA);
            PG8_WAIT_V(8); PG8_WAIT_L(0); PG8_BAR; PG8_MMA(0, 0, At, B0); PG8_MMA(0, 1, At, B1); PG8_BAR; PG8_SCHED;
            PG8_LDA(At, 0, 1); PG8_STAGE(PG8_SB(0, 0), b2, voffB); PG8_STAGE(PG8_SB(0, 1), b2 + hstepB, voffB); PG8_STAGE(PG8_SA(0, 0), a2, voffA);
            PG8_WAIT_V(8); PG8_WAIT_L(0); PG8_BAR; PG8_MMA(1, 0, At, B0); PG8_MMA(1, 1, At, B1); PG8_BAR; PG8_SCHED;
            PG8_LDB(B0, 1, 0); PG8_LDB(B1, 1, 1); PG8_SCHED; PG8_LDA(At, 1, 0); PG8_STAGE(PG8_SA(0, 1), a2 + hstepA, voffA);
            PG8_WAIT_V(8); PG8_WAIT_L(0); PG8_BAR; PG8_MMA(0, 0, At, B0); PG8_MMA(0, 1, At, B1); PG8_BAR; PG8_SCHED;
            PG8_LDA(At, 1, 1); PG8_STAGE(PG8_SB(1, 0), b3, voffB); PG8_STAGE(PG8_SB(1, 1), b3 + hstepB, voffB); PG8_STAGE(PG8_SA(1, 0), a3, voffA);
            PG8_WAIT_V(8); PG8_WAIT_L(0); PG8_BAR; PG8_MMA(1, 0, At, B0); PG8_MMA(1, 1, At, B1); PG8_BAR; PG8_SCHED;
        }
        if (wr == 0) PG8_BAR;
        { int fr2 = fr, fq2 = fq; asm volatile("" : "+v"(fr2), "+v"(fq2)); E(acc, cur, wr, wc, fr2, fq2); }
        if (!has_next) break;
#pragma unroll
        for (int a = 0; a < 2; ++a)
#pragma unroll
            for (int b = 0; b < 2; ++b)
#pragma unroll
                for (int m = 0; m < 4; ++m)
#pragma unroll
                    for (int n = 0; n < 2; ++n) acc[a][b][m][n] = (f32x4){0.f, 0.f, 0.f, 0.f};
        cur = nxt; cA = nA; cB = nB; ++ui;
        if (wr == 1) PG8_BAR;
    }
    PG8_WAIT_V(0);
    PG8_BAR;
#undef PG8_SA
#undef PG8_SB
#undef PG8_STAGE
#undef PG8_LDA
#undef PG8_LDB
#undef PG8_MMA
#undef PG8_WAIT_V
#undef PG8_WAIT_L
#undef PG8_BAR
#undef PG8_SCHED
}
}
using pg8::Unit;
typedef f32x4 Acc[2][2][4][2];

struct KArgs { const float* in[19]; float* out; unsigned char* ws; int ph_lo, ph_hi, probe, pad; };
enum { I_X = 0, I_F1N, I_F1WI, I_F1WO, I_MIXN, I_WIN, I_LBL, I_HON, I_CONVW, I_ALOG, I_DTB, I_GON, I_WBH, I_WBG, I_WOUT, I_F2N, I_F2WI, I_F2WO, I_FINN };

struct SchedStd {
    const char* A; const char* B; int lda, ldb, nt; pg8::Order O;
    DI bool next(int i, Unit& u) const { return O.next(i, u); }
    DI int ntu(const Unit&) const { return nt; }
    DI void ptrs(const Unit& u, const char*& a, const char*& b) const { a = A + (size_t)u.pm * 256 * lda * 2; b = B + (size_t)u.pn * 256 * ldb * 2; }
};
DI int g3_perm(int lp) {
    const int k = lp >> 3, t = lp & 7;
    if (t == 0 || t == 1 || t == 6) { const int i = 3 * k + (t == 6 ? 2 : t); return i < 8 ? i : i + 4; }
    const int i = 5 * k + (t == 7 ? 4 : t - 2); return i < 4 ? 8 + i : 12 + i;
}
DI int g3_late(int lp) { const int lt = lp - 32, k = lt >> 2, t = lt & 3; return t < 2 ? 32 + 2 * k + t : 40 + 2 * k + (t - 2); }
DI int g3_map(int perm, int lp) { return perm == 1 ? g3_perm(lp) : (perm == 3 ? g3_late(lp) : lp); }
struct SchedG3 {
    const char* A; const char* B; int lda, ldb, nt, j, pn0, perm; pg8::Order O;
    DI bool next(int i, Unit& u) const { return O.next(i, u); }
    DI int ntu(const Unit&) const { return nt; }
    DI void ptrs(const Unit& u, const char*& a, const char*& b) const {
        const size_t grow = (size_t)(u.pm >> 2) * 4096 + 1024 * j + (u.pm & 3) * 256;
        const int lp = pn0 + u.pn; a = A + grow * 1024 * 2; b = B + (size_t)g3_map(perm, lp) * 256 * 1024 * 2; }
};
struct SchedG4 {
    const char* P; const char* L; const char* B; int lda, ldb, c;
    DI bool next(int i, Unit& u) const { if (c >= 192 || i >= 1) return false; const int tile = c / 3; u.pm = tile >> 2; u.pn = tile & 3; u.part = c - 3 * tile; return true; }
    DI int ntu(const Unit&) const { return 16; }
    DI void ptrs(const Unit& u, const char*& a, const char*& b) const {
        a = u.part == 0 ? P + ((size_t)u.pm * 256 * PLD + C_HG) * 2 : L + ((size_t)u.pm * 256 * LLD + L_GZ + 1024 * (u.part - 1)) * 2;
        b = B + ((size_t)u.pn * 256 * 3072 + (size_t)u.part * 1024) * 2; }
};

struct EpiSwiglu {
    static constexpr bool PERM = true;
    u16* H; const float* ss;
    DI bool operator()(Acc& acc, const Unit& u, int wr, int wc, int fr, int fq) const {
        const int row0 = u.pm * 256 + wr * 64 + fr, hc0 = u.pn * 128 + wc * 32 + 8 * fq;
#pragma unroll
        for (int ai = 0; ai < 2; ++ai)
#pragma unroll
            for (int m = 0; m < 4; ++m) { const int row = row0 + ai * 128 + m * 16; const float rs = rsqrtf(ss[row] * (1.0f / 1024.0f) + EPS);
                float h[8];
#pragma unroll
                for (int n = 0; n < 2; ++n)
#pragma unroll
                    for (int e = 0; e < 4; ++e) { const float a = acc[ai][0][m][n][e] * rs, b = acc[ai][1][m][n][e] * rs; h[4 * n + e] = a * sigm(a) * b; }
                u32x4 w; w.x = cvt_pk_bf16(h[0], h[1]); w.y = cvt_pk_bf16(h[2], h[3]); w.z = cvt_pk_bf16(h[4], h[5]); w.w = cvt_pk_bf16(h[6], h[7]);
                *(u32x4*)(H + (size_t)row * DFF + hc0) = w; asm volatile("" ::: "memory"); }
        return true;
    }
};
struct EpiResid {
    static constexpr bool PERM = false;
    const float* base; float* out; float scale; u16* xn; const float* g; float* ss_out; bool dry; float* dummy;
    DI bool operator()(Acc& acc, const Unit& u, int wr, int wc, int fr, int fq) const {
        const int row0 = u.pm * 256 + wr * 64 + fr, col0 = u.pn * 256 + wc * 32 + 4 * fq;
#pragma unroll
        for (int ai = 0; ai < 2; ++ai)
#pragma unroll
            for (int m = 0; m < 4; ++m) { const int row = row0 + ai * 128 + m * 16; const size_t off = (size_t)row * DM + col0; float q = 0.f;
#pragma unroll
                for (int bj = 0; bj < 2; ++bj)
#pragma unroll
                    for (int n = 0; n < 2; ++n) { const int co = bj * 128 + n * 16; const f32x4 bs = *(const f32x4*)(base + off + co); const f32x4 o = bs + acc[ai][bj][m][n] * scale;
                        *(f32x4*)(dry ? dummy + 4 * (fr + 16 * fq) : out + off + co) = o; q += (o[0] * o[0] + o[1] * o[1]) + (o[2] * o[2] + o[3] * o[3]);
                        if (xn) { const f32x4 gv = *(const f32x4*)(g + col0 + co); u32x2 w; w.x = cvt_pk_bf16(o[0] * gv[0], o[1] * gv[1]); w.y = cvt_pk_bf16(o[2] * gv[2], o[3] * gv[3]); *(u32x2*)(dry ? (u16*)dummy + 4 * (fr + 16 * fq) : xn + off + co) = w; }
                        asm volatile("" ::: "memory"); }
                q += __shfl_xor(q, 16); q += __shfl_xor(q, 32);
                if (fq == 0 && !dry) atomicAdd(ss_out + row, q); asm volatile("" ::: "memory"); }
        return true;
    }
};
struct EpiProj {
    static constexpr bool PERM = true;
    u16* P; u16* L; const float* ss; const float* lbl; u16* halo; int j, pn0, perm;
    DI bool operator()(Acc& acc, const Unit& u, int wr, int wc, int fr, int fq) const {
        const int b = u.pm >> 2, tl0 = (u.pm & 3) * 256 + wr * 64 + fr;
        const int pn = g3_map(perm, pn0 + u.pn); const int kind = pn < 4 ? 0 : pn < 8 ? 1 : pn < 12 ? 2 : pn < 16 ? 3 : pn < 32 ? 4 : pn < 40 ? 5 : 6;
        float lb[2][8];
#pragma unroll
        for (int bj = 0; bj < 2; ++bj)
#pragma unroll
            for (int e = 0; e < 8; ++e) lb[bj][e] = 0.f;
        const float sc = kind == 0 ? 0.08838834764831845f : 1.0f;
#pragma unroll
        for (int ai = 0; ai < 2; ++ai)
#pragma unroll
            for (int m = 0; m < 4; ++m) { const int tl = tl0 + ai * 128 + m * 16; const int lr = b * 1024 + tl; const int gr = b * 4096 + 1024 * j + tl;
                const float rs = rsqrtf(ss[gr] * (1.0f / 1024.0f) + EPS);
#pragma unroll
                for (int bj = 0; bj < 2; ++bj) { const int col = pn * 256 + bj * 128 + wc * 32 + 8 * fq; float r[8];
#pragma unroll
                    for (int n = 0; n < 2; ++n)
#pragma unroll
                        for (int e = 0; e < 4; ++e) { const float v = acc[ai][bj][m][n][e] * rs; float o = v;
                            if (kind == 5) o = v * sigm(v);
                            r[4 * n + e] = o; }
                    u32x4 w;
                    if (kind == 1) { w.x = f2h(r[0]) | ((unsigned)f2h(r[1]) << 16); w.y = f2h(r[2]) | ((unsigned)f2h(r[3]) << 16); w.z = f2h(r[4]) | ((unsigned)f2h(r[5]) << 16); w.w = f2h(r[6]) | ((unsigned)f2h(r[7]) << 16); }
                    else { w.x = cvt_pk_bf16(r[0], r[1]); w.y = cvt_pk_bf16(r[2], r[3]); w.z = cvt_pk_bf16(r[4], r[5]); w.w = cvt_pk_bf16(r[6], r[7]); }
                    if (pn < 32) *(u32x4*)(P + (size_t)lr * PLD + col) = w; else *(u32x4*)(L + (size_t)lr * LLD + (col - 8192)) = w;
                    if (kind == 4 && (tl & 63) >= 61) { const int n_ch = (1024 * j + tl) >> 6; *(u32x4*)(halo + ((size_t)((b * 32 + (n_ch & 31)) * 3 + (tl & 63) - 61)) * 4096 + (col - C_GQ)) = w; } }
                asm volatile("" ::: "memory"); }
        return true;
    }
};
struct EpiG4 {
    static constexpr bool PERM = true;
    const u16* L; u16* Y; u16* TMP; unsigned* flags; int j;
    DI bool operator()(Acc& acc, const Unit& u, int wr, int wc, int fr, int fq) const {
        const int b = u.pm >> 2, tl0 = (u.pm & 3) * 256 + wr * 64 + fr, col0 = u.pn * 256 + wc * 32 + 8 * fq;
        unsigned* flag = flags + (j * 64 + u.pm * 4 + u.pn);
        int part = u.part; asm volatile("" : "+s"(part));
        if (part != 0) {
            u16* T = TMP + (size_t)(part - 1) * 4096 * DM;
#pragma unroll
            for (int ai = 0; ai < 2; ++ai)
#pragma unroll
                for (int m = 0; m < 4; ++m) { const int tl = tl0 + ai * 128 + m * 16; const int lr = b * 1024 + tl;
#pragma unroll
                    for (int bj = 0; bj < 2; ++bj) { const int col = col0 + bj * 128;
                        float gg[8]; unpack8(*(const u32x4*)(L + (size_t)lr * LLD + L_GG + col), gg); float y[8];
#pragma unroll
                        for (int e = 0; e < 8; ++e) gg[e] = sigm(gg[e]);
#pragma unroll
                        for (int n = 0; n < 2; ++n)
#pragma unroll
                            for (int e = 0; e < 4; ++e) y[4 * n + e] = acc[ai][bj][m][n][e] * gg[4 * n + e];
                        u32x4 w; w.x = cvt_pk_bf16(y[0], y[1]); w.y = cvt_pk_bf16(y[2], y[3]); w.z = cvt_pk_bf16(y[4], y[5]); w.w = cvt_pk_bf16(y[6], y[7]);
                        *(u32x4*)(T + (size_t)lr * DM + col) = w; }
                    asm volatile("" ::: "memory"); }
            asm volatile("s_waitcnt vmcnt(0)" ::: "memory");
            __syncthreads();
            if (threadIdx.x == 0) { __builtin_amdgcn_fence(__ATOMIC_RELEASE, "agent"); asm volatile("s_waitcnt vmcnt(0)" ::: "memory"); (void)__hip_atomic_fetch_add(flag, 1u, __ATOMIC_RELAXED, __HIP_MEMORY_SCOPE_AGENT); }
        } else {
#pragma unroll
            for (int ai = 0; ai < 2; ++ai)
#pragma unroll
                for (int m = 0; m < 4; ++m) { const int tl = tl0 + ai * 128 + m * 16; const int lr = b * 1024 + tl;
#pragma unroll
                    for (int bj = 0; bj < 2; ++bj) { const int col = col0 + bj * 128; float gh[8]; unpack8(*(const u32x4*)(L + (size_t)lr * LLD + L_GH + col), gh);
#pragma unroll
                        for (int n = 0; n < 2; ++n)
#pragma unroll
                            for (int e = 0; e < 4; ++e) acc[ai][bj][m][n][e] *= sigm(gh[4 * n + e]); }
                    asm volatile("" ::: "memory"); }
            if (threadIdx.x == 0) { unsigned sp = 0;
                while (__hip_atomic_load(flag, __ATOMIC_RELAXED, __HIP_MEMORY_SCOPE_AGENT) < 2u) { __builtin_amdgcn_s_sleep(2); if (++sp > (1u << 22)) break; }
                __builtin_amdgcn_fence(__ATOMIC_ACQUIRE, "agent"); asm volatile("s_waitcnt vmcnt(0)" ::: "memory"); }
            __syncthreads();
#pragma unroll
            for (int ai = 0; ai < 2; ++ai)
#pragma unroll
                for (int m = 0; m < 4; ++m) { const int tl = tl0 + ai * 128 + m * 16; const int lr = b * 1024 + tl; const int gr = b * 4096 + 1024 * j + tl;
#pragma unroll
                    for (int bj = 0; bj < 2; ++bj) { const int col = col0 + bj * 128;
                        float t1[8], t2[8];
                        unpack8(*(const u32x4*)(TMP + (size_t)lr * DM + col), t1); unpack8(*(const u32x4*)(TMP + (size_t)4096 * DM + (size_t)lr * DM + col), t2); float y[8];
#pragma unroll
                        for (int n = 0; n < 2; ++n)
#pragma unroll
                            for (int e = 0; e < 4; ++e) y[4 * n + e] = acc[ai][bj][m][n][e] + (t1[4 * n + e] + t2[4 * n + e]);
                        u32x4 w; w.x = cvt_pk_bf16(y[0], y[1]); w.y = cvt_pk_bf16(y[2], y[3]); w.z = cvt_pk_bf16(y[4], y[5]); w.w = cvt_pk_bf16(y[6], y[7]);
                        *(u32x4*)(Y + (size_t)gr * DM + col) = w; }
                    asm volatile("" ::: "memory"); }
        }
        return true;
    }
};

DI void transpose_item(const float* W, int N, u16* WT, int ldd, int koff, LAS float* scr, int kb, int nb, int lane, int mode) {
    const int k0 = 64 * kb, n0 = 32 * nb;
#pragma unroll 8
    for (int i = 0; i < 32; ++i) { const int kk = 2 * i + (lane >> 5); scr[kk * 33 + (lane & 31)] = W[(size_t)(k0 + kk) * N + n0 + (lane & 31)]; }
    asm volatile("s_waitcnt lgkmcnt(0)" ::: "memory");
    const int c = lane & 7;
#pragma unroll
    for (int jj = 0; jj < 4; ++jj) { const int n = (lane >> 3) + 8 * jj; const int cn = n0 + n; int dr = cn;
        if (mode == 1) { if (cn < DFF) dr = 256 * (cn >> 7) + (cn & 127); else { const int q = cn - DFF; dr = 256 * (q >> 7) + 128 + (q & 127); } }
        if (mode == 2) { if (cn >= 8224) dr = cn - 32; }
        const LAS float* s = scr + (8 * c) * 33 + n;
        u32x4 o; o.x = pk2(s[0 * 33], s[1 * 33]); o.y = pk2(s[2 * 33], s[3 * 33]); o.z = pk2(s[4 * 33], s[5 * 33]); o.w = pk2(s[6 * 33], s[7 * 33]);
        *(u32x4*)(WT + (size_t)dr * ldd + koff + k0 + 8 * c) = o; }
    asm volatile("s_waitcnt lgkmcnt(0)" ::: "memory");
}
DI void convert_weight(const float* W, int K, int N, u16* WT, int ldd, int koff, int mode, LAS float* scr, int gw, int ngw, int lane) {
    const int nblk = N / 32, nitems = (K / 64) * nblk;
    for (int it = gw; it < nitems; it += ngw) { const int kb = it / nblk, nb = it % nblk; if (mode == 2 && nb == 256) continue; transpose_item(W, N, WT, ldd, koff, scr, kb, nb, lane, mode); }
}

DI void gab_item(LAS unsigned char* lds, const KArgs& a, int gr0) {
    int tid_ = threadIdx.x; asm volatile("" : "+v"(tid_));
    const int tid = tid_, lane = tid & 63, wid = tid >> 6, lj = lane & 15, g = lane >> 4;
    unsigned char* ws = a.ws; const u16* XN = (const u16*)(ws + WS_XN); const u16* WAB = (const u16*)(ws + WS_WAB); const float* ss2 = (const float*)(ws + WS_SS) + T_TOK;
    LAS float* red = (LAS float*)lds;
    f32x4 acc[2][4];
#pragma unroll
    for (int nt = 0; nt < 2; ++nt)
#pragma unroll
        for (int mt = 0; mt < 4; ++mt) acc[nt][mt] = (f32x4){0.f, 0.f, 0.f, 0.f};
#pragma unroll
    for (int q = 0; q < 4; ++q) { const int kk = 4 * wid + q; bf16x8 bfr[2], afr[4];
#pragma unroll
        for (int nt = 0; nt < 2; ++nt) bfr[nt] = *(const bf16x8*)(WAB + (size_t)(16 * nt + lj) * 1024 + 32 * kk + 8 * g);
#pragma unroll
        for (int mt = 0; mt < 4; ++mt) afr[mt] = *(const bf16x8*)(XN + (size_t)(gr0 + 16 * mt + lj) * 1024 + 32 * kk + 8 * g);
#pragma unroll
        for (int nt = 0; nt < 2; ++nt)
#pragma unroll
            for (int mt = 0; mt < 4; ++mt) acc[nt][mt] = MFMA16(afr[mt], bfr[nt], acc[nt][mt]); }
#pragma unroll
    for (int nt = 0; nt < 2; ++nt)
#pragma unroll
        for (int mt = 0; mt < 4; ++mt)
#pragma unroll
            for (int r = 0; r < 4; ++r) red[(wid * 64 + 16 * mt + 4 * g + r) * 32 + 16 * nt + lj] = acc[nt][mt][r];
    __syncthreads();
#pragma unroll
    for (int q = 0; q < 4; ++q) { const int idx = tid + 512 * q, tok = idx >> 5, col = idx & 31; float sum = 0.f;
#pragma unroll
        for (int w2 = 0; w2 < 8; ++w2) sum += red[(w2 * 64 + tok) * 32 + col];
        sum *= rsqrtf(ss2[gr0 + tok] * (1.0f / 1024.0f) + EPS);
        if (col < 16) { const float xx = sum + a.in[I_DTB][col]; const float sp = xx > 20.f ? xx : log1pf(__expf(xx)); ((float*)(ws + WS_GBG))[(size_t)(gr0 + tok) * 16 + col] = -__expf(a.in[I_ALOG][col]) * sp; }
        else ((float*)(ws + WS_GBB))[(size_t)(gr0 + tok) * 16 + col - 16] = sigm(sum); }
    __syncthreads();
}
DI int swt(int v) { return ((v >> 3) ^ v) & 7; }
DI int swz(int v, int s) { return v * 64 + ((((s >> 3) ^ swt(v)) & 7) << 3) + (s & 7); }
DI void prep_gdn(LAS unsigned char* lds, const KArgs& a, int j, int b, int nl, int hq, bool dry) {
    int tid_ = threadIdx.x; asm volatile("" : "+v"(tid_));
    const int tid = tid_, lane = tid & 63, wid = tid >> 6, lj = lane & 15, g = lane >> 4;
    unsigned char* ws = a.ws;
    u16* P = (u16*)(ws + WS_PROJ); u16* Pw = dry ? (u16*)(ws + WS_DUMMY) : P; const u16* XN = (const u16*)(ws + WS_XN); const u16* halo = (const u16*)(ws + WS_HALO); const float* ss2 = (const float*)(ws + WS_SS) + T_TOK;
    const int n = 16 * j + nl, lr0 = b * 1024 + 64 * nl, gr0 = b * 4096 + 64 * n;
    LAS u16* QGs = (LAS u16*)lds;
    LAS u16* KGs = QGs + 64 * 136;
    LAS u16* VBT = KGs + 64 * 136;
    LAS u16* KBT = VBT + 2 * 128 * 64;
    LAS float* AM = (LAS float*)(KBT + 2 * 128 * 64);
    LAS u16* TM = (LAS u16*)(AM + 2 * 64 * 68);
    LAS float* gms = (LAS float*)(TM + 2 * 64 * 72);
    const bool sk1 = dry && (a.probe & 0x10000), sk2 = dry && (a.probe & 0x20000), sk3 = dry && (a.probe & 0x40000), sk4 = dry && (a.probe & 0x80000), sk5 = dry && (a.probe & 0x100000);
    const int mat = tid >> 7, tg = (tid >> 4) & 7, c8 = tid & 15, t0 = 8 * tg;
    const int cb = mat == 0 ? C_GQ + 128 * hq : (mat == 1 ? C_GK + 128 * hq : C_GV + 128 * (2 * hq + mat - 2));
    const int wcol = cb - C_GQ + 8 * c8;
    u32x4 raw[11];
#pragma unroll
    for (int rr = 0; rr < 11; ++rr) { const int tt = t0 - 3 + rr; raw[rr] = (u32x4){0u, 0u, 0u, 0u};
        if (tt >= 0) raw[rr] = *(const u32x4*)(P + (size_t)(lr0 + tt) * PLD + cb + 8 * c8);
        else if (n > 0) raw[rr] = *(const u32x4*)(halo + ((size_t)((b * 32 + ((n - 1) & 31)) * 3 + (3 + tt))) * 4096 + wcol); }
    float w[4][8];
#pragma unroll
    for (int jj = 0; jj < 4; ++jj) { const f32x4 w0 = *(const f32x4*)(a.in[I_CONVW] + jj * 4096 + wcol), w1 = *(const f32x4*)(a.in[I_CONVW] + jj * 4096 + wcol + 4);
#pragma unroll
        for (int e = 0; e < 4; ++e) { w[jj][e] = w0[e]; w[jj][4 + e] = w1[e]; } }
    if (tid < 128) { const int e = tid >> 6, tok = tid & 63;
        gms[e * 64 + tok] = ((const float*)(ws + WS_GBG))[(size_t)(gr0 + tok) * 16 + 2 * hq + e]; gms[128 + e * 64 + tok] = ((const float*)(ws + WS_GBB))[(size_t)(gr0 + tok) * 16 + 2 * hq + e]; }
    __syncthreads();
    if (wid < 2) { float v = gms[wid * 64 + lane];
#pragma unroll
        for (int o = 1; o < 64; o <<= 1) { const float t = __shfl_up(v, o); if (lane >= o) v += t; }
        gms[wid * 64 + lane] = v; }
    __syncthreads();
    if (!sk2) {
        float y[8][8];
#pragma unroll
        for (int i = 0; i < 8; ++i)
#pragma unroll
            for (int e = 0; e < 8; ++e) y[i][e] = 0.f;
#pragma unroll
        for (int rr = 0; rr < 11; ++rr) { float x[8]; unpack8(raw[rr], x);
#pragma unroll
            for (int jj = 0; jj < 4; ++jj) { const int i = rr - jj; if (i >= 0 && i < 8) {
#pragma unroll
                for (int e = 0; e < 8; ++e) y[i][e] += w[jj][e] * x[e]; } } }
#pragma unroll
        for (int i = 0; i < 8; ++i) {
#pragma unroll
            for (int e = 0; e < 8; ++e) y[i][e] = y[i][e] * sigm(y[i][e]);
            if (mat < 2) { float q = 0.f;
#pragma unroll
                for (int e = 0; e < 8; ++e) q += y[i][e] * y[i][e];
                q = row16_sum(q);
                const float sc = rsqrtf(q + EPS) * (mat == 0 ? 0.08838834764831845f : 1.0f);
#pragma unroll
                for (int e = 0; e < 8; ++e) y[i][e] *= sc;
                *(LAS u32x4*)((mat == 0 ? QGs : KGs) + (t0 + i) * 136 + 8 * c8) = pack8(y[i]); } }
        if (mat >= 1) {
#pragma unroll
            for (int ee = 0; ee < 2; ++ee) { if (mat == 1 || mat - 2 == ee) {
                float f[8];
#pragma unroll
                for (int i = 0; i < 8; ++i) f[i] = gms[128 + ee * 64 + t0 + i] * (mat == 1 ? __expf(gms[ee * 64 + t0 + i]) : 1.0f);
                LAS u16* dst = (mat == 1 ? KBT : VBT) + ee * 8192;
#pragma unroll
                for (int e = 0; e < 8; ++e) { const int v = 8 * c8 + e; float col[8];
#pragma unroll
                    for (int i = 0; i < 8; ++i) col[i] = y[i][e] * f[i];
                    *(LAS u32x4*)(dst + v * 64 + (((tg ^ swt(v)) & 7) << 3)) = pack8(col); } } }
        }
    }
    __syncthreads();
    const int cv0 = ((b * 16 + nl) * 16 + 2 * hq);
    u16* QKo = (u16*)(ws + WS_QK); u16* WMo = (u16*)(ws + WS_WM); float* GAMo = (float*)(ws + WS_GAM);
#pragma unroll
    for (int x = 0; x < 2; ++x) { if (sk3) break; const int tt = 2 * wid + x, mi = tt >> 2, ni = tt & 3;
        f32x4 kk = (f32x4){0.f, 0.f, 0.f, 0.f}, qk = (f32x4){0.f, 0.f, 0.f, 0.f};
#pragma unroll
        for (int ks = 0; ks < 4; ++ks) { const bf16x8 ka = fragN(KGs, 16 * mi + lj, 32 * ks, g, 136), kb2 = fragN(KGs, 16 * ni + lj, 32 * ks, g, 136), qb = fragN(QGs, 16 * ni + lj, 32 * ks, g, 136);
            kk = MFMA16(ka, kb2, kk); qk = MFMA16(ka, qb, qk); }
#pragma unroll
        for (int e = 0; e < 2; ++e) {
#pragma unroll
            for (int r = 0; r < 4; ++r) { const int t = 16 * mi + 4 * g + r, s = 16 * ni + lj;
                AM[e * 4352 + t * 68 + s] = (s < t) ? kk[r] * gms[128 + e * 64 + t] * __expf(gms[e * 64 + t] - gms[e * 64 + s]) : 0.f; }
            const int t = 16 * ni + lj; float o4[4];
#pragma unroll
            for (int r = 0; r < 4; ++r) { const int s = 16 * mi + 4 * g + r; o4[r] = (s <= t) ? qk[r] * __expf(gms[e * 64 + t] - gms[e * 64 + s]) : 0.f; }
            u32x2 w; w.x = pk2(o4[0], o4[1]); w.y = pk2(o4[2], o4[3]);
            *(LAS u32x2*)(TM + e * 4608 + t * 72 + 16 * mi + 4 * g) = w; } }
    __syncthreads();
#pragma unroll
    for (int q = 0; q < 2; ++q) { const int pid = tid + 512 * q, e = pid >> 9, row = (pid >> 3) & 63, c = pid & 7;
        *(u32x4*)(QKo + (size_t)(cv0 + e) * 4096 + row * 64 + 8 * c) = *(const LAS u32x4*)(TM + e * 4608 + row * 72 + 8 * c); }
    __syncthreads();
    if (wid < 2 && !sk4) { const LAS float* Ae = AM + wid * 4352; float Tc[64];
        f32x4 an[16], ac[16];
        Tc[0] = (lane == 0) ? 1.f : 0.f;
        an[0] = *(const LAS f32x4*)(Ae + 68);
#pragma unroll
        for (int i = 1; i < 64; ++i) {
#pragma unroll
            for (int q = 0; q < (i + 3) / 4; ++q) ac[q] = an[q];
            if (i + 1 < 64) {
#pragma unroll
                for (int q = 0; q < (i + 4) / 4; ++q) an[q] = *(const LAS f32x4*)(Ae + (i + 1) * 68 + 4 * q); }
            __builtin_amdgcn_sched_barrier(0);
            float s0 = (i == lane) ? 1.f : 0.f, s1 = 0.f;
#pragma unroll
            for (int jj = 0; jj < i; ++jj) { if (jj & 1) s1 -= ac[jj >> 2][jj & 3] * Tc[jj]; else s0 -= ac[jj >> 2][jj & 3] * Tc[jj]; }
            Tc[i] = s0 + s1;
            __builtin_amdgcn_sched_barrier(0);
        }
#pragma unroll
        for (int i = 0; i < 64; ++i) TM[wid * 4608 + i * 72 + lane] = (u16)f2bf(Tc[i]);
    } else if (wid >= 2) { const int t2 = tid - 128;
        for (int pid = t2; pid < 1024; pid += 384) { const int row = pid >> 4, c = pid & 15; *(u32x4*)(Pw + widx(dry, tid, (size_t)(lr0 + row) * PLD + C_GQ + 128 * hq + 8 * c)) = *(const LAS u32x4*)(QGs + row * 136 + 8 * c); }
        for (int pid = t2; pid < 1024; pid += 384) { const int k = pid >> 3, c = pid & 7; float v[8];
#pragma unroll
            for (int e = 0; e < 8; ++e) v[e] = bf2f(KGs[(8 * c + e) * 136 + k]);
            *(u32x4*)(Pw + widx(dry, tid, (size_t)(lr0 + (k >> 1)) * PLD + C_GK + 128 * hq + 64 * (k & 1) + 8 * c)) = pack8(v); }
        if (t2 < 128) GAMo[(size_t)(cv0 + (t2 >> 6)) * 64 + (t2 & 63)] = gms[t2];
    }
    __syncthreads();
    LAS u16* WMst = QGs;
    LAS u16* UTst = (LAS u16*)AM;
    if (!sk5) { const int e = wid >> 2, q = wid & 3; const LAS u16* Te = TM + e * 4608;
        bf16x8 ta[2];
#pragma unroll
        for (int ks = 0; ks < 2; ++ks) ta[ks] = fragN(Te, 16 * q + lj, 32 * ks, g, 72);
#pragma unroll
        for (int vt = 0; vt < 8; ++vt) { const int v = 16 * vt + lj; f32x4 c = (f32x4){0.f, 0.f, 0.f, 0.f};
#pragma unroll
            for (int ks = 0; ks < 2; ++ks) c = MFMA16(ta[ks], *(const LAS bf16x8*)(VBT + e * 8192 + v * 64 + ((((4 * ks + g) ^ swt(v)) & 7) << 3)), c);
            const int t = 16 * q + 4 * g; u32x2 w; w.x = pk2(c[0], c[1]); w.y = pk2(c[2], c[3]);
            *(LAS u32x2*)(UTst + e * 8192 + v * 64 + t) = w; }
        bf16x8 tb[4][2];
#pragma unroll
        for (int tt = 0; tt < 4; ++tt)
#pragma unroll
            for (int ks = 0; ks < 2; ++ks) tb[tt][ks] = fragN(Te, 16 * tt + lj, 32 * ks, g, 72);
#pragma unroll
        for (int k2 = 0; k2 < 2; ++k2) { const int kt = 2 * q + k2, k = 16 * kt + lj; bf16x8 ka[2];
#pragma unroll
            for (int ks = 0; ks < 2; ++ks) ka[ks] = *(const LAS bf16x8*)(KBT + e * 8192 + k * 64 + ((((4 * ks + g) ^ swt(k)) & 7) << 3));
#pragma unroll
            for (int tt = 0; tt < 4; ++tt) { f32x4 c = (f32x4){0.f, 0.f, 0.f, 0.f};
#pragma unroll
                for (int ks = 0; ks < 2; ++ks) c = MFMA16(ka[ks], tb[tt][ks], c);
                const int t = 16 * tt + lj, kk = 16 * kt + 4 * g; u32x2 w; w.x = pk2(c[0], c[1]); w.y = pk2(c[2], c[3]);
                *(LAS u32x2*)(WMst + e * 8704 + t * 136 + kk) = w; } }
    }
    __syncthreads();
#pragma unroll
    for (int q = 0; q < 4; ++q) { const int pid = tid + 512 * q, e = pid >> 10, r10 = pid & 1023;
        { const int v = r10 >> 3, c = r10 & 7; *(u32x4*)(Pw + widx(dry, tid, (size_t)(lr0 + (v >> 1)) * PLD + C_GV + 128 * (2 * hq + e) + 64 * (v & 1) + 8 * c)) = *(const LAS u32x4*)(UTst + e * 8192 + v * 64 + 8 * c); }
        { const int t = r10 >> 4, c = r10 & 15; *(u32x4*)(WMo + (size_t)(cv0 + e) * 8192 + t * 128 + 8 * c) = *(const LAS u32x4*)(WMst + e * 8704 + t * 136 + 8 * c); } }
    __syncthreads();
}

DI void prep_hgrn(LAS unsigned char* lds, const KArgs& a, int b, int nl, int hi_, bool dry) {
    int tid_ = threadIdx.x; asm volatile("" : "+v"(tid_));
    const int tid = tid_, lane = tid & 63, wid = tid >> 6, lj = lane & 15, g = lane >> 4;
    unsigned char* ws = a.ws; u16* P = (u16*)(ws + WS_PROJ); u16* Pw = dry ? (u16*)(ws + WS_DUMMY) : P;
    const int lr0 = b * 1024 + 64 * nl; const int item = (b * 16 + nl) * 8 + hi_;
    LAS float* segs = (LAS float*)lds;
    LAS u16* Qs = (LAS u16*)(segs + 512);
    LAS u16* Ks = Qs + 64 * 136;
    const int k = tid & 127, seg = tid >> 7;
    const float lbk = __builtin_amdgcn_rcpf(1.0f + __expf(a.in[I_LBL][1024 + 128 * hi_ + k] - a.in[I_LBL][128 * hi_ + k]));
    float q[16], lf[16], vv[16];
#pragma unroll
    for (int r = 0; r < 16; ++r) { const size_t ro = (size_t)(lr0 + 16 * seg + r) * PLD + 128 * hi_ + k;
        const float qv = bf2f(P[ro + C_HQ]), fv = h2f(P[ro + C_HF]); q[r] = qv * sigm(qv) * 0.08838834764831845f; lf[r] = __logf(lbk + (1.0f - lbk) * sigm(fv)); vv[r] = bf2f(P[ro + C_HI]); }
    float cs[16]; { float s = 0.f;
#pragma unroll
        for (int r = 0; r < 16; ++r) { s += lf[r]; cs[r] = s; } }
    segs[seg * 128 + k] = cs[15];
    __syncthreads();
    const float s0 = segs[k], s1 = segs[128 + k], s2 = segs[256 + k], s3 = segs[384 + k];
    const float pre = seg == 0 ? 0.f : (seg == 1 ? s0 : (seg == 2 ? s0 + s1 : s0 + s1 + s2));
    const float bmid = s0 + s1, bend = s0 + s1 + s2 + s3;
    float ke[16], qe[16];
#pragma unroll
    for (int r = 0; r < 16; ++r) { const float bb = pre + cs[r]; const float kh = -expm1f(lf[r]); const int t = 16 * seg + r;
        qe[r] = q[r] * __expf(bb); ke[r] = kh * __expf(bend - bb);
        Qs[t * 136 + k] = (u16)f2bf(q[r] * __expf(bb - bmid)); Ks[t * 136 + k] = (u16)f2bf(kh * __expf(bmid - bb)); }
#pragma unroll
    for (int r = 0; r < 16; ++r) Pw[widx(dry, tid, (size_t)(lr0 + 16 * seg + r) * PLD + C_HQ + 128 * hi_ + k)] = (u16)f2bf(qe[r]);
    { u16* kd = Pw + widx(dry, 2 * tid, (size_t)(lr0 + (k >> 1)) * PLD + C_HF + 128 * hi_ + 64 * (k & 1) + 16 * seg); u16* vd = Pw + widx(dry, 2 * tid, (size_t)(lr0 + (k >> 1)) * PLD + C_HI + 128 * hi_ + 64 * (k & 1) + 16 * seg);
        float t8[8];
#pragma unroll
        for (int h = 0; h < 2; ++h) {
#pragma unroll
            for (int e = 0; e < 8; ++e) t8[e] = ke[8 * h + e];
            *(u32x4*)(kd + 8 * h) = pack8(t8);
#pragma unroll
            for (int e = 0; e < 8; ++e) t8[e] = vv[8 * h + e];
            *(u32x4*)(vd + 8 * h) = pack8(t8); } }
    if (seg == 0) ((float*)(ws + WS_DEC))[(size_t)item * 128 + k] = __expf(bend);
    __syncthreads();
    u16* SCo = (u16*)(ws + WS_SC) + (size_t)item * 4096;
#pragma unroll 1
    for (int x = 0; x < 2; ++x) { const int tt = 2 * wid + x, mi = tt >> 2, ni = tt & 3; f32x4 c = (f32x4){0.f, 0.f, 0.f, 0.f};
        if (mi <= ni) {
#pragma unroll
            for (int ks = 0; ks < 4; ++ks) c = MFMA16(fragN(Ks, 16 * mi + lj, 32 * ks, g, 136), fragN(Qs, 16 * ni + lj, 32 * ks, g, 136), c); }
        const int t = 16 * ni + lj; float o4[4];
#pragma unroll
        for (int r = 0; r < 4; ++r) { const int s = 16 * mi + 4 * g + r; o4[r] = (s <= t) ? c[r] : 0.f; }
        u32x2 w; w.x = pk2(o4[0], o4[1]); w.y = pk2(o4[2], o4[3]);
        *(u32x2*)(SCo + t * 64 + 16 * mi + 4 * g) = w; }
    __syncthreads();
}

DI void norm_accum(const f32x4 (&o)[4], LAS float* tot, int lj, int g) {
#pragma unroll
    for (int mt = 0; mt < 4; ++mt) { f32x4 q = o[mt] * o[mt];
        q[0] = row16_sum(q[0]); q[1] = row16_sum(q[1]); q[2] = row16_sum(q[2]); q[3] = row16_sum(q[3]);
        if (lj == 0) {
#pragma unroll
            for (int r = 0; r < 4; ++r) (void)__hip_atomic_fetch_add(tot + 16 * mt + 4 * g + r, q[r], __ATOMIC_RELAXED, __HIP_MEMORY_SCOPE_WORKGROUP); } }
}
DI void norm_finish(const f32x4 (&o)[4], const LAS float* tot, LAS u16* GT, float gnv, u16* gdst  , int pitch, bool dry, u16* sink, int w, int lane, int lj, int g, bool silu_gate) {
#pragma unroll
    for (int mt = 0; mt < 4; ++mt) { const f32x4 tt = *(const LAS f32x4*)(tot + 16 * mt + 4 * g);
#pragma unroll
        for (int r = 0; r < 4; ++r) { LAS u16* gp = GT + (16 * mt + 4 * g + r) * 136 + 16 * w + lj; float gt = bf2f(*gp); if (silu_gate) gt = gt * sigm(gt); *gp = (u16)pk2(o[mt][r] * rsqrtf(tt[r] * (1.0f / 128.0f) + EPS) * gnv * gt, 0.f); } }
    asm volatile("s_waitcnt lgkmcnt(0)" ::: "memory");
#pragma unroll
    for (int q = 0; q < 2; ++q) { const int p = lane + 64 * q, row = p >> 1, hf = p & 1; const u32x4 v = *(const LAS u32x4*)(GT + row * 136 + 16 * w + 8 * hf);
        *(u32x4*)(dry ? sink : gdst + (size_t)row * pitch + 16 * w + 8 * hf) = v; }
}

DI void recur_gdn(LAS unsigned char* lds, const KArgs& a, int j, int b, int vh, bool dry) {
    int tid_ = threadIdx.x; asm volatile("" : "+v"(tid_));
    const int tid = tid_, lane = tid & 63, w = tid >> 6, lj = lane & 15, g = lane >> 4;
    unsigned char* ws = a.ws; u16* P = (u16*)(ws + WS_PROJ); u16* LT = (u16*)(ws + WS_LATE) + (size_t)(j & 1) * 4096 * LLD;
    LAS u16* QG = (LAS u16*)lds;
    LAS u16* WMs = QG + 64 * 136;
    LAS u16* KT = WMs + 64 * 136;
    LAS u16* UT = KT + 128 * 72;
    LAS u16* QKs = UT + 128 * 72;
    LAS float* gam = (LAS float*)(QKs + 64 * 72);
    LAS float* tot = gam + 192;
    LAS u16* GT = (LAS u16*)(tot + 128);
    const int hq = vh >> 1; const int chain = b * 16 + vh;
    float* ST = (float*)(ws + WS_STATE) + (size_t)chain * 16384;
    u16* sink = (u16*)(ws + WS_DUMMY) + 8 * tid;
    f32x4 S[8];
#pragma unroll
    for (int m = 0; m < 8; ++m) S[m] = (j == 0) ? (f32x4){0.f, 0.f, 0.f, 0.f} : *(const f32x4*)(ST + ((w * 8 + m) * 64 + lane) * 4);
    u32x4 R[11]; float Rg = 0.f;
    unsigned oA[2], oT[2], oS[2];
#pragma unroll
    for (int q = 0; q < 2; ++q) { const int pid = tid + 512 * q; oA[q] = (unsigned)((pid >> 4) * PLD + 8 * (pid & 15)) * 2u; const int x = pid >> 3, c = pid & 7; oT[q] = (unsigned)((x >> 1) * PLD + 64 * (x & 1) + 8 * c) * 2u;
        const int p = lane + 64 * q; oS[q] = (unsigned)((p >> 1) * LLD + 16 * w + 8 * (p & 1)) * 2u; }
    auto load_chunk = [&](int nl) {
        const int lr0 = b * 1024 + 64 * nl; const size_t cv = (size_t)((b * 16 + nl) * 16 + vh);
        const char* wm = (const char*)(ws + WS_WM) + cv * 16384; const char* qk = (const char*)(ws + WS_QK) + cv * 8192;
        const char* pq = (const char*)(P + (size_t)lr0 * PLD + C_GQ + 128 * hq); const char* pk = (const char*)(P + (size_t)lr0 * PLD + C_GK + 128 * hq);
        const char* pv = (const char*)(P + (size_t)lr0 * PLD + C_GV + 128 * vh); const char* pg = (const char*)(LT + (size_t)lr0 * LLD + L_GZ + 128 * vh);
#pragma unroll
        for (int q = 0; q < 2; ++q) { R[q] = *(const u32x4*)(pq + oA[q]); R[2 + q] = *(const u32x4*)(wm + (unsigned)(tid + 512 * q) * 16u); R[4 + q] = *(const u32x4*)(pk + oT[q]); R[6 + q] = *(const u32x4*)(pv + oT[q]); R[9 + q] = *(const u32x4*)(pg + oS[q]); }
        R[8] = *(const u32x4*)(qk + (unsigned)tid * 16u);
        if (tid < 64) Rg = ((const float*)(ws + WS_GAM))[cv * 64 + tid];
    };
    auto store_chunk = [&]() {
#pragma unroll
        for (int q = 0; q < 2; ++q) { const int pid = tid + 512 * q; st_perm(QG + (pid >> 4) * 136, pid & 15, R[q]); st_perm(WMs + (pid >> 4) * 136, pid & 15, R[2 + q]);
            st_perm(KT + (pid >> 3) * 72, pid & 7, R[4 + q]); *(LAS u32x4*)(UT + (pid >> 3) * 72 + 8 * (pid & 7)) = R[6 + q]; }
        st_perm(QKs + (tid >> 3) * 72, tid & 7, R[8]);
#pragma unroll
        for (int q = 0; q < 2; ++q) { const int p = lane + 64 * q; *(LAS u32x4*)(GT + (p >> 1) * 136 + 16 * w + 8 * (p & 1)) = R[9 + q]; }
        if (tid < 64) { const float ge = __shfl(Rg, 63); gam[tid] = __expf(Rg); gam[64 + tid] = __expf(ge - Rg); if (tid == 63) gam[128] = __expf(ge); }
    };
    const float gnv = a.in[I_GON][16 * w + lj];
    load_chunk(0);
    if (tid < 128) tot[tid] = 0.f;
    store_chunk();
#pragma unroll 1
    for (int nl = 0; nl < 16; ++nl) {
        __syncthreads();
        if (nl + 1 < 16) load_chunk(nl + 1);
        f32x4 vn[4], o[4];
        bf16x8 Sb[4];
#pragma unroll
        for (int kk = 0; kk < 4; ++kk) Sb[kk] = packacc(S[2 * kk], S[2 * kk + 1]);
        bf16x8 fa[3][4];
#define SBAR __builtin_amdgcn_sched_barrier(0)
#define LD_A(bf, M, mt, st) do { _Pragma("unroll") for (int kk = 0; kk < 4; ++kk) fa[bf][kk] = fragN(M, 16 * (mt) + lj, 32 * kk, g, st); } while (0)
#define LD_B(bf, M, m0) do { _Pragma("unroll") for (int m2 = 0; m2 < 2; ++m2) _Pragma("unroll") for (int tk = 0; tk < 2; ++tk) fa[bf][2 * m2 + tk] = fragN(M, 16 * ((m0) + m2) + lj, 32 * tk, g, 72); } while (0)
#define MF_W(bf, mt) do { f32x4 c = (f32x4){0.f, 0.f, 0.f, 0.f}; _Pragma("unroll") for (int kk = 0; kk < 4; ++kk) c = MFMA16(fa[bf][kk], Sb[kk], c); vn[mt] = c; } while (0)
#define MF_Q(bf, mt) do { f32x4 c2 = (f32x4){0.f, 0.f, 0.f, 0.f}; _Pragma("unroll") for (int kk = 0; kk < 4; ++kk) c2 = MFMA16(fa[bf][kk], Sb[kk], c2); \
            o[mt] = c2; } while (0)
#define MF_QK(bf, m0) do { _Pragma("unroll") for (int m2 = 0; m2 < 2; ++m2) { f32x4 c = (f32x4){0.f, 0.f, 0.f, 0.f}; _Pragma("unroll") for (int tk = 0; tk < 2; ++tk) c = MFMA16(fa[bf][2 * m2 + tk], vb[tk], c); dq[(m0) + m2] = c; } } while (0)
#define MF_KT(bf, m0) do { _Pragma("unroll") for (int m2 = 0; m2 < 2; ++m2) { f32x4 c = S[(m0) + m2] * eG; _Pragma("unroll") for (int tk = 0; tk < 2; ++tk) c = MFMA16(fa[bf][2 * m2 + tk], vsb[tk], c); S[(m0) + m2] = c; } } while (0)
        LD_A(0, WMs, 0, 136); LD_A(1, QG, 0, 136); SBAR;
        LD_A(2, WMs, 1, 136); SBAR; MF_W(0, 0); SBAR;
        LD_A(0, QG, 1, 136); SBAR; MF_Q(1, 0); SBAR;
        LD_A(1, WMs, 2, 136); SBAR; MF_W(2, 1); SBAR;
        LD_A(2, QG, 2, 136); SBAR; MF_Q(0, 1); SBAR;
        LD_A(0, WMs, 3, 136); SBAR; MF_W(1, 2); SBAR;
        LD_A(1, QG, 3, 136); SBAR; MF_Q(2, 2); SBAR;
        LD_B(2, QKs, 0); SBAR; MF_W(0, 3); SBAR;
        LD_B(0, QKs, 2); SBAR; MF_Q(1, 3); SBAR;
        bf16x8 vb[2], vsb[2]; f32x4 dq[4]; float eG;
        { u32x2 uw[4]; f32x4 es[4];
#pragma unroll
            for (int mt = 0; mt < 4; ++mt) { uw[mt] = *(const LAS u32x2*)(UT + (16 * w + lj) * 72 + 16 * mt + 4 * g); es[mt] = *(const LAS f32x4*)(gam + 64 + 16 * mt + 4 * g); }
            eG = gam[128];
            SBAR;
#pragma unroll
            for (int mt = 0; mt < 4; ++mt) { vn[mt][0] = bf2f(uw[mt].x & 0xffffu) - vn[mt][0]; vn[mt][1] = bf2f(uw[mt].x >> 16) - vn[mt][1]; vn[mt][2] = bf2f(uw[mt].y & 0xffffu) - vn[mt][2]; vn[mt][3] = bf2f(uw[mt].y >> 16) - vn[mt][3]; }
#pragma unroll
            for (int tk = 0; tk < 2; ++tk) { vb[tk] = packacc(vn[2 * tk], vn[2 * tk + 1]); vsb[tk] = packacc(vn[2 * tk] * es[2 * tk], vn[2 * tk + 1] * es[2 * tk + 1]); } }
        SBAR;
        LD_B(1, KT, 0); SBAR; MF_QK(2, 0); SBAR;
        LD_B(2, KT, 2); SBAR; MF_QK(0, 2); SBAR;
        LD_B(0, KT, 4); SBAR; MF_KT(1, 0); SBAR;
        LD_B(1, KT, 6); SBAR; MF_KT(2, 2); SBAR;
        MF_KT(0, 4); SBAR; MF_KT(1, 6); SBAR;
#undef LD_A
#undef LD_B
#undef MF_W
#undef MF_Q
#undef MF_QK
#undef MF_KT
#pragma unroll
        for (int mt = 0; mt < 4; ++mt) o[mt] = o[mt] * *(const LAS f32x4*)(gam + 16 * mt + 4 * g) + dq[mt];
        LAS float* tc = tot + 64 * (nl & 1);
        norm_accum(o, tc, lj, g);
        __syncthreads();
        norm_finish(o, tc, GT, gnv, LT + (size_t)(b * 1024 + 64 * nl) * LLD + L_GZ + 128 * vh, LLD, dry, sink, w, lane, lj, g, false);
        if (tid < 64) tot[64 * ((nl + 1) & 1) + tid] = 0.f;
        if (nl + 1 < 16) store_chunk();
    }
#pragma unroll
    for (int m = 0; m < 8; ++m) *(f32x4*)(ST + ((w * 8 + m) * 64 + lane) * 4) = S[m];
    __syncthreads();
}

DI void recur_hgrn(LAS unsigned char* lds, const KArgs& a, int j, int b, int hi_, bool dry) {
    int tid_ = threadIdx.x; asm volatile("" : "+v"(tid_));
    const int tid = tid_, lane = tid & 63, w = tid >> 6, lj = lane & 15, g = lane >> 4;
    unsigned char* ws = a.ws; u16* P = (u16*)(ws + WS_PROJ);
    LAS u16* QE = (LAS u16*)lds;
    LAS u16* KET = QE + 64 * 136;
    LAS u16* VT = KET + 128 * 72;
    LAS u16* SCs = VT + 128 * 72;
    LAS float* dec = (LAS float*)(SCs + 64 * 72);
    LAS float* tot = dec + 128;
    LAS u16* GT = (LAS u16*)(tot + 128);
    const int chain = 64 + b * 8 + hi_;
    float* ST = (float*)(ws + WS_STATE) + (size_t)chain * 16384;
    u16* sink = (u16*)(ws + WS_DUMMY) + 8 * tid;
    f32x4 S[8];
#pragma unroll
    for (int m = 0; m < 8; ++m) S[m] = (j == 0) ? (f32x4){0.f, 0.f, 0.f, 0.f} : *(const f32x4*)(ST + ((w * 8 + m) * 64 + lane) * 4);
    u32x4 R[9]; float Rd = 0.f;
    unsigned oA[2], oT[2], oS[2];
#pragma unroll
    for (int q = 0; q < 2; ++q) { const int pid = tid + 512 * q; oA[q] = (unsigned)((pid >> 4) * PLD + 8 * (pid & 15)) * 2u; const int x = pid >> 3, c = pid & 7; oT[q] = (unsigned)((x >> 1) * PLD + 64 * (x & 1) + 8 * c) * 2u;
        const int p = lane + 64 * q; oS[q] = (unsigned)((p >> 1) * PLD + 16 * w + 8 * (p & 1)) * 2u; }
    auto load_chunk = [&](int nl) {
        const int lr0 = b * 1024 + 64 * nl; const size_t item = (size_t)((b * 16 + nl) * 8 + hi_);
        const char* sc = (const char*)(ws + WS_SC) + item * 8192;
        const char* pq = (const char*)(P + (size_t)lr0 * PLD + C_HQ + 128 * hi_); const char* pk = (const char*)(P + (size_t)lr0 * PLD + C_HF + 128 * hi_);
        const char* pv = (const char*)(P + (size_t)lr0 * PLD + C_HI + 128 * hi_); const char* pg = (const char*)(P + (size_t)lr0 * PLD + C_HG + 128 * hi_);
#pragma unroll
        for (int q = 0; q < 2; ++q) { R[q] = *(const u32x4*)(pq + oA[q]); R[2 + q] = *(const u32x4*)(pk + oT[q]); R[4 + q] = *(const u32x4*)(pv + oT[q]); R[7 + q] = *(const u32x4*)(pg + oS[q]); }
        R[6] = *(const u32x4*)(sc + (unsigned)tid * 16u);
        if (tid < 128) Rd = ((const float*)(ws + WS_DEC))[item * 128 + tid];
    };
    auto store_chunk = [&]() {
#pragma unroll
        for (int q = 0; q < 2; ++q) { const int pid = tid + 512 * q; st_perm(QE + (pid >> 4) * 136, pid & 15, R[q]);
            *(LAS u32x4*)(KET + (pid >> 3) * 72 + 8 * (pid & 7)) = R[2 + q]; *(LAS u32x4*)(VT + (pid >> 3) * 72 + 8 * (pid & 7)) = R[4 + q]; }
        *(LAS u32x4*)(SCs + (tid >> 3) * 72 + 8 * (tid & 7)) = R[6];
#pragma unroll
        for (int q = 0; q < 2; ++q) { const int p = lane + 64 * q; *(LAS u32x4*)(GT + (p >> 1) * 136 + 16 * w + 8 * (p & 1)) = R[7 + q]; }
        if (tid < 128) dec[tid] = Rd;
    };
    const float gnv = a.in[I_HON][16 * w + lj];
    load_chunk(0);
    if (tid < 128) tot[tid] = 0.f;
    store_chunk();
#pragma unroll 1
    for (int nl = 0; nl < 16; ++nl) {
        __syncthreads();
        if (nl + 1 < 16) load_chunk(nl + 1);
        bf16x8 Sb[4];
#pragma unroll
        for (int kk = 0; kk < 4; ++kk) Sb[kk] = packacc(S[2 * kk], S[2 * kk + 1]);
        bf16x8 Vb[2];
#pragma unroll
        for (int tk = 0; tk < 2; ++tk) Vb[tk] = fragN(VT, 16 * w + lj, 32 * tk, g, 72);
        f32x4 o[4];
        bf16x8 fa[2][8];
#define LD_QS(bf, mt) do { _Pragma("unroll") for (int kk = 0; kk < 4; ++kk) fa[bf][kk] = fragN(QE, 16 * (mt) + lj, 32 * kk, g, 136); \
            _Pragma("unroll") for (int tk = 0; tk < 2; ++tk) fa[bf][4 + tk] = fragN(SCs, 16 * (mt) + lj, 32 * tk, g, 72); } while (0)
#define LD_KE(bf, m0) do { _Pragma("unroll") for (int m2 = 0; m2 < 4; ++m2) _Pragma("unroll") for (int tk = 0; tk < 2; ++tk) fa[bf][2 * m2 + tk] = fragN(KET, 16 * ((m0) + m2) + lj, 32 * tk, g, 72); } while (0)
#define MF_QS(bf, mt) do { f32x4 c = (f32x4){0.f, 0.f, 0.f, 0.f}; _Pragma("unroll") for (int kk = 0; kk < 4; ++kk) c = MFMA16(fa[bf][kk], Sb[kk], c); \
            _Pragma("unroll") for (int tk = 0; tk < 2; ++tk) c = MFMA16(fa[bf][4 + tk], Vb[tk], c); o[mt] = c; } while (0)
#define MF_KE(bf, m0) do { _Pragma("unroll") for (int m2 = 0; m2 < 4; ++m2) { f32x4 c = S[(m0) + m2] * *(const LAS f32x4*)(dec + 16 * ((m0) + m2) + 4 * g); \
            _Pragma("unroll") for (int tk = 0; tk < 2; ++tk) c = MFMA16(fa[bf][2 * m2 + tk], Vb[tk], c); S[(m0) + m2] = c; } } while (0)
        LD_QS(0, 0); SBAR;
        LD_QS(1, 1); SBAR; MF_QS(0, 0); SBAR;
        LD_QS(0, 2); SBAR; MF_QS(1, 1); SBAR;
        LD_QS(1, 3); SBAR; MF_QS(0, 2); SBAR;
        LD_KE(0, 0); SBAR; MF_QS(1, 3); SBAR;
        LD_KE(1, 4); SBAR; MF_KE(0, 0); SBAR;
        MF_KE(1, 4); SBAR;
#undef LD_QS
#undef LD_KE
#undef MF_QS
#undef MF_KE
        LAS float* tc = tot + 64 * (nl & 1);
        norm_accum(o, tc, lj, g);
        __syncthreads();
        norm_finish(o, tc, GT, gnv, P + (size_t)(b * 1024 + 64 * nl) * PLD + C_HG + 128 * hi_, PLD, dry, sink, w, lane, lj, g, true);
        if (tid < 64) tot[64 * ((nl + 1) & 1) + tid] = 0.f;
        if (nl + 1 < 16) store_chunk();
    }
#pragma unroll
    for (int m = 0; m < 8; ++m) *(f32x4*)(ST + ((w * 8 + m) * 64 + lane) * 4) = S[m];
    __syncthreads();
}

#ifdef ONLY
#define EN(k) (ONLY == (k))
#else
#define EN(k) 1
#endif
__global__ void __launch_bounds__(512, 2) mk_fwd(KArgs a) {
    extern __shared__ __attribute__((aligned(16))) unsigned char lds_raw[];
    LAS unsigned char* lds = (LAS unsigned char*)lds_raw;
    cg::grid_group grid = cg::this_grid();
    volatile LAS unsigned* bst = (volatile LAS unsigned*)(lds + LDS_BYTES - 64);
    if (threadIdx.x < 2) bst[threadIdx.x] = 0u;
    __syncthreads();
    const XcdBarrier xbar = xcd_barrier_post((unsigned*)(a.ws + WS_BAR), bst);
    int seam = 0;
#define GRID_BAR() do { if (seam == 0) grid.sync(); else xcd_barrier(xbar); ++seam; } while (0)
    const int G = gridDim.x, bx = blockIdx.x;
    unsigned char* ws = a.ws;
    float* ssb = (float*)(ws + WS_SS);
    u16* XN = (u16*)(ws + WS_XN);

#pragma unroll 1
    for (int ph = a.ph_lo; ph < a.ph_hi; ++ph) {
        const int ptype = ph == 0 ? 0 : (ph == 1 || ph == 20) ? 1 : (ph == 2 || ph == 19 || ph == 21) ? 2 : ph == 22 ? 7 : 3 + ((ph - 3) & 3);
        (void)ptype;
        {
        constexpr bool dry = false;
        int tid_ = threadIdx.x; asm volatile("" : "+v"(tid_));
        const int tid = tid_, lane = tid & 63, wave = tid >> 6;
        const int gw = bx * 8 + wave, ngw = G * 8;
        LAS float* scr = (LAS float*)(lds + wave * 16384);
        if (EN(0) && ph == 0) {
            convert_weight(a.in[I_F1WI], DM, 2 * DFF, (u16*)(ws + WS_WFI), DM, 0, 1, scr, gw, ngw, lane);
            convert_weight(a.in[I_F1WO], DFF, DM, (u16*)(ws + WS_WFO), DFF, 0, 0, scr, gw, ngw, lane);
            convert_weight(a.in[I_WIN], DM, INW, (u16*)(ws + WS_WIN), DM, 0, 2, scr, gw, ngw, lane);
            convert_weight(a.in[I_WBH], DM, DM, (u16*)(ws + WS_WB), 3072, 0, 0, scr, gw, ngw, lane);
            convert_weight(a.in[I_WBG], 2048, DM, (u16*)(ws + WS_WB), 3072, 1024, 0, scr, gw, ngw, lane);
            convert_weight(a.in[I_WOUT], DM, DM, (u16*)(ws + WS_WOUT), DM, 0, 0, scr, gw, ngw, lane);
            if (bx < 64) { const int idx = bx * 512 + tid; const int k = idx >> 5, c = idx & 31; ((u16*)(ws + WS_WAB))[c * 1024 + k] = (u16)f2bf(a.in[I_WIN][(size_t)k * INW + 8192 + c]); }
            for (int m = gw; m < T_TOK; m += ngw) {
                const f32x4* xr = (const f32x4*)(a.in[I_X] + (size_t)m * DM) + lane; const f32x4* gr = (const f32x4*)a.in[I_F1N] + lane; float s = 0.f;
                unsigned long long* o8 = (unsigned long long*)(XN + (size_t)m * DM) + lane;
#pragma unroll
                for (int q = 0; q < 4; ++q) { const f32x4 v = xr[64 * q], gg = gr[64 * q]; s += (v[0] * v[0] + v[1] * v[1]) + (v[2] * v[2] + v[3] * v[3]);
                    o8[64 * q] = (unsigned long long)pk2(v[0] * gg[0], v[1] * gg[1]) | ((unsigned long long)pk2(v[2] * gg[2], v[3] * gg[3]) << 32); }
                s = wave_sum(s);
                if (lane == 0) { ssb[m] = s; ssb[T_TOK + m] = 0.f; ssb[2 * T_TOK + m] = 0.f; ssb[3 * T_TOK + m] = 0.f; }
            }
        } else if (EN(1) && (ph == 1 || ph == 20)) {
            SchedStd S; S.A = (const char*)(ws + (ph == 1 ? WS_XN : WS_XN3)); S.B = (const char*)(ws + WS_WFI); S.lda = DM; S.ldb = DM; S.nt = 16; S.O.init(64, 22, G, bx);
            EpiSwiglu E; E.H = (u16*)(ws + WS_HID); E.ss = ssb + (ph == 1 ? 0 : 2 * T_TOK);
            pg8::gemm_phase(lds, S, E);
        } else if (EN(2) && (ph == 2 || ph == 19 || ph == 21)) {
            SchedStd S; EpiResid E;
            if (ph == 19) { S.A = (const char*)(ws + WS_XN); S.B = (const char*)(ws + WS_WOUT); S.lda = DM; S.ldb = DM; S.nt = 16;
                E.base = a.out; E.scale = 1.0f; E.xn = (u16*)(ws + WS_XN3); E.g = a.in[I_F2N]; E.ss_out = ssb + 2 * T_TOK; }
            else { S.A = (const char*)(ws + WS_HID); S.B = (const char*)(ws + WS_WFO); S.lda = DFF; S.ldb = DFF; S.nt = 44;
                E.base = ph == 2 ? a.in[I_X] : a.out; E.scale = 0.5f; E.xn = ph == 2 ? XN : nullptr; E.g = a.in[I_MIXN]; E.ss_out = ssb + (ph == 2 ? T_TOK : 3 * T_TOK); }
            E.out = a.out; E.dry = dry; E.dummy = (float*)(ws + WS_DUMMY); S.O.init(64, 4, G, bx);
            pg8::gemm_phase(lds, S, E);
        } else if (ph < 19) {
            const int j = (ph - 3) >> 2, sub = (ph - 3) & 3;
            if (EN(3) && sub == 0) {
                SchedG3 S; S.A = (const char*)XN; S.B = (const char*)(ws + WS_WIN); S.lda = DM; S.ldb = DM; S.nt = 16; S.j = j; S.pn0 = 0; S.perm = (j != 0); S.O.init(16, j == 0 ? 48 : 32, G, bx);
                EpiProj E; E.P = (u16*)(ws + WS_PROJ); E.L = (u16*)(ws + WS_LATE) + (size_t)(j & 1) * 4096 * LLD; E.ss = ssb + T_TOK; E.lbl = a.in[I_LBL]; E.halo = (u16*)(ws + WS_HALO); E.j = j; E.pn0 = 0; E.perm = (j != 0);
                pg8::gemm_phase(lds, S, E);
                if (j == 0) { for (int it = bx; it < 256; it += G) gab_item(lds, a, it * 64); }
            } else if (sub == 1) {
#pragma unroll 1
                for (int it = bx; it < 1024; it += G) {
                    if (EN(4) && it < 512) { if (!(dry && (a.probe & 0x4000))) prep_gdn(lds, a, j, it >> 7, (it >> 3) & 15, it & 7, dry); }
                    else if (EN(5) && it >= 512) { const int i2 = it - 512; if (!(dry && (a.probe & 0x8000))) prep_hgrn(lds, a, i2 >> 7, (i2 >> 3) & 15, i2 & 7, dry); }
                }
            } else if (sub == 2) {
                if (j < 3 && bx >= 96 && !dry) {
                    SchedG3 S; S.A = (const char*)XN; S.B = (const char*)(ws + WS_WIN); S.lda = DM; S.ldb = DM; S.nt = 16; S.j = j + 1; S.pn0 = 32; S.perm = 3; S.O.init(16, 16, G - 96, bx - 96);
                    EpiProj E; E.P = (u16*)(ws + WS_PROJ); E.L = (u16*)(ws + WS_LATE) + (size_t)((j + 1) & 1) * 4096 * LLD; E.ss = ssb + T_TOK; E.lbl = a.in[I_LBL]; E.halo = (u16*)(ws + WS_HALO); E.j = j + 1; E.pn0 = 32; E.perm = 3;
                    pg8::gemm_phase(lds, S, E);
                }
                if (j == 3 && bx >= 96 && !dry) {
                    const int gw2 = (bx - 96) * 8 + wave, ngw2 = (G - 96) * 8;
                    convert_weight(a.in[I_F2WI], DM, 2 * DFF, (u16*)(ws + WS_WFI), DM, 0, 1, scr, gw2, ngw2, lane);
                    convert_weight(a.in[I_F2WO], DFF, DM, (u16*)(ws + WS_WFO), DFF, 0, 0, scr, gw2, ngw2, lane);
                }
#pragma unroll 1
                for (int c = bx; c < 96; c += G) {
                    if (EN(6) && c < 64) { recur_gdn(lds, a, j, c >> 4, c & 15, false); }
                    else if (EN(7) && c >= 64) { recur_hgrn(lds, a, j, (c - 64) >> 3, (c - 64) & 7, false); }
                }
            } else if (EN(8)) {
                SchedG4 S; S.P = (const char*)(ws + WS_PROJ); S.L = (const char*)(ws + WS_LATE) + (size_t)(j & 1) * 4096 * LLD * 2; S.B = (const char*)(ws + WS_WB); S.lda = (bx % 3 == 0) ? PLD : LLD; S.ldb = 3072; S.c = bx;
                EpiG4 E; E.L = (const u16*)(ws + WS_LATE) + (size_t)(j & 1) * 4096 * LLD; E.Y = (u16*)(ws + WS_XN); E.TMP = (u16*)(ws + (j == 3 ? WS_WM : WS_WFI)); E.flags = (unsigned*)(ws + WS_BAR) + 3584; E.j = j;
                pg8::gemm_phase(lds, S, E);
            }
        } else {
            const float* ss4 = ssb + 3 * T_TOK;
            for (int m = gw; m < T_TOK; m += ngw) { f32x4* xr = (f32x4*)(a.out + (size_t)m * DM) + lane; const f32x4* gr = (const f32x4*)a.in[I_FINN] + lane;
                f32x4* xw = dry ? (f32x4*)(ws + WS_DUMMY) + lane : xr;
                const float rs = rsqrtf(ss4[m] * (1.0f / 1024.0f) + EPS);
#pragma unroll
                for (int q = 0; q < 4; ++q) xw[dry ? 0 : 64 * q] = xr[64 * q] * gr[64 * q] * rs; }
        }
        if (dry) GRID_BAR();
        }
        if (ph + 1 < a.ph_hi) GRID_BAR();
    }
}

#ifndef PROBE_MASK
#define PROBE_MASK 0
#endif
extern "C" void kernel_launch(void* const* d_in, const int* in_sizes, int n_in, void* d_out, int out_size, void* d_ws, size_t ws_size, hipStream_t stream) {
    static int grid = 0;
    if (grid == 0) {
        if (n_in != 19 || ws_size < WS_END) { fprintf(stderr, "kernel_launch: unexpected inputs (n_in %d, ws %zu)\n", n_in, ws_size); grid = -1; return; }
        int dev = 0, cus = 0, per_cu = 0;
        hipGetDevice(&dev); hipDeviceGetAttribute(&cus, hipDeviceAttributeMultiprocessorCount, dev);
        hipFuncSetAttribute((const void*)mk_fwd, hipFuncAttributeMaxDynamicSharedMemorySize, LDS_BYTES);
        hipOccupancyMaxActiveBlocksPerMultiprocessor(&per_cu, (const void*)mk_fwd, 512, LDS_BYTES);
        if (per_cu < 1) { fprintf(stderr, "kernel_launch: occupancy query says %d blocks per CU\n", per_cu); per_cu = 1; }
        if (per_cu > 1) per_cu = 1;
        grid = cus * per_cu;
    }
    if (grid < 0) return;
    if (hipMemsetAsync((char*)d_ws + WS_BAR, 0, BAR_BYTES, stream) != hipSuccess) { fprintf(stderr, "kernel_launch: memset failed\n"); return; }
    KArgs a{};
    for (int i = 0; i < 19; ++i) a.in[i] = (const float*)d_in[i];
    a.out = (float*)d_out; a.ws = (unsigned char*)d_ws; a.ph_lo = 0; a.ph_hi = 23; a.probe = PROBE_MASK;
    void* args[] = {&a};
    hipError_t e = hipLaunchCooperativeKernel((const void*)mk_fwd, dim3(grid), dim3(512), args, LDS_BYTES, stream);
    if (e != hipSuccess) fprintf(stderr, "cooperative launch failed: %s (grid %d)\n", hipGetErrorString(e), grid);
}
```
